# Optimizing an MI355X kernel written in HIP

```python
import math
import jax, jax.numpy as jnp
from jax import lax
import numpy as np

D_MODEL = 1024
BATCH = 16
SEQ = 2048
DEPTH = 4

N_MIXERS = 3
N_A_LAYERS = (DEPTH + 2) // 3
N_B_LAYERS = (DEPTH + 1) // 3
N_C_LAYERS = DEPTH // 3

RMS_EPS = 1e-6
CONV_W = 3

NA_HEAD_DIM = 64
NA_HEADS = D_MODEL // NA_HEAD_DIM
GRID_W = 64
NA_MAX_ROWS = 8
NA_COLS = 16
NA_QCOLS = 16
NA_SPAN = NA_QCOLS + NA_COLS

HYENA_ORDER = 2
HYENA_BANDS = 16
HYENA_EMB = 1 + 2 * HYENA_BANDS
HYENA_FILTER_HIDDEN = 64
HYENA_DECAY_TARGET = 1e-2
HYENA_FAST_DECAY = 0.3
HYENA_SLOW_DECAY = 1.5

FFN_HIDDEN = ((8 * D_MODEL + 3 * 256 - 1) // (3 * 256)) * 256

kernel_name = 'hybrid_shortconv_natten_hyena_encoder'


def rmsnorm(x, g):
    xf = x.astype(jnp.float32)
    y = xf * lax.rsqrt(jnp.mean(xf * xf, axis=-1, keepdims=True) + RMS_EPS)
    return (y * g.astype(jnp.float32)).astype(x.dtype)


def depthwise_conv3(x, w, b=None):
    c = x.shape[-1]
    y = lax.conv_general_dilated(
        x, w.astype(x.dtype)[:, None, :], (1,), ((CONV_W // 2, CONV_W // 2),),
        dimension_numbers=('NWC', 'WIO', 'NWC'), feature_group_count=c)
    return y if b is None else y + b.astype(x.dtype)


def short_conv_mixer(h, w_in, conv_w, w_out):
    b_gate, c_gate, u = jnp.split(h @ w_in, 3, axis=-1)
    return (b_gate * depthwise_conv3(c_gate * u, conv_w)) @ w_out


def na_column_tables():
    cb = np.arange(GRID_W // NA_QCOLS)
    starts = np.clip(cb * NA_QCOLS - NA_COLS // 2, 0, GRID_W - NA_SPAN)
    key_col = starts[:, None] + np.arange(NA_SPAN)
    q_col = cb[:, None] * NA_QCOLS + np.arange(NA_QCOLS)
    col_start = np.clip(q_col - NA_COLS // 2, 0, GRID_W - NA_COLS)
    kc = key_col[:, None, :]
    valid = (kc >= col_start[:, :, None]) & (kc < col_start[:, :, None] + NA_COLS)
    dc_idx = np.clip(kc - q_col[:, :, None] + NA_COLS - 1, 0, 2 * NA_COLS - 2)
    return key_col, valid, dc_idx


def neighborhood_attention(h, w_qkv, q_g, k_g, rpb, w_out):
    bsz, seq, d = h.shape
    rows = seq // GRID_W
    wr = min(NA_MAX_ROWS, rows)
    q, k, v = jnp.split(h @ w_qkv, 3, axis=-1)
    grid = (bsz, rows, GRID_W, NA_HEADS, NA_HEAD_DIM)
    q = rmsnorm(q.reshape(grid), q_g)
    k = rmsnorm(k.reshape(grid), k_g)
    v = v.reshape(grid)
    key_col, valid, dc_idx = na_column_tables()
    ncb = key_col.shape[0]
    scale = NA_HEAD_DIM ** -0.5
    neg = jnp.finfo(jnp.float32).min
    mask = valid[None, None, :, :, None, :]

    def row_block(r):
        rs = jnp.clip(r - wr // 2, 0, rows - wr)
        q_r = lax.dynamic_index_in_dim(q, r, axis=1, keepdims=False)
        q_r = q_r.reshape(bsz, ncb, NA_QCOLS, NA_HEADS, NA_HEAD_DIM)
        k_r = lax.dynamic_slice_in_dim(k, rs, wr, axis=1)[:, :, key_col]
        v_r = lax.dynamic_slice_in_dim(v, rs, wr, axis=1)[:, :, key_col]
        s = jnp.einsum('bnqhd,brnkhd->bhnqrk', q_r, k_r).astype(jnp.float32) * scale
        dr_idx = rs + jnp.arange(wr) - r + NA_MAX_ROWS - 1
        bias = rpb[:, dr_idx[None, None, :, None], dc_idx[:, :, None, :]]
        s = jnp.where(mask, s + bias.astype(jnp.float32)[None], neg)
        p = jax.nn.softmax(s.reshape(s.shape[:4] + (wr * NA_SPAN,)), axis=-1)
        p = p.reshape(s.shape).astype(v.dtype)
        o = jnp.einsum('bhnqrk,brnkhd->bnqhd', p, v_r)
        return o.reshape(bsz, GRID_W, d)

    o = lax.map(row_block, jnp.arange(rows))
    return o.transpose(1, 0, 2, 3).reshape(bsz, seq, d) @ w_out


def hyena_filters(seq, w1, b1, w2, b2, w3, freq):
    f32 = jnp.float32
    t = jnp.linspace(0.0, 1.0, seq, dtype=f32)[:, None]
    bands = jnp.linspace(1e-4, HYENA_BANDS - 1, HYENA_BANDS, dtype=f32)
    ang = (2.0 * math.pi) * jnp.arange(seq, dtype=f32)[:, None] / seq * bands
    z = jnp.concatenate([t, jnp.cos(ang), -jnp.sin(ang)], axis=-1)
    fr = freq.astype(f32)
    hid = jnp.sin(fr * (z @ w1.astype(f32) + b1.astype(f32)))
    hid = jnp.sin(fr * (hid @ w2.astype(f32) + b2.astype(f32)))
    filt = (hid @ w3.astype(f32)).reshape(seq, HYENA_ORDER, 2, D_MODEL)
    lt = math.log(HYENA_DECAY_TARGET)
    deltas = jnp.abs(jnp.linspace(lt / HYENA_SLOW_DECAY, lt / HYENA_FAST_DECAY, D_MODEL, dtype=f32))
    filt = filt * jnp.exp(-t * deltas)[:, None, None, :]
    fwd, rev = filt[:, :, 0], filt[:, :, 1]
    h_full = jnp.concatenate([fwd[:1] + rev[:1], fwd[1:], jnp.zeros_like(fwd[:1]), rev[:0:-1]], axis=0)
    h_full = h_full / jnp.sum(jnp.abs(h_full), axis=0, keepdims=True)
    return jnp.fft.rfft(h_full, axis=0)


def hyena_mixer(h, w_in, short_w, short_b, f_w1, f_b1, f_w2, f_b2, f_w3, f_freq, f_skip, w_out):
    seq = h.shape[1]
    v, x1, x2 = jnp.split(depthwise_conv3(h @ w_in, short_w, short_b), 3, axis=-1)
    h_freq = hyena_filters(seq, f_w1, f_b1, f_w2, f_b2, f_w3, f_freq)

    def long_conv(u, n):
        uf = u.astype(jnp.float32)
        y = jnp.fft.irfft(jnp.fft.rfft(uf, n=2 * seq, axis=1) * h_freq[:, n], n=2 * seq, axis=1)[:, :seq]
        return (y + uf * f_skip[n].astype(jnp.float32)).astype(u.dtype)

    z = x1 * long_conv(v, 0)
    z = x2 * long_conv(z, 1)
    return z @ w_out


def swiglu(h, w13, w2):
    g, u = jnp.split(h @ w13, 2, axis=-1)
    return (jax.nn.silu(g) * u) @ w2


def setup_inputs(seed: int = 0) -> dict:
    key = jax.random.key(seed)
    ks = jax.random.split(key, 24)
    f32 = jnp.float32

    def nrm(k, shape, fan_in):
        return jax.random.normal(k, shape, f32) * (fan_in ** -0.5)

    def gain(k, shape):
        return 1.0 + 0.02 * jax.random.normal(k, shape, f32)

    def small(k, shape, s=0.02):
        return s * jax.random.normal(k, shape, f32)

    D = D_MODEL
    return {
        'x': jax.random.normal(ks[0], (BATCH, SEQ, D), f32),
        'norm_mix_g': gain(ks[1], (DEPTH, D)),
        'norm_ffn_g': gain(ks[2], (DEPTH, D)),
        'a_w_in': nrm(ks[3], (N_A_LAYERS, D, 3 * D), D),
        'a_conv_w': nrm(ks[4], (N_A_LAYERS, CONV_W, D), CONV_W),
        'a_w_out': nrm(ks[5], (N_A_LAYERS, D, D), D),
        'b_w_qkv': nrm(ks[6], (N_B_LAYERS, D, 3 * D), D),
        'b_q_norm_g': gain(ks[7], (N_B_LAYERS, NA_HEAD_DIM)),
        'b_k_norm_g': gain(ks[8], (N_B_LAYERS, NA_HEAD_DIM)),
        'b_rpb': small(ks[9], (N_B_LAYERS, NA_HEADS, 2 * NA_MAX_ROWS - 1, 2 * NA_COLS - 1)),
        'b_w_out': nrm(ks[10], (N_B_LAYERS, D, D), D),
        'c_w_in': nrm(ks[11], (N_C_LAYERS, D, 3 * D), D),
        'c_short_w': nrm(ks[12], (N_C_LAYERS, CONV_W, 3 * D), CONV_W),
        'c_short_b': small(ks[13], (N_C_LAYERS, 3 * D)),
        'c_f_w1': nrm(ks[14], (N_C_LAYERS, HYENA_EMB, HYENA_FILTER_HIDDEN), HYENA_EMB),
        'c_f_b1': small(ks[15], (N_C_LAYERS, HYENA_FILTER_HIDDEN)),
        'c_f_w2': nrm(ks[16], (N_C_LAYERS, HYENA_FILTER_HIDDEN, HYENA_FILTER_HIDDEN), HYENA_FILTER_HIDDEN),
        'c_f_b2': small(ks[17], (N_C_LAYERS, HYENA_FILTER_HIDDEN)),
        'c_f_w3': nrm(ks[18], (N_C_LAYERS, HYENA_FILTER_HIDDEN, HYENA_ORDER * 2 * D), HYENA_FILTER_HIDDEN),
        'c_f_freq': gain(ks[19], (N_C_LAYERS, HYENA_FILTER_HIDDEN)),
        'c_f_skip': small(ks[20], (N_C_LAYERS, HYENA_ORDER, D), 0.5),
        'c_w_out': nrm(ks[21], (N_C_LAYERS, D, D), D),
        'f_w13': nrm(ks[22], (DEPTH, D, 2 * FFN_HIDDEN), D),
        'f_w2': nrm(ks[23], (DEPTH, FFN_HIDDEN, D), FFN_HIDDEN),
    }


def reference(x, norm_mix_g, norm_ffn_g, a_w_in, a_conv_w, a_w_out,
              b_w_qkv, b_q_norm_g, b_k_norm_g, b_rpb, b_w_out,
              c_w_in, c_short_w, c_short_b, c_f_w1, c_f_b1, c_f_w2, c_f_b2,
              c_f_w3, c_f_freq, c_f_skip, c_w_out, f_w13, f_w2):
    ia = ib = ic = 0
    for i in range(DEPTH):
        h = rmsnorm(x, norm_mix_g[i])
        kind = i % N_MIXERS
        if kind == 0:
            y = short_conv_mixer(h, a_w_in[ia], a_conv_w[ia], a_w_out[ia])
            ia += 1
        elif kind == 1:
            y = neighborhood_attention(h, b_w_qkv[ib], b_q_norm_g[ib], b_k_norm_g[ib], b_rpb[ib], b_w_out[ib])
            ib += 1
        else:
            y = hyena_mixer(h, c_w_in[ic], c_short_w[ic], c_short_b[ic], c_f_w1[ic], c_f_b1[ic],
                            c_f_w2[ic], c_f_b2[ic], c_f_w3[ic], c_f_freq[ic], c_f_skip[ic], c_w_out[ic])
            ic += 1
        x = x + y
        x = x + swiglu(rmsnorm(x, norm_ffn_g[i]), f_w13[i], f_w2[i])
    return x
```

```cpp
#include <hip/hip_runtime.h>
#include <hip/hip_cooperative_groups.h>
#include <cstdio>
#include <cstdint>
namespace cg = cooperative_groups;
namespace pg8 {
#define PG8_LAS __attribute__((address_space(3)))
typedef unsigned short bf16_t;
typedef short bf16x8 __attribute__((ext_vector_type(8)));
typedef float f32x4 __attribute__((ext_vector_type(4)));
typedef unsigned u32x4 __attribute__((ext_vector_type(4)));
constexpr int BM = 256, BK = 64, HALF = 128, HTB = HALF * BK * 2  , STAGE_BYTES = 8 * HTB, NXCD = 8, WGM = 8;

__host__ __device__ __forceinline__ int lds_byte(int r, int c) { const int st = (r >> 4) * 2 + (c >> 5), rr = r & 15, cc = c & 31, ob = rr * 64 + cc * 2; return st * 1024 + (ob ^ (((ob >> 9) & 1) << 5)); }
__host__ __device__ __forceinline__ void stage_rc(int b, int& R, int& C) { const int st = b / 1024, sb = b % 1024, swz = sb ^ (((sb >> 9) & 1) << 5); R = (st >> 1) * 16 + swz / 64; C = (st & 1) * 32 + (swz % 64) / 2; }
__host__ __device__ __forceinline__ int perm32(int rho) { const int n = rho >> 4, i = rho & 15; return 8 * (i >> 2) + 4 * n + (i & 3); }

struct Unit { int pm, pn, idx; };
struct Gemm { const bf16_t* A; const bf16_t* Bt; int M, N, K; };

struct StaticOrder {
    int nM, nN, nwg, G, c;
    __host__ __device__ void init(int M, int N, int G_, int c_) { nM = M / BM; nN = N / BM; nwg = nM * nN; G = G_; c = c_; }
    __host__ __device__ bool next(int i, Unit& u) const {
        const long L = (long)i * G + c; if (L >= nwg) return false;
        int wgid = (int)L; { const int q = nwg / NXCD, r = nwg % NXCD, xcd = wgid % NXCD, off = wgid / NXCD; wgid = (xcd < r ? xcd * (q + 1) : r * (q + 1) + (xcd - r) * q) + off; }
        const int nig = WGM * nN, gid = wgid / nig, fm = gid * WGM, gsz = (nM - fm) < WGM ? (nM - fm) : WGM;
        u.pm = fm + ((wgid % nig) % gsz); u.pn = (wgid % nig) / gsz; u.idx = i; return true;
    }
    __device__ __forceinline__ void a_ready(const Unit&) const {}
    __device__ __forceinline__ void done(const Unit&) const {}
};
__device__ __forceinline__ unsigned cvt_pk_bf16(float lo, float hi) { unsigned r; asm volatile("v_cvt_pk_bf16_f32 %0, %1, %2" : "=v"(r) : "v"(lo), "v"(hi)); return r; }
__device__ __forceinline__ float row_rscale(const float* ss, int row) { const f32x4* p = (const f32x4*)(ss + (size_t)row * 16); const f32x4 a = (p[0] + p[1]) + (p[2] + p[3]);
    return __builtin_amdgcn_rsqf(((a[0] + a[1]) + (a[2] + a[3])) * (1.0f / 1024.0f) + 1e-6f); }
template <bool KSS = false> struct EpiBf16PT {
    static constexpr bool PERM = true, AFTER_DRAIN = false;
    bf16_t* O; int ldc; const PG8_LAS float* rst; float* kss; int mrows;
    __device__ __forceinline__ void operator()(const f32x4 (&acc)[2][2][4][2], const Unit& u, int wr, int wc, int fr, int fq) const {
        const int row0 = u.pm * BM + wr * 64 + fr, col0 = u.pn * BM + wc * 32 + 8 * fq;
        const bool kt = KSS && u.pn >= 4 && u.pn < 8;
#pragma unroll
        for (int ai = 0; ai < 2; ++ai)
#pragma unroll
            for (int m = 0; m < 4; ++m) { const int row = row0 + ai * HALF + m * 16; bf16_t* rowp = O + (size_t)row * ldc + col0; const float rs = rst[u.idx * 256 + wr * 64 + fr + ai * HALF + m * 16];
#pragma unroll
                for (int bj = 0; bj < 2; ++bj) { const f32x4 v0 = acc[ai][bj][m][0] * rs, v1 = acc[ai][bj][m][1] * rs;
                    u32x4 w; w.x = cvt_pk_bf16(v0[0], v0[1]); w.y = cvt_pk_bf16(v0[2], v0[3]); w.z = cvt_pk_bf16(v1[0], v1[1]); w.w = cvt_pk_bf16(v1[2], v1[3]);
                    *(u32x4*)(rowp + bj * HALF) = w;
                    if (kt) { float q = ((v0[0] * v0[0] + v0[1] * v0[1]) + (v0[2] * v0[2] + v0[3] * v0[3])) + ((v1[0] * v1[0] + v1[1] * v1[1]) + (v1[2] * v1[2] + v1[3] * v1[3]));
                        q += __shfl_xor(q, 16); q += __shfl_xor(q, 32);
                        if (fq == 0) kss[(size_t)((u.pn - 4) * 8 + bj * 4 + wc) * mrows + row] = q; } }
                if (KSS) asm volatile("" ::: "memory"); }
    }
};
typedef EpiBf16PT<false> EpiBf16P;
__device__ __forceinline__ float silu_mul(float g, float u) { return g * __builtin_amdgcn_rcpf(1.0f + __expf(-g)) * u; }
struct EpiSwiGLU {
    static constexpr bool PERM = true, AFTER_DRAIN = false;
    bf16_t* H; int ldh; const PG8_LAS float* rst;
    __device__ __forceinline__ void operator()(const f32x4 (&acc)[2][2][4][2], const Unit& u, int wr, int wc, int fr, int fq) const {
        const int row0 = u.pm * BM + wr * 64 + fr, col0 = u.pn * HALF + wc * 32 + 8 * fq;
#pragma unroll
        for (int ai = 0; ai < 2; ++ai)
#pragma unroll
            for (int m = 0; m < 4; ++m) { bf16_t* rowp = H + (size_t)(row0 + ai * HALF + m * 16) * ldh + col0; const float rs = rst[u.idx * 256 + wr * 64 + fr + ai * HALF + m * 16];
                const f32x4 g0 = acc[ai][0][m][0] * rs, g1 = acc[ai][0][m][1] * rs, u0 = acc[ai][1][m][0] * rs, u1 = acc[ai][1][m][1] * rs;
                u32x4 w; w.x = cvt_pk_bf16(silu_mul(g0[0], u0[0]), silu_mul(g0[1], u0[1])); w.y = cvt_pk_bf16(silu_mul(g0[2], u0[2]), silu_mul(g0[3], u0[3]));
                w.z = cvt_pk_bf16(silu_mul(g1[0], u1[0]), silu_mul(g1[1], u1[1])); w.w = cvt_pk_bf16(silu_mul(g1[2], u1[2]), silu_mul(g1[3], u1[3]));
                *(u32x4*)rowp = w; }
    }
};
typedef unsigned u32x2 __attribute__((ext_vector_type(2)));
template <bool LAST = false> struct EpiResNormT {
    static constexpr bool PERM = true, AFTER_DRAIN = false;
    float* out; bf16_t* xb; float* ss; int ldc;
    __device__ __forceinline__ void operator()(const f32x4 (&acc)[2][2][4][2], const Unit& u, int wr, int wc, int fr, int fq) const {
        const int row0 = u.pm * BM + wr * 64 + fr, col0 = u.pn * BM + wc * 32 + 8 * fq;
#pragma unroll
        for (int ai = 0; ai < 2; ++ai)
#pragma unroll
            for (int m = 0; m < 4; ++m) { const int row = row0 + ai * HALF + m * 16; const size_t off = (size_t)row * ldc + col0; float s = 0.f;
#pragma unroll
                for (int bj = 0; bj < 2; ++bj) { const size_t o = off + bj * HALF; const u32x4 b = *(const u32x4*)(xb + o);
                    f32x4 r0, r1;
                    r0[0] = __uint_as_float(b.x << 16) + acc[ai][bj][m][0][0]; r0[1] = __uint_as_float(b.x & 0xffff0000u) + acc[ai][bj][m][0][1];
                    r0[2] = __uint_as_float(b.y << 16) + acc[ai][bj][m][0][2]; r0[3] = __uint_as_float(b.y & 0xffff0000u) + acc[ai][bj][m][0][3];
                    r1[0] = __uint_as_float(b.z << 16) + acc[ai][bj][m][1][0]; r1[1] = __uint_as_float(b.z & 0xffff0000u) + acc[ai][bj][m][1][1];
                    r1[2] = __uint_as_float(b.w << 16) + acc[ai][bj][m][1][2]; r1[3] = __uint_as_float(b.w & 0xffff0000u) + acc[ai][bj][m][1][3];
                    if (LAST) { *(f32x4*)(out + o) = r0; *(f32x4*)(out + o + 4) = r1; }
                    else { s += ((r0[0] * r0[0] + r0[1] * r0[1]) + (r0[2] * r0[2] + r0[3] * r0[3])) + ((r1[0] * r1[0] + r1[1] * r1[1]) + (r1[2] * r1[2] + r1[3] * r1[3]));
                        u32x4 w; w.x = cvt_pk_bf16(r0[0], r0[1]); w.y = cvt_pk_bf16(r0[2], r0[3]); w.z = cvt_pk_bf16(r1[0], r1[1]); w.w = cvt_pk_bf16(r1[2], r1[3]); *(u32x4*)(xb + o) = w; } }
                if (!LAST) { s += __shfl_xor(s, 16); s += __shfl_xor(s, 32); if (fq == 0) ss[(size_t)row * 16 + u.pn * 4 + wc] = s; }
                asm volatile("" ::: "memory"); }
    }
};
typedef EpiResNormT<false> EpiResNorm;
template <class Epi, class Sched, bool ALIGN_EPI = false, bool SP2 = false>
__device__ __forceinline__ void gemm_phase(PG8_LAS unsigned char* lds, const Gemm g, const Sched& S, const Epi& E) {
    const int tid = threadIdx.x, wid = __builtin_amdgcn_readfirstlane(tid >> 6), lane = tid & 63, wr = wid >> 2, wc = wid & 3, fr = lane & 15, fq = lane >> 4;
    const int K = g.K, nt = K / BK;
    unsigned voffA[2], voffB[2];
#pragma unroll
    for (int i = 0; i < 2; ++i) { int R, C; stage_rc(tid * 16 + i * 8192, R, C); const int Rb = Epi::PERM ? ((R & ~31) + perm32(R & 31)) : R;
        voffA[i] = (unsigned)(R * K + C) * 2u; voffB[i] = (unsigned)(Rb * K + C) * 2u; }
    const size_t kstep = (size_t)(BK * 2);
    const size_t hstep = (size_t)HALF * K * 2;
    const size_t tstep = 2 * hstep;
    const unsigned ldsw = (unsigned)wid * 1024u;
    const int aoff = lds_byte(wr * 64 + fr, fq * 8), boff = lds_byte(wc * 32 + fr, fq * 8);
#define PG8_SA(b, h) (((b) * 2 + (h)) * HTB)
#define PG8_SB(b, h) ((4 + (b) * 2 + (h)) * HTB)
#define PG8_STAGE(bufoff, gbase, voff) do { _Pragma("unroll") for (int _i = 0; _i < 2; ++_i) \
        __builtin_amdgcn_global_load_lds((const unsigned*)((const char*)(gbase) + (voff)[_i]), (PG8_LAS unsigned*)(lds + (bufoff) + ldsw + _i * 8192), 16, 0, 0); } while (0)
#define PG8_LDA(dst, b, h) do { _Pragma("unroll") for (int m = 0; m < 4; ++m) _Pragma("unroll") for (int k = 0; k < 2; ++k) dst[m][k] = *(const PG8_LAS bf16x8*)(lds + PG8_SA(b, h) + aoff + m * 2048 + k * 1024); } while (0)
#define PG8_LDB(dst, b, h) do { _Pragma("unroll") for (int n = 0; n < 2; ++n) _Pragma("unroll") for (int k = 0; k < 2; ++k) dst[n][k] = *(const PG8_LAS bf16x8*)(lds + PG8_SB(b, h) + boff + n * 2048 + k * 1024); } while (0)
#define PG8_MMA(ai, bj, At, Bt) do { __builtin_amdgcn_s_setprio(1); _Pragma("unroll") for (int m = 0; m < 4; ++m) _Pragma("unroll") for (int n = 0; n < 2; ++n) _Pragma("unroll") for (int k = 0; k < 2; ++k) \
        acc[ai][bj][m][n] = __builtin_amdgcn_mfma_f32_16x16x32_bf16(Bt[n][k], At[m][k], acc[ai][bj][m][n], 0, 0, 0); __builtin_amdgcn_s_setprio(0); } while (0)
#define PG8_WAIT_V(n) asm volatile("s_waitcnt vmcnt(" #n ")" ::: "memory")
#define PG8_WAIT_L(n) asm volatile("s_waitcnt lgkmcnt(" #n ")" ::: "memory")
#define PG8_BAR __builtin_amdgcn_s_barrier()
#define PG8_SCHED __builtin_amdgcn_sched_barrier(0)
    Unit cur, nxt; int ui = 0;
    if (!S.next(0, cur)) return;
    f32x4 acc[2][2][4][2];
#pragma unroll
    for (int a = 0; a < 2; ++a)
#pragma unroll
        for (int b = 0; b < 2; ++b)
#pragma unroll
            for (int m = 0; m < 4; ++m)
#pragma unroll
                for (int n = 0; n < 2; ++n) acc[a][b][m][n] = (f32x4){0.f, 0.f, 0.f, 0.f};
    bf16x8 At[4][2], B0[2][2], B1[2][2];
    const char* cA = (const char*)g.A + (size_t)cur.pm * tstep; const char* cB = (const char*)g.Bt + (size_t)cur.pn * tstep;
    S.a_ready(cur);
    if constexpr (SP2) {
        PG8_STAGE(PG8_SB(0, 0), cB, voffB); PG8_STAGE(PG8_SB(0, 1), cB + hstep, voffB); PG8_STAGE(PG8_SA(0, 0), cA, voffA); PG8_STAGE(PG8_SA(0, 1), cA + hstep, voffA);
        if (wr == 1) PG8_BAR;
        PG8_WAIT_V(2); PG8_BAR;
        PG8_STAGE(PG8_SB(1, 0), cB + kstep, voffB); PG8_STAGE(PG8_SA(1, 0), cA + kstep, voffA); PG8_STAGE(PG8_SB(1, 1), cB + hstep + kstep, voffB);
        PG8_WAIT_V(6); PG8_BAR;
    } else {
        PG8_STAGE(PG8_SB(0, 0), cB, voffB); PG8_STAGE(PG8_SA(0, 0), cA, voffA); PG8_STAGE(PG8_SB(0, 1), cB + hstep, voffB); PG8_STAGE(PG8_SA(0, 1), cA + hstep, voffA);
        if (wr == 1) PG8_BAR;
        PG8_WAIT_V(4); PG8_BAR;
        PG8_STAGE(PG8_SB(1, 0), cB + kstep, voffB); PG8_STAGE(PG8_SA(1, 0), cA + kstep, voffA); PG8_STAGE(PG8_SB(1, 1), cB + hstep + kstep, voffB);
        PG8_WAIT_V(6); PG8_BAR;
    }
    for (;;) {
        const bool has_next = S.next(ui + 1, nxt);
        const char* nA = has_next ? (const char*)g.A + (size_t)nxt.pm * tstep : cA; const char* nB = has_next ? (const char*)g.Bt + (size_t)nxt.pn * tstep : cB;
        for (int t = 0; t < nt; t += 2) {
            const bool last = (t == nt - 2);
            const char* a1 = cA + (size_t)(t + 1) * kstep;
            const char* a2 = last ? nA : cA + (size_t)(t + 2) * kstep; const char* b2 = last ? nB : cB + (size_t)(t + 2) * kstep;
            const char* a3 = a2 + kstep; const char* b3 = b2 + kstep;
            if (last && has_next) S.a_ready(nxt);
            if constexpr (SP2) {
            PG8_LDB(B0, 0, 0); PG8_LDB(B1, 0, 1); PG8_SCHED; PG8_LDA(At, 0, 0); PG8_STAGE(PG8_SA(1, 1), a1 + hstep, voffA);
            PG8_WAIT_V(8); PG8_WAIT_L(0); PG8_BAR; PG8_MMA(0, 0, At, B0); PG8_MMA(0, 1, At, B1); PG8_BAR; PG8_SCHED;
            PG8_LDA(At, 0, 1); PG8_STAGE(PG8_SB(0, 0), b2, voffB); PG8_STAGE(PG8_SB(0, 1), b2 + hstep, voffB); PG8_STAGE(PG8_SA(0, 0), a2, voffA);
            PG8_WAIT_V(8); PG8_WAIT_L(0); PG8_BAR; PG8_MMA(1, 0, At, B0); PG8_MMA(1, 1, At, B1); PG8_BAR; PG8_SCHED;
            PG8_LDB(B0, 1, 0); PG8_LDB(B1, 1, 1); PG8_SCHED; PG8_LDA(At, 1, 0); PG8_STAGE(PG8_SA(0, 1), a2 + hstep, voffA);
            PG8_WAIT_V(8); PG8_WAIT_L(0); PG8_BAR; PG8_MMA(0, 0, At, B0); PG8_MMA(0, 1, At, B1); PG8_BAR; PG8_SCHED;
            PG8_LDA(At, 1, 1); PG8_STAGE(PG8_SB(1, 0), b3, voffB); PG8_STAGE(PG8_SB(1, 1), b3 + hstep, voffB); PG8_STAGE(PG8_SA(1, 0), a3, voffA);
            PG8_WAIT_V(8); PG8_WAIT_L(0); PG8_BAR; PG8_MMA(1, 0, At, B0); PG8_MMA(1, 1, At, B1); PG8_BAR; PG8_SCHED;
            } else {
            PG8_LDB(B0, 0, 0); PG8_SCHED; PG8_LDA(At, 0, 0); PG8_STAGE(PG8_SA(1, 1), a1 + hstep, voffA);
            PG8_WAIT_L(8); PG8_BAR; PG8_WAIT_L(0); PG8_MMA(0, 0, At, B0); PG8_BAR; PG8_SCHED;
            PG8_LDB(B1, 0, 1); PG8_STAGE(PG8_SB(0, 0), b2, voffB);
            PG8_BAR; PG8_WAIT_L(0); PG8_MMA(0, 1, At, B1); PG8_BAR;
            PG8_LDA(At, 0, 1); PG8_STAGE(PG8_SA(0, 0), a2, voffA);
            PG8_BAR; PG8_WAIT_L(0); PG8_MMA(1, 0, At, B0); PG8_BAR; PG8_SCHED;
            PG8_STAGE(PG8_SB(0, 1), b2 + hstep, voffB);
            PG8_WAIT_V(6); PG8_BAR; PG8_MMA(1, 1, At, B1); PG8_BAR;
            PG8_LDB(B0, 1, 0); PG8_SCHED; PG8_LDA(At, 1, 0); PG8_STAGE(PG8_SA(0, 1), a2 + hstep, voffA);
            PG8_WAIT_L(8); PG8_BAR; PG8_WAIT_L(0); PG8_MMA(0, 0, At, B0); PG8_BAR; PG8_SCHED;
            PG8_LDB(B1, 1, 1); PG8_STAGE(PG8_SB(1, 0), b3, voffB);
            PG8_BAR; PG8_WAIT_L(0); PG8_MMA(0, 1, At, B1); PG8_BAR;
            PG8_LDA(At, 1, 1); PG8_STAGE(PG8_SA(1, 0), a3, voffA);
            PG8_BAR; PG8_WAIT_L(0); PG8_MMA(1, 0, At, B0); PG8_BAR; PG8_SCHED;
            PG8_STAGE(PG8_SB(1, 1), b3 + hstep, voffB);
            PG8_WAIT_V(6); PG8_BAR; PG8_MMA(1, 1, At, B1); PG8_BAR;
            }
        }
        if constexpr (ALIGN_EPI) { if (wr == 0) PG8_BAR; }
        if constexpr (!Epi::AFTER_DRAIN) { E(acc, cur, wr, wc, fr, fq); S.done(cur); }
        if (!has_next) break;
#pragma unroll
        for (int a = 0; a < 2; ++a)
#pragma unroll
            for (int b = 0; b < 2; ++b)
#pragma unroll
                for (int m = 0; m < 4; ++m)
#pragma unroll
                    for (int n = 0; n < 2; ++n) acc[a][b][m][n] = (f32x4){0.f, 0.f, 0.f, 0.f};
        cur = nxt; cA = nA; cB = nB; ++ui;
        if constexpr (ALIGN_EPI) { if (wr == 1) PG8_BAR; }
    }
    PG8_WAIT_V(0);
    if constexpr (!ALIGN_EPI) { if (wr == 0) PG8_BAR; }
    PG8_BAR;
    if constexpr (Epi::AFTER_DRAIN) { E.fused(acc, cur, wr, wc, fr, fq, lds, wid, lane); S.done(cur); }
#undef PG8_SA
#undef PG8_SB
#undef PG8_STAGE
#undef PG8_LDA
#undef PG8_LDB
#undef PG8_MMA
#undef PG8_WAIT_V
#undef PG8_WAIT_L
#undef PG8_BAR
#undef PG8_SCHED
}
}

#ifndef MK_N_LAUNCHES
#define MK_N_LAUNCHES 1
#endif
constexpr int NB = 16, SEQ = 2048, DM = 1024, MTOK = NB * SEQ, NQKV = 3072, FFH = 2816, NW13 = 2 * FFH, NLAYER = 4;
constexpr float RMS_EPS = 1e-6f;
constexpr int NWAVES = 8, NTHREADS = 512;
constexpr size_t MiB = 1u << 20;
constexpr size_t WS_W = 1 * MiB, W_LAYER = 49 * MiB / 2;
constexpr size_t W_IN = 0, W_OUT = 6 * MiB, W_13 = 8 * MiB, W_2 = 19 * MiB;
constexpr size_t WS_SS = 439 * MiB;
constexpr size_t WS_HID = 100 * MiB;
constexpr size_t WS_KF = 102 * MiB;
constexpr int KF_LEN = 4112;
constexpr size_t WS_XN = 119 * MiB;
constexpr size_t WS_MIXO = 183 * MiB;
constexpr size_t WS_BIG = 247 * MiB;
constexpr size_t WS_VT = 441 * MiB;
constexpr size_t WS_KSS = 505 * MiB;
constexpr size_t WS_END = 509 * MiB;
constexpr int MISC_OFF = 163776, RST_OFF = 131072;
constexpr size_t WS_BAR = 16384, CTL_ZERO_BYTES = 65536;
constexpr int LDS_BYTES = 163840;
#define LAS __attribute__((address_space(3)))
typedef unsigned short bf16;
typedef unsigned v4u __attribute__((ext_vector_type(4)));
typedef unsigned v2u __attribute__((ext_vector_type(2)));
typedef float f32x4 __attribute__((ext_vector_type(4)));
typedef short bf16x8 __attribute__((ext_vector_type(8)));
typedef short v4i16_t __attribute__((ext_vector_type(4)));
#define LDS_WAIT() asm volatile("s_waitcnt lgkmcnt(0)" ::: "memory")
typedef float f32x2_cv __attribute__((ext_vector_type(2))); typedef __bf16 bf16x2_cv __attribute__((ext_vector_type(2)));
__device__ __forceinline__ unsigned pk2c(float lo, float hi) { const f32x2_cv v = {lo, hi}; const bf16x2_cv b = __builtin_convertvector(v, bf16x2_cv); return __builtin_bit_cast(unsigned, b); }
__device__ __forceinline__ unsigned pk2(float lo, float hi) { return pg8::cvt_pk_bf16(lo, hi); }
__device__ __forceinline__ float bflo(unsigned w) { return __uint_as_float(w << 16); }
__device__ __forceinline__ float bfhi(unsigned w) { return __uint_as_float(w & 0xffff0000u); }
__device__ __forceinline__ float bf2f(unsigned short b) { return __uint_as_float(((unsigned)b) << 16); }
__device__ __forceinline__ unsigned short f2bf(float f) { return (unsigned short)(pk2(f, 0.f) & 0xffffu); }
__device__ __forceinline__ float wave_sum(float v) {
#pragma unroll
    for (int o = 1; o < 64; o <<= 1) v += __shfl_xor(v, o);
    return v;
}

#define RLX_AGENT __ATOMIC_RELAXED, __HIP_MEMORY_SCOPE_AGENT
#define XB_TMO      128
#define XB_XCNT(j)  (256  + 64 * (j))
#define XB_XSUB(j)  (1280 + 64 * (j))
#define XB_XGEN(j)  (2304 + 64 * (j))
#define XB_TOP      3328
#define XB_TOPGEN   3392
#define XCD_BAR_WORDS 3456
#define XB_SPIN_CAP (1u << 18)

__device__ __forceinline__ unsigned xb_ld(unsigned* p)              { return __hip_atomic_load(p, __ATOMIC_RELAXED, __HIP_MEMORY_SCOPE_AGENT); }
__device__ __forceinline__ unsigned xb_add(unsigned* p, unsigned v) { return __hip_atomic_fetch_add(p, v, __ATOMIC_RELAXED, __HIP_MEMORY_SCOPE_AGENT); }
__device__ __forceinline__ unsigned xb_xcc_id() { return (unsigned)__builtin_amdgcn_s_getreg((3 << 11) | 20) & 0xFu; }
#define XB_SPIN(cond, bar) do { unsigned _sp = 0; while (cond) { __builtin_amdgcn_s_sleep(1); \
    if ((++_sp & 255u) == 0u) { if (xb_ld(&(bar)[XB_TMO])) break; if (_sp > XB_SPIN_CAP) { atomicAdd(&(bar)[XB_TMO], 1u); break; } } } } while (0)

struct XcdBarrier {
    unsigned* bar; unsigned x;
    volatile LAS unsigned* st;
};

__device__ __forceinline__ XcdBarrier xcd_barrier_post(unsigned* bar, volatile LAS unsigned* st) {
    XcdBarrier b; b.bar = bar; b.x = xb_xcc_id(); b.st = st;
    if (threadIdx.x == 0) (void)xb_add(&bar[XB_XCNT(b.x)], 1u);
    return b;
}
__device__ __forceinline__ void xcd_barrier_complete(unsigned* bar, unsigned x, unsigned& nloc, unsigned& nx) {
    const unsigned G = gridDim.x * gridDim.y * gridDim.z;
    unsigned sum, cnt, mine, sp = 0u;
    for (;;) {
        sum = 0u; cnt = 0u; mine = 0u;
#pragma unroll
        for (unsigned j = 0; j < 16; ++j) { const unsigned c = xb_ld(&bar[XB_XCNT(j)]); sum += c; cnt += (c > 0u) ? 1u : 0u; mine = (j == x) ? c : mine; }
        if (sum == G) break;
        __builtin_amdgcn_s_sleep(1);
        if ((++sp & 255u) == 0u) { if (xb_ld(&bar[XB_TMO])) break; if (sp > XB_SPIN_CAP) { atomicAdd(&bar[XB_TMO], 1u); break; } }
    }
    nloc = mine > 0u ? mine : 1u; nx = cnt > 0u ? cnt : 1u;
}

__device__ __forceinline__ void xcd_barrier(const XcdBarrier& b) {
    asm volatile("s_waitcnt vmcnt(0)" ::: "memory");
    __syncthreads();
    if (threadIdx.x == 0) {
        unsigned* bar = b.bar;
        __builtin_amdgcn_s_waitcnt(0);
        unsigned nloc = b.st[0], nx = b.st[1];
        if (nloc == 0u) { xcd_barrier_complete(bar, b.x, nloc, nx); b.st[0] = nloc; b.st[1] = nx; }
        const unsigned old = xb_add(&bar[XB_XSUB(b.x)], 1u);
        const unsigned gen = old / nloc;
        if (old + 1u == (gen + 1u) * nloc) {
            __builtin_amdgcn_fence(__ATOMIC_RELEASE, "agent");
            asm volatile("s_waitcnt vmcnt(0)" ::: "memory");
            const unsigned og = xb_add(&bar[XB_TOP], 1u);
            const unsigned tg = og / nx;
            if (og + 1u == (tg + 1u) * nx) xb_add(&bar[XB_TOPGEN], 1u);
            else XB_SPIN(xb_ld(&bar[XB_TOPGEN]) == tg, bar);
            __builtin_amdgcn_fence(__ATOMIC_ACQUIRE, "agent");
            xb_add(&bar[XB_XGEN(b.x)], 1u);
            asm volatile("s_waitcnt vmcnt(0)" ::: "memory");
        } else {
            XB_SPIN(xb_ld(&bar[XB_XGEN(b.x)]) == gen, bar);
            __builtin_amdgcn_fence(__ATOMIC_ACQUIRE, "agent");
            asm volatile("s_waitcnt vmcnt(0)" ::: "memory");
        }
    }
    __syncthreads();
}

__device__ __forceinline__ void transpose_item(const float* __restrict__ W, int K, int N, const float* __restrict__ gain, bf16* WT, int dst_row0, LAS float* scr, int k0, int n0, int lane) {
    float tv[32];
#pragma unroll
    for (int i = 0; i < 32; ++i) { const int kk = 2 * i + (lane >> 5); tv[i] = W[(size_t)(k0 + kk) * N + n0 + (lane & 31)]; }
#pragma unroll
    for (int i = 0; i < 32; ++i) { const int kk = 2 * i + (lane >> 5); float v = tv[i]; if (gain) v *= gain[k0 + kk]; scr[kk * 33 + (lane & 31)] = v; }
    LDS_WAIT();
    const int c = lane & 7;
#pragma unroll
    for (int j = 0; j < 4; ++j) { const int n = (lane >> 3) + 8 * j; const LAS float* s = scr + (8 * c) * 33 + n;
        v4u o; o.x = pk2(s[0 * 33], s[1 * 33]); o.y = pk2(s[2 * 33], s[3 * 33]); o.z = pk2(s[4 * 33], s[5 * 33]); o.w = pk2(s[6 * 33], s[7 * 33]);
        *(v4u*)(WT + (size_t)(dst_row0 + n) * K + k0 + 8 * c) = o; }
    LDS_WAIT();
}

struct Args { const float* in[24]; float* out; unsigned char* ws; int ph_lo, ph_hi; };

__device__ __forceinline__ void phase_prologue(const Args& a, LAS unsigned char* lds, int gw, int ngw, int wave, int lane) {
    LAS float* scr = (LAS float*)(lds + wave * 16384);
    constexpr int I_IN = 16 * 96, I_OUT = 16 * 32, I_13 = 16 * 176, I_2 = 44 * 32, I_L = I_IN + I_OUT + I_13 + I_2;
    for (int it = gw; it < NLAYER * I_L; it += ngw) {
        const int L = it / I_L; int r = it - L * I_L;
        const float* win = (L == 1) ? a.in[6] : (L == 2) ? a.in[11] : (L == 0 ? a.in[3] : a.in[3] + (size_t)DM * NQKV);
        const float* wout = (L == 1) ? a.in[10] : (L == 2) ? a.in[21] : (L == 0 ? a.in[5] : a.in[5] + (size_t)DM * DM);
        bf16* wl = (bf16*)(a.ws + WS_W + (size_t)L * W_LAYER);
        if (r < I_IN) { const int kb = r / 96, nb = r % 96; transpose_item(win, DM, NQKV, a.in[1] + L * DM, wl + W_IN / 2, 32 * nb, scr, 64 * kb, 32 * nb, lane); continue; }
        r -= I_IN;
        if (r < I_OUT) { const int kb = r / 32, nb = r % 32; transpose_item(wout, DM, DM, nullptr, wl + W_OUT / 2, 32 * nb, scr, 64 * kb, 32 * nb, lane); continue; }
        r -= I_OUT;
        if (r < I_13) { const int kb = r / 176, nb = r % 176, n0 = 32 * nb, half = n0 / FFH, j = n0 % FFH, dst = 256 * (j / 128) + 128 * half + (j % 128);
            transpose_item(a.in[22] + (size_t)L * DM * NW13, DM, NW13, a.in[2] + L * DM, wl + W_13 / 2, dst, scr, 64 * kb, n0, lane); continue; }
        r -= I_13;
        { const int kb = r / 32, nb = r % 32; transpose_item(a.in[23] + (size_t)L * FFH * DM, FFH, DM, nullptr, wl + W_2 / 2, 32 * nb, scr, 64 * kb, 32 * nb, lane); }
    }
    const float* w1 = a.in[14]; const float* b1 = a.in[15]; const float* w2 = a.in[16]; const float* b2 = a.in[17]; const float* fr = a.in[19];
    float* hid = (float*)(a.ws + WS_HID);
    for (int t = gw; t < SEQ; t += ngw) {
        float zv = 0.f;
        if (lane == 0) zv = (float)t / (float)(SEQ - 1);
        else if (lane <= 32) { const int k = (lane - 1) & 15; const float band = 1e-4f + (float)k * ((15.0f - 1e-4f) / 15.0f);
            const float ang = ((6.283185307179586f * (float)t) / (float)SEQ) * band; zv = (lane <= 16) ? cosf(ang) : -sinf(ang); }
        float a1 = b1[lane];
        for (int e = 0; e < 33; ++e) a1 += __shfl(zv, e) * w1[e * 64 + lane];
        const float f = fr[lane];
        const float h1 = sinf(f * a1);
        float a2 = b2[lane];
        for (int i = 0; i < 64; ++i) a2 += __shfl(h1, i) * w2[i * 64 + lane];
        hid[t * 64 + lane] = sinf(f * a2);
    }
}

__device__ __forceinline__ void phase_filters(const Args& a, int gw, int ngw, int lane) {
    const float* hid = (const float*)(a.ws + WS_HID); const float* w3 = a.in[18]; bf16* KF = (bf16*)(a.ws + WS_KF);
    for (int p = gw; p < 2 * DM; p += ngw) {
        const int o = p >> 10, d = p & 1023, cf = o * 2048 + d, cr = cf + 1024;
        const float delta = 4.605170185988091f * (1.0f / 1.5f + (float)d * ((1.0f / 0.3f - 1.0f / 1.5f) / 1023.0f));
        float inv = 0.f;
        bf16* kf = KF + (size_t)p * KF_LEN;
        float wf[64], wr[64];
#pragma unroll
        for (int j = 0; j < 64; ++j) { wf[j] = w3[(size_t)j * 4096 + cf]; wr[j] = w3[(size_t)j * 4096 + cr]; }
#pragma unroll 1
        for (int pass = 0; pass < 2; ++pass) {
            float asum = 0.f;
#pragma unroll 1
            for (int it = 0; it < 32; ++it) {
                const int t = lane + 64 * it; const f32x4* hr = (const f32x4*)(hid + t * 64);
                float af = 0.f, ar = 0.f;
#pragma unroll
                for (int j4 = 0; j4 < 16; ++j4) { const f32x4 h = hr[j4];
                    af += h[0] * wf[4 * j4] + h[1] * wf[4 * j4 + 1] + h[2] * wf[4 * j4 + 2] + h[3] * wf[4 * j4 + 3];
                    ar += h[0] * wr[4 * j4] + h[1] * wr[4 * j4 + 1] + h[2] * wr[4 * j4 + 2] + h[3] * wr[4 * j4 + 3]; }
                const float dec = __expf(-((float)t / (float)(SEQ - 1)) * delta);
                af *= dec; ar *= dec;
                if (pass == 0) asum += (t == 0) ? fabsf(af + ar) : (fabsf(af) + fabsf(ar));
                else { if (t == 0) kf[2048] = f2bf((af + ar) * inv); else { kf[2048 - t] = f2bf(af * inv); kf[2048 + t] = f2bf(ar * inv); } }
            }
            if (pass == 0) inv = 1.0f / wave_sum(asum);
        }
        if (lane < 17) kf[lane == 0 ? 0 : 4095 + lane] = 0;
    }
}

__device__ __forceinline__ void phase_norm0(const float* __restrict__ x, bf16* __restrict__ xn, float* __restrict__ ss, int gw, int ngw, int lane) {
    for (int m = gw; m < MTOK; m += ngw) {
        const f32x4* xr = (const f32x4*)(x + (size_t)m * DM) + lane;
        f32x4 v[4]; float s = 0.f;
#pragma unroll
        for (int j = 0; j < 4; ++j) { v[j] = xr[64 * j]; s += (v[j].x * v[j].x + v[j].y * v[j].y) + (v[j].z * v[j].z + v[j].w * v[j].w); }
        s = wave_sum(s);
        if (lane < 16) ss[(size_t)m * 16 + lane] = (lane == 0) ? s : 0.f;
        unsigned long long* o8 = (unsigned long long*)(xn + (size_t)m * DM) + lane;
#pragma unroll
        for (int j = 0; j < 4; ++j) o8[64 * j] = (unsigned long long)pk2(v[j].x, v[j].y) | ((unsigned long long)pk2(v[j].z, v[j].w) << 32);
    }
}

__device__ __forceinline__ void fill_row_scales(const pg8::StaticOrder& S, const float* ss, LAS float* rst, int tid) {
    for (int idx = tid; idx < 11 * 256; idx += NTHREADS) { pg8::Unit u; if (!S.next(idx >> 8, u)) break; rst[idx] = pg8::row_rscale(ss, u.pm * 256 + (idx & 255)); }
    __syncthreads();
}

__device__ __forceinline__ void phase_shortconv(const bf16* __restrict__ big, const float* __restrict__ cw, bf16* __restrict__ outp, int gtid, int ngt) {
    for (int idx = gtid; idx < MTOK * 128; idx += ngt) {
        const int m = idx >> 7, d0 = (idx & 127) * 8, t = m & (SEQ - 1);
        const bf16* row = big + (size_t)m * NQKV + d0;
        const v4u bv = *(const v4u*)row, c1 = *(const v4u*)(row + DM), u1 = *(const v4u*)(row + 2 * DM);
        v4u c0 = {0u, 0u, 0u, 0u}, u0 = c0, c2 = c0, u2 = c0;
        if (t > 0) { c0 = *(const v4u*)(row - NQKV + DM); u0 = *(const v4u*)(row - NQKV + 2 * DM); }
        if (t < SEQ - 1) { c2 = *(const v4u*)(row + NQKV + DM); u2 = *(const v4u*)(row + NQKV + 2 * DM); }
        const f32x4 wa0 = *(const f32x4*)(cw + d0), wa1 = *(const f32x4*)(cw + d0 + 4), wb0 = *(const f32x4*)(cw + DM + d0), wb1 = *(const f32x4*)(cw + DM + d0 + 4),
                    wc0 = *(const f32x4*)(cw + 2 * DM + d0), wc1 = *(const f32x4*)(cw + 2 * DM + d0 + 4);
        v4u o;
#pragma unroll
        for (int k = 0; k < 4; ++k) {
            const float w0l = (k < 2) ? wa0[2 * k] : wa1[2 * k - 4], w0h = (k < 2) ? wa0[2 * k + 1] : wa1[2 * k - 3];
            const float w1l = (k < 2) ? wb0[2 * k] : wb1[2 * k - 4], w1h = (k < 2) ? wb0[2 * k + 1] : wb1[2 * k - 3];
            const float w2l = (k < 2) ? wc0[2 * k] : wc1[2 * k - 4], w2h = (k < 2) ? wc0[2 * k + 1] : wc1[2 * k - 3];
            const float lo = bflo(bv[k]) * (w0l * (bflo(c0[k]) * bflo(u0[k])) + w1l * (bflo(c1[k]) * bflo(u1[k])) + w2l * (bflo(c2[k]) * bflo(u2[k])));
            const float hi = bfhi(bv[k]) * (w0h * (bfhi(c0[k]) * bfhi(u0[k])) + w1h * (bfhi(c1[k]) * bfhi(u1[k])) + w2h * (bfhi(c2[k]) * bfhi(u2[k])));
            o[k] = pk2(lo, hi);
        }
        *(v4u*)(outp + (size_t)m * DM + d0) = o;
    }
}

__device__ __forceinline__ void norm_frag(const v4u r0, const v4u r1, const LAS float* g, int quad, float extra, bf16x8& f0, bf16x8& f1) {
    float x[16];
#pragma unroll
    for (int k = 0; k < 4; ++k) { x[2 * k] = bflo(r0[k]); x[2 * k + 1] = bfhi(r0[k]); x[8 + 2 * k] = bflo(r1[k]); x[9 + 2 * k] = bfhi(r1[k]); }
    float ss = 0.f;
#pragma unroll
    for (int k = 0; k < 16; ++k) ss += x[k] * x[k];
    ss += __shfl_xor(ss, 16); ss += __shfl_xor(ss, 32);
    const float r = rsqrtf(ss * (1.0f / 64.0f) + RMS_EPS) * extra;
    v4u o0, o1;
#pragma unroll
    for (int k = 0; k < 4; ++k) { o0[k] = pk2c(x[2 * k] * r * g[8 * quad + 2 * k], x[2 * k + 1] * r * g[8 * quad + 2 * k + 1]);
        o1[k] = pk2c(x[8 + 2 * k] * r * g[32 + 8 * quad + 2 * k], x[9 + 2 * k] * r * g[32 + 8 * quad + 2 * k + 1]); }
    f0 = __builtin_bit_cast(bf16x8, o0); f1 = __builtin_bit_cast(bf16x8, o1);
}

constexpr int AR_SLOT = 16640, AR_V = 8192, AR_RK = 16384, AR_NSLOT = 9, AR_RPB = AR_NSLOT * AR_SLOT, AR_G = AR_RPB + 1920;
__device__ __forceinline__ int ar_off(int k, int c) { return k * 128 + ((c ^ (k & 7)) << 4); }

constexpr int A3_NSLOT = 8, A3_RPB = A3_NSLOT * AR_SLOT, A3_G = A3_RPB + 1920, A3_CMB = A3_G + 256, A3_CMB_BYTES = 4608;
static_assert(A3_CMB + 4 * A3_CMB_BYTES <= MISC_OFF, "attention LDS map");
__device__ __forceinline__ void phase_natten3(const bf16* qkv, const float* qg, const float* kg, const float* rpb, const float* kss, bf16* outp, LAS unsigned char* lds, int vcu, int G, int wave, int lane, int tid) {
    LAS float* rpb_l = (LAS float*)(lds + A3_RPB); LAS float* g_l = (LAS float*)(lds + A3_G);
    const int n = lane & 15, quad = lane >> 4, qq = (lane >> 2) & 3, p = lane & 3;
    const int cb = wave & 3, kh = wave >> 2;
    LAS unsigned char* cmb = lds + A3_CMB + cb * A3_CMB_BYTES;
    const int lk = (tid >> 3) & 63, lc = tid & 7;
    for (int unit = vcu; unit < NB * 16; unit += G) {
        const int b = unit >> 4, h = unit & 15;
        const bf16* kvbase = qkv + (size_t)b * SEQ * NQKV + DM + h * 64 + lc * 8 + (size_t)lk * NQKV;
        const float* ksbase = kss + (size_t)(2 * h) * MTOK + (size_t)b * SEQ + tid;
        __syncthreads();
        for (int i = tid; i < 15 * 31; i += NTHREADS) rpb_l[i] = rpb[h * (15 * 31) + i];
        if (tid < 64) g_l[tid] = qg[tid] * kg[tid];
        {   v4u rk_[8], rv_[8]; float rs_[8];
#pragma unroll
            for (int rho = 0; rho < 8; ++rho) { const bf16* pp = kvbase + (size_t)rho * 64 * NQKV; rk_[rho] = *(const v4u*)pp; rv_[rho] = *(const v4u*)(pp + DM);
                rs_[rho] = (tid < 64) ? ksbase[rho * 64] + ksbase[MTOK + rho * 64] : 0.f; }
#pragma unroll
            for (int rho = 0; rho < 8; ++rho) { LAS unsigned char* slot = lds + rho * AR_SLOT; *(LAS v4u*)(slot + ar_off(lk, lc)) = rk_[rho]; *(LAS v4u*)(slot + AR_V + ar_off(lk, lc)) = rv_[rho];
                if (tid < 64) *(LAS float*)(slot + AR_RK + 4 * tid) = __builtin_amdgcn_rsqf(rs_[rho] * (1.0f / 64.0f) + RMS_EPS); } }
        int start = cb * 16 - 8; start = start < 0 ? 0 : (start > 32 ? 32 : start);
        const int qc = cb * 16 + n; int cs = qc - 8; cs = cs < 0 ? 0 : (cs > 48 ? 48 : cs);
        const bf16* qbase = qkv + (size_t)(b * SEQ + cb * 16 + n) * NQKV + h * 64 + 8 * quad;
        v4u qr0 = *(const v4u*)qbase, qr1 = *(const v4u*)(qbase + 32);
        __syncthreads();
#pragma unroll 1
        for (int r = 0; r < 32; ++r) {
            int rs = r - 4; rs = rs < 0 ? 0 : (rs > 24 ? 24 : rs);
            int rsn = r - 3; rsn = rsn < 0 ? 0 : (rsn > 24 ? 24 : rsn);
            const bool slide = (r < 31) && (rsn != rs);
            v4u nk = {0u, 0u, 0u, 0u}, nv = nk; float nss = 0.f;
            if (slide) { const bf16* pp = kvbase + (size_t)(rs + 8) * 64 * NQKV; nk = *(const v4u*)pp; nv = *(const v4u*)(pp + DM); if (tid < 64) nss = ksbase[(rs + 8) * 64] + ksbase[MTOK + (rs + 8) * 64]; }
            bf16x8 qf0, qf1;
            norm_frag(qr0, qr1, g_l, quad, 0.125f, qf0, qf1);
            if (r < 31) { const bf16* qp = qbase + (size_t)(r + 1) * 64 * NQKV; qr0 = *(const v4u*)qp; qr1 = *(const v4u*)(qp + 32); }
            f32x4 st[4][2];
#pragma unroll
            for (int jj = 0; jj < 4; ++jj) { const LAS unsigned char* slot = lds + ((rs + 4 * kh + jj) & 7) * AR_SLOT;
#pragma unroll
                for (int kt = 0; kt < 2; ++kt) { const int k = start + 16 * kt + n;
                    const bf16x8 kf0 = *(const LAS bf16x8*)(slot + ar_off(k, quad)), kf1 = *(const LAS bf16x8*)(slot + ar_off(k, quad + 4));
                    f32x4 sacc = {0.f, 0.f, 0.f, 0.f};
                    sacc = __builtin_amdgcn_mfma_f32_16x16x32_bf16(kf0, qf0, sacc, 0, 0, 0);
                    sacc = __builtin_amdgcn_mfma_f32_16x16x32_bf16(kf1, qf1, sacc, 0, 0, 0);
                    st[jj][kt] = sacc; } }
            float mx = -3.0e38f;
#pragma unroll
            for (int jj = 0; jj < 4; ++jj) { const int dr = rs + 4 * kh + jj - r + 7; const LAS unsigned char* slot = lds + ((rs + 4 * kh + jj) & 7) * AR_SLOT;
#pragma unroll
                for (int kt = 0; kt < 2; ++kt) { const f32x4 rk = *(const LAS f32x4*)(slot + AR_RK + 4 * (start + 16 * kt + 4 * quad));
#pragma unroll
                    for (int i = 0; i < 4; ++i) { const int kc = start + 16 * kt + 4 * quad + i; int dc = kc - qc + 15; dc = dc < 0 ? 0 : (dc > 30 ? 30 : dc);
                        const bool valid = (kc >= cs) && (kc < cs + 16);
                        const float v = valid ? st[jj][kt][i] * rk[i] + rpb_l[dr * 31 + dc] : -3.0e38f;
                        st[jj][kt][i] = v; mx = fmaxf(mx, v); } } }
            mx = fmaxf(mx, __shfl_xor(mx, 16)); mx = fmaxf(mx, __shfl_xor(mx, 32));
            float sum = 0.f;
#pragma unroll
            for (int jj = 0; jj < 4; ++jj)
#pragma unroll
                for (int kt = 0; kt < 2; ++kt)
#pragma unroll
                    for (int i = 0; i < 4; ++i) { const float e = __expf(st[jj][kt][i] - mx); st[jj][kt][i] = e; sum += e; }
            sum += __shfl_xor(sum, 16); sum += __shfl_xor(sum, 32);
            f32x4 oacc[4];
#pragma unroll
            for (int dt = 0; dt < 4; ++dt) oacc[dt] = (f32x4){0.f, 0.f, 0.f, 0.f};
            const int kl = start + 4 * quad + qq;
            v4i16_t lo[4][4], hi[4][4];
#pragma unroll
            for (int jj = 0; jj < 4; ++jj) {
                const unsigned vs = (unsigned)(unsigned long long)(lds + ((rs + 4 * kh + jj) & 7) * AR_SLOT + AR_V) + 8 * (p & 1);
#pragma unroll
                for (int dt = 0; dt < 4; ++dt) { const unsigned a_lo = vs + ar_off(kl, 2 * dt + (p >> 1)), a_hi = vs + ar_off(kl + 16, 2 * dt + (p >> 1));
                    asm volatile("ds_read_b64_tr_b16 %0, %1" : "=v"(lo[jj][dt]) : "v"(a_lo) : "memory");
                    asm volatile("ds_read_b64_tr_b16 %0, %1" : "=v"(hi[jj][dt]) : "v"(a_hi) : "memory"); } }
            bf16x8 pf[4];
#pragma unroll
            for (int jj = 0; jj < 4; ++jj) { const f32x4 s0 = st[jj][0], s1 = st[jj][1];
                v4u pw; pw.x = pk2c(s0[0], s0[1]); pw.y = pk2c(s0[2], s0[3]); pw.z = pk2c(s1[0], s1[1]); pw.w = pk2c(s1[2], s1[3]); pf[jj] = __builtin_bit_cast(bf16x8, pw); }
            asm volatile("s_waitcnt lgkmcnt(0)" ::: "memory"); __builtin_amdgcn_sched_barrier(0);
#pragma unroll
            for (int jj = 0; jj < 4; ++jj)
#pragma unroll
                for (int dt = 0; dt < 4; ++dt) {
                    const bf16x8 vf = (bf16x8){lo[jj][dt][0], lo[jj][dt][1], lo[jj][dt][2], lo[jj][dt][3], hi[jj][dt][0], hi[jj][dt][1], hi[jj][dt][2], hi[jj][dt][3]};
                    oacc[dt] = __builtin_amdgcn_mfma_f32_16x16x32_bf16(vf, pf[jj], oacc[dt], 0, 0, 0);
                }
            if (kh == 1) {
#pragma unroll
                for (int dt = 0; dt < 4; ++dt) *(LAS f32x4*)(cmb + (dt * 64 + lane) * 16) = oacc[dt];
                *(LAS float*)(cmb + 4096 + lane * 8) = mx; *(LAS float*)(cmb + 4096 + lane * 8 + 4) = sum;
            }
            __syncthreads();
            if (kh == 0) {
                const float mb = *(const LAS float*)(cmb + 4096 + lane * 8), lb = *(const LAS float*)(cmb + 4096 + lane * 8 + 4);
                const float M = fmaxf(mx, mb), fa = __expf(mx - M), fb = __expf(mb - M), inv = 1.0f / (sum * fa + lb * fb), wa = fa * inv, wb = fb * inv;
                bf16* op = outp + (size_t)(b * SEQ + r * 64 + cb * 16 + n) * DM + h * 64 + 4 * quad;
#pragma unroll
                for (int dt = 0; dt < 4; ++dt) { const f32x4 ob = *(const LAS f32x4*)(cmb + (dt * 64 + lane) * 16); const f32x4 o = oacc[dt] * wa + ob * wb;
                    v2u w; w.x = pk2c(o[0], o[1]); w.y = pk2c(o[2], o[3]); *(v2u*)(op + 16 * dt) = w; }
            }
            if (slide) { LAS unsigned char* slot = lds + ((rs + 8) & 7) * AR_SLOT; *(LAS v4u*)(slot + ar_off(lk, lc)) = nk; *(LAS v4u*)(slot + AR_V + ar_off(lk, lc)) = nv;
                if (tid < 64) *(LAS float*)(slot + AR_RK + 4 * tid) = __builtin_amdgcn_rsqf(nss * (1.0f / 64.0f) + RMS_EPS); }
            __syncthreads();
        }
    }
}

constexpr int CT_STRIDE = 144, CT_BYTES = 66 * CT_STRIDE;
__device__ __forceinline__ void hyena_pre_fetch(const bf16* big, int id, int lane, v4u (&v)[9]) {
    const int ct = id & 31, tt = id >> 5, b = tt >> 5, t0 = (tt & 31) * 64, c0 = ct * 64;
#pragma unroll
    for (int ps = 0; ps < 9; ++ps) { const int rr = ps * 8 + (lane >> 3), part = lane & 7, t = t0 - 1 + rr;
        v[ps] = (v4u){0u, 0u, 0u, 0u};
        if (rr < 66 && t >= 0 && t < SEQ) v[ps] = *(const v4u*)(big + (size_t)(b * SEQ + t) * NQKV + c0 + part * 8); }
}
__device__ __forceinline__ void phase_hyena_pre(const bf16* big, const float* sw, const float* sb, bf16* VTp, bf16* X1Tp, LAS unsigned char* lds, int gw, int ngw, int wave, int lane) {
    LAS unsigned char* scr = lds + wave * 16384;
    v4u vin[9];
    if (gw < 512 * 32) hyena_pre_fetch(big, gw, lane, vin);
    for (int id = gw; id < 512 * 32; id += ngw) {
        const int ct = id & 31, tt = id >> 5, b = tt >> 5, t0 = (tt & 31) * 64, c0 = ct * 64;
#pragma unroll
        for (int ps = 0; ps < 9; ++ps) { const int rr = ps * 8 + (lane >> 3), part = lane & 7; if (rr < 66) *(LAS v4u*)(scr + rr * CT_STRIDE + part * 16) = vin[ps]; }
        if (id + ngw < 512 * 32) hyena_pre_fetch(big, id + ngw, lane, vin);
        LDS_WAIT();
        const int cg = c0 + lane; const float w0 = sw[cg], w1 = sw[NQKV + cg], w2 = sw[2 * NQKV + cg], bias = sb[cg];
        const LAS unsigned short* col = (const LAS unsigned short*)(scr + 2 * lane);
        float pa = bf2f(col[0]), pb = bf2f(col[CT_STRIDE / 2]);
        v4u o[8];
#pragma unroll
        for (int g8 = 0; g8 < 8; ++g8) { float y[8];
#pragma unroll
            for (int k = 0; k < 8; ++k) { const float pc = bf2f(col[(g8 * 8 + k + 2) * (CT_STRIDE / 2)]); y[k] = w0 * pa + w1 * pb + w2 * pc + bias; pa = pb; pb = pc; }
            o[g8].x = pk2(y[0], y[1]); o[g8].y = pk2(y[2], y[3]); o[g8].z = pk2(y[4], y[5]); o[g8].w = pk2(y[6], y[7]); }
        LDS_WAIT();
#pragma unroll
        for (int g8 = 0; g8 < 8; ++g8) *(LAS v4u*)(scr + lane * CT_STRIDE + g8 * 16) = o[g8];
        LDS_WAIT();
#pragma unroll
        for (int ps = 0; ps < 8; ++ps) { const int cl = ps * 8 + (lane >> 3), part = lane & 7, cc = c0 + cl;
            const v4u v = *(const LAS v4u*)(scr + cl * CT_STRIDE + part * 16);
            bf16* op = (cc < DM ? VTp + (size_t)cc * NB * SEQ : X1Tp + (size_t)(cc - DM) * NB * SEQ) + (size_t)b * SEQ + t0 + part * 8;
            *(v4u*)op = v; }
        LDS_WAIT();
    }
}
constexpr int U_STRIDE = 4112, U_BYTES = 16 * U_STRIDE, CP_OFF = U_BYTES, CP_STRIDE = 8224;
struct HyFilt { v4u a, b; };
__device__ __forceinline__ HyFilt hyena_fetch_filter(const bf16* kf, int tid) { HyFilt f; const v4u* src = (const v4u*)kf; f.a = src[tid]; f.b = (tid < 2) ? src[512 + tid] : (v4u){0u, 0u, 0u, 0u}; return f; }
__device__ __forceinline__ void hyena_put_filter(LAS unsigned char* lds, const HyFilt& f, int tid) {
    *(LAS v4u*)(lds + CP_OFF + 16 * tid) = f.a;
    if (tid < 2) *(LAS v4u*)(lds + CP_OFF + 16 * (512 + tid)) = f.b;
    __syncthreads();
    const v4u lo = *(LAS v4u*)(lds + CP_OFF + 16 * tid), hi = *(LAS v4u*)(lds + CP_OFF + 16 * tid + 16);
    const unsigned s[8] = {lo.x, lo.y, lo.z, lo.w, hi.x, hi.y, hi.z, hi.w};
#pragma unroll
    for (int r = 1; r < 8; ++r) { v4u o;
#pragma unroll
        for (int w = 0; w < 4; ++w) { const int q = w + r / 2; o[w] = (r & 1) ? ((s[q] >> 16) | (s[q + 1] << 16)) : s[q]; }
        *(LAS v4u*)(lds + CP_OFF + r * CP_STRIDE + 16 * tid) = o; }
    __syncthreads();
}
__device__ __forceinline__ void hyena_conv(LAS unsigned char* lds, f32x4 (&acc)[16], unsigned toep0, unsigned uaddr0) {
#pragma unroll
    for (int ti = 0; ti < 16; ++ti) acc[ti] = (f32x4){0.f, 0.f, 0.f, 0.f};
#pragma unroll 1
    for (int k4 = 0; k4 < 16; ++k4) {
        bf16x8 uf[4];
#pragma unroll
        for (int s = 0; s < 4; ++s) uf[s] = *(const LAS bf16x8*)(lds + uaddr0 + 256 * k4 + 64 * s);
#pragma unroll
        for (int x = 0; x < 22; ++x) {
            const bf16x8 tf = *(const LAS bf16x8*)(lds + toep0 + 256 * k4 + 32 * x);
#pragma unroll
            for (int s = 0; s < 4; ++s) { const int ti = 15 + 2 * s - x; if (ti >= 0 && ti < 16) acc[ti] = __builtin_amdgcn_mfma_f32_16x16x32_bf16(tf, uf[s], acc[ti], 0, 0, 0); }
        }
    }
}
__device__ __forceinline__ void phase_hyena(bf16* VT, const bf16* X1T, const bf16* KF, const float* skip, LAS unsigned char* lds, int vcu, int G, int wave, int lane, int tid) {
    const int n = lane & 15, quad = lane >> 4, rho = (-n) & 7;
    const int base = 2048 - 256 * wave - n + 8 * quad;
    const unsigned toep0 = CP_OFF + rho * CP_STRIDE + 16 * ((base >> 3) - 30);
    const unsigned uaddr0 = n * U_STRIDE + 16 * quad;
    v4u ur[8]; HyFilt f0;
    if (vcu < DM) { const v4u* src = (const v4u*)(VT + (size_t)vcu * NB * SEQ);
#pragma unroll
        for (int k = 0; k < 8; ++k) ur[k] = src[tid + 512 * k];
        f0 = hyena_fetch_filter(KF + (size_t)vcu * KF_LEN, tid); }
    for (int d = vcu; d < DM; d += G) {
        bf16* vrow = VT + (size_t)d * NB * SEQ;
#pragma unroll
        for (int k = 0; k < 8; ++k) { const int c = tid + 512 * k; *(LAS v4u*)(lds + (c >> 8) * U_STRIDE + 16 * (c & 255)) = ur[k]; }
        hyena_put_filter(lds, f0, tid);
        const HyFilt f1 = hyena_fetch_filter(KF + (size_t)(DM + d) * KF_LEN, tid);
        v2u xx[16];
#pragma unroll
        for (int ti = 0; ti < 16; ++ti) xx[ti] = *(const v2u*)(X1T + ((size_t)d * NB + n) * SEQ + 256 * wave + 16 * ti + 4 * quad);
        f32x4 acc[16];
        hyena_conv(lds, acc, toep0, uaddr0);
        const float sk0 = skip[d], sk1 = skip[DM + d];
        v2u z[16];
#pragma unroll
        for (int ti = 0; ti < 16; ++ti) { const int t = 256 * wave + 16 * ti + 4 * quad;
            const v2u vv = *(const LAS v2u*)(lds + n * U_STRIDE + 2 * t);
            const float z0 = bflo(xx[ti].x) * (acc[ti][0] + sk0 * bflo(vv.x)), z1 = bfhi(xx[ti].x) * (acc[ti][1] + sk0 * bfhi(vv.x));
            const float z2 = bflo(xx[ti].y) * (acc[ti][2] + sk0 * bflo(vv.y)), z3 = bfhi(xx[ti].y) * (acc[ti][3] + sk0 * bfhi(vv.y));
            z[ti].x = pk2(z0, z1); z[ti].y = pk2(z2, z3); }
        __syncthreads();
#pragma unroll
        for (int ti = 0; ti < 16; ++ti) { const int t = 256 * wave + 16 * ti + 4 * quad; *(LAS v2u*)(lds + n * U_STRIDE + 2 * t) = z[ti]; }
        hyena_put_filter(lds, f1, tid);
        if (d + G < DM) { const v4u* src = (const v4u*)(VT + (size_t)(d + G) * NB * SEQ);
#pragma unroll
            for (int k = 0; k < 8; ++k) ur[k] = src[tid + 512 * k];
            f0 = hyena_fetch_filter(KF + (size_t)(d + G) * KF_LEN, tid); }
        hyena_conv(lds, acc, toep0, uaddr0);
        __syncthreads();
#pragma unroll
        for (int ti = 0; ti < 16; ++ti) { const int t = 256 * wave + 16 * ti + 4 * quad;
            const float o0 = acc[ti][0] + sk1 * bflo(z[ti].x), o1 = acc[ti][1] + sk1 * bfhi(z[ti].x), o2 = acc[ti][2] + sk1 * bflo(z[ti].y), o3 = acc[ti][3] + sk1 * bfhi(z[ti].y);
            v2u w; w.x = pk2(o0, o1); w.y = pk2(o2, o3); *(LAS v2u*)(lds + n * U_STRIDE + 2 * t) = w; }
        __syncthreads();
        {   v4u* dst = (v4u*)vrow;
#pragma unroll
            for (int k = 0; k < 8; ++k) { const int c = tid + 512 * k; dst[c] = *(const LAS v4u*)(lds + (c >> 8) * U_STRIDE + 16 * (c & 255)); } }
        __syncthreads();
    }
}
constexpr int C5_STRIDE = 132;
__device__ __forceinline__ void phase_hyena_post(const bf16* big, const float* sw, const float* sb, const bf16* ZT, bf16* outp, LAS unsigned char* lds, int gw, int ngw, int wave, int lane) {
    LAS unsigned char* scr = lds + wave * 16384;
    for (int id = gw; id < 512 * 16; id += ngw) {
        const int dtile = id & 15, tt = id >> 4, b = tt >> 5, t0 = (tt & 31) * 64, d0 = dtile * 64;
        const int cg = 2 * DM + d0 + lane; const float w0 = sw[cg], w1 = sw[NQKV + cg], w2 = sw[2 * NQKV + cg], bias = sb[cg];
        const bf16* pp = big + (size_t)(b * SEQ + t0) * NQKV + cg;
        unsigned short pr[66];
#pragma unroll
        for (int k = 0; k < 66; ++k) { const int t = t0 - 1 + k; pr[k] = (t >= 0 && t < SEQ) ? pp[(long)(k - 1) * NQKV] : (unsigned short)0; }
        v4u zv[8];
#pragma unroll
        for (int ps = 0; ps < 8; ++ps) { const int dd = ps * 8 + (lane >> 3), part = lane & 7; zv[ps] = *(const v4u*)(ZT + ((size_t)(d0 + dd) * NB + b) * SEQ + t0 + part * 8); }
#pragma unroll
        for (int ps = 0; ps < 8; ++ps) { const int dd = ps * 8 + (lane >> 3), part = lane & 7;
            LAS unsigned* w = (LAS unsigned*)(scr + dd * C5_STRIDE + part * 16); w[0] = zv[ps].x; w[1] = zv[ps].y; w[2] = zv[ps].z; w[3] = zv[ps].w; }
        LDS_WAIT();
        const LAS unsigned short* zr = (const LAS unsigned short*)(scr + lane * C5_STRIDE);
        bf16* op = outp + (size_t)(b * SEQ + t0) * DM + d0 + lane;
#pragma unroll
        for (int k = 0; k < 64; ++k) { const float y = (w0 * bf2f(pr[k]) + w1 * bf2f(pr[k + 1]) + w2 * bf2f(pr[k + 2]) + bias) * bf2f(zr[k]); op[(size_t)k * DM] = f2bf(y); }
        LDS_WAIT();
    }
}

__global__ void __launch_bounds__(NTHREADS, 2) mk_fwd(Args a) {
    extern __shared__ __attribute__((aligned(16))) unsigned char lds_raw[];
    LAS unsigned char* lds = (LAS unsigned char*)lds_raw;
    cg::grid_group grid = cg::this_grid();
    const int tid = threadIdx.x, lane = tid & 63, wave = __builtin_amdgcn_readfirstlane(tid >> 6);
    const int G = gridDim.x, bx = blockIdx.x;
    const int vcu = (G % 8 == 0) ? (bx % 8) * (G / 8) + bx / 8 : bx;
    const int gw = vcu * NWAVES + wave, ngw = G * NWAVES;
    unsigned char* ws = a.ws;
    float* SS = (float*)(ws + WS_SS); bf16* XN = (bf16*)(ws + WS_XN); bf16* VT = (bf16*)(ws + WS_VT); bf16* MIXO = (bf16*)(ws + WS_MIXO); bf16* BIG = (bf16*)(ws + WS_BIG);
    const int lo = a.ph_lo, hi = a.ph_hi; int ph = 0;
    volatile LAS unsigned* MISC = (volatile LAS unsigned*)(lds + MISC_OFF);
    if (tid < 16) MISC[tid] = 0u;
    __syncthreads();
    XcdBarrier xbar = xcd_barrier_post((unsigned*)(ws + WS_BAR), MISC);
#define PH_BEGIN if (ph >= lo && ph < hi) {
#define PH_END   if (ph + 1 < hi) { if (ph == 0) grid.sync(); else xcd_barrier(xbar); } } ++ph;

    PH_BEGIN phase_prologue(a, lds, gw, ngw, wave, lane);
    PH_END
    PH_BEGIN phase_filters(a, gw, ngw, lane); phase_norm0(a.in[0], XN, SS, gw, ngw, lane); PH_END

    { constexpr int L = 0;

        constexpr int kind = L % 3;
        const bf16* wl = (const bf16*)(ws + WS_W + (size_t)L * W_LAYER);
        PH_BEGIN { pg8::Gemm g{XN, wl + W_IN / 2, MTOK, NQKV, DM}; pg8::StaticOrder S; S.init(MTOK, NQKV, G, bx); pg8::EpiBf16PT<(kind == 1)> E{BIG, NQKV, (const LAS float*)(lds + RST_OFF), (float*)(ws + WS_KSS), MTOK}; fill_row_scales(S, SS, (LAS float*)(lds + RST_OFF), tid);
                   pg8::gemm_phase<pg8::EpiBf16PT<(kind == 1)>, pg8::StaticOrder, true, true>(lds, g, S, E);
 } PH_END
        if (kind == 0) {
            PH_BEGIN phase_shortconv(BIG, a.in[4] + (size_t)(L / 3) * 3 * DM, MIXO, vcu * NTHREADS + tid, G * NTHREADS);
            PH_END
        } else if (kind == 1) {
            PH_BEGIN
            phase_natten3(BIG, a.in[7], a.in[8], a.in[9], (const float*)(ws + WS_KSS), MIXO, lds, vcu, G, wave, lane, tid); PH_END
        } else {
            PH_BEGIN phase_hyena_pre(BIG, a.in[12], a.in[13], VT, MIXO, lds, gw, ngw, wave, lane);
            PH_END
            PH_BEGIN
            phase_hyena(VT, MIXO, (const bf16*)(ws + WS_KF), a.in[20], lds, vcu, G, wave, lane, tid); PH_END
            PH_BEGIN phase_hyena_post(BIG, a.in[12], a.in[13], VT, MIXO, lds, gw, ngw, wave, lane);
            PH_END
        }
        PH_BEGIN { pg8::Gemm g{MIXO, wl + W_OUT / 2, MTOK, DM, DM}; pg8::StaticOrder S; S.init(MTOK, DM, G, bx); pg8::EpiResNorm E{a.out, XN, SS, DM};
                   pg8::gemm_phase<pg8::EpiResNorm, pg8::StaticOrder, true, true>(lds, g, S, E); } PH_END
        PH_BEGIN { pg8::Gemm g{XN, wl + W_13 / 2, MTOK, NW13, DM}; pg8::StaticOrder S; S.init(MTOK, NW13, G, bx); pg8::EpiSwiGLU E{BIG, FFH, (const LAS float*)(lds + RST_OFF)}; fill_row_scales(S, SS, (LAS float*)(lds + RST_OFF), tid);
                   pg8::gemm_phase<pg8::EpiSwiGLU, pg8::StaticOrder, true, true>(lds, g, S, E);
 } PH_END
        PH_BEGIN { pg8::Gemm g{BIG, wl + W_2 / 2, MTOK, DM, FFH}; pg8::StaticOrder S; S.init(MTOK, DM, G, bx); pg8::EpiResNormT<(L == NLAYER - 1)> E{a.out, XN, SS, DM};
                   pg8::gemm_phase<pg8::EpiResNormT<(L == NLAYER - 1)>, pg8::StaticOrder, true, true>(lds, g, S, E); } PH_END
        }
    { constexpr int L = 1;

        constexpr int kind = L % 3;
        const bf16* wl = (const bf16*)(ws + WS_W + (size_t)L * W_LAYER);
        PH_BEGIN { pg8::Gemm g{XN, wl + W_IN / 2, MTOK, NQKV, DM}; pg8::StaticOrder S; S.init(MTOK, NQKV, G, bx); pg8::EpiBf16PT<(kind == 1)> E{BIG, NQKV, (const LAS float*)(lds + RST_OFF), (float*)(ws + WS_KSS), MTOK}; fill_row_scales(S, SS, (LAS float*)(lds + RST_OFF), tid);
                   pg8::gemm_phase<pg8::EpiBf16PT<(kind == 1)>, pg8::StaticOrder, true, true>(lds, g, S, E);
 } PH_END
        if (kind == 0) {
            PH_BEGIN phase_shortconv(BIG, a.in[4] + (size_t)(L / 3) * 3 * DM, MIXO, vcu * NTHREADS + tid, G * NTHREADS);
            PH_END
        } else if (kind == 1) {
            PH_BEGIN
            phase_natten3(BIG, a.in[7], a.in[8], a.in[9], (const float*)(ws + WS_KSS), MIXO, lds, vcu, G, wave, lane, tid); PH_END
        } else {
            PH_BEGIN phase_hyena_pre(BIG, a.in[12], a.in[13], VT, MIXO, lds, gw, ngw, wave, lane);
            PH_END
            PH_BEGIN
            phase_hyena(VT, MIXO, (const bf16*)(ws + WS_KF), a.in[20], lds, vcu, G, wave, lane, tid); PH_END
            PH_BEGIN phase_hyena_post(BIG, a.in[12], a.in[13], VT, MIXO, lds, gw, ngw, wave, lane);
            PH_END
        }
        PH_BEGIN { pg8::Gemm g{MIXO, wl + W_OUT / 2, MTOK, DM, DM}; pg8::StaticOrder S; S.init(MTOK, DM, G, bx); pg8::EpiResNorm E{a.out, XN, SS, DM};
                   pg8::gemm_phase<pg8::EpiResNorm, pg8::StaticOrder, true, true>(lds, g, S, E); } PH_END
        PH_BEGIN { pg8::Gemm g{XN, wl + W_13 / 2, MTOK, NW13, DM}; pg8::StaticOrder S; S.init(MTOK, NW13, G, bx); pg8::EpiSwiGLU E{BIG, FFH, (const LAS float*)(lds + RST_OFF)}; fill_row_scales(S, SS, (LAS float*)(lds + RST_OFF), tid);
                   pg8::gemm_phase<pg8::EpiSwiGLU, pg8::StaticOrder, true, true>(lds, g, S, E);
 } PH_END
        PH_BEGIN { pg8::Gemm g{BIG, wl + W_2 / 2, MTOK, DM, FFH}; pg8::StaticOrder S; S.init(MTOK, DM, G, bx); pg8::EpiResNormT<(L == NLAYER - 1)> E{a.out, XN, SS, DM};
                   pg8::gemm_phase<pg8::EpiResNormT<(L == NLAYER - 1)>, pg8::StaticOrder, true, true>(lds, g, S, E); } PH_END
        }
    { constexpr int L = 2;

        constexpr int kind = L % 3;
        const bf16* wl = (const bf16*)(ws + WS_W + (size_t)L * W_LAYER);
        PH_BEGIN { pg8::Gemm g{XN, wl + W_IN / 2, MTOK, NQKV, DM}; pg8::StaticOrder S; S.init(MTOK, NQKV, G, bx); pg8::EpiBf16PT<(kind == 1)> E{BIG, NQKV, (const LAS float*)(lds + RST_OFF), (float*)(ws + WS_KSS), MTOK}; fill_row_scales(S, SS, (LAS float*)(lds + RST_OFF), tid);
                   pg8::gemm_phase<pg8::EpiBf16PT<(kind == 1)>, pg8::StaticOrder, true, true>(lds, g, S, E);
 } PH_END
        if (kind == 0) {
            PH_BEGIN phase_shortconv(BIG, a.in[4] + (size_t)(L / 3) * 3 * DM, MIXO, vcu * NTHREADS + tid, G * NTHREADS);
            PH_END
        } else if (kind == 1) {
            PH_BEGIN
            phase_natten3(BIG, a.in[7], a.in[8], a.in[9], (const float*)(ws + WS_KSS), MIXO, lds, vcu, G, wave, lane, tid); PH_END
        } else {
            PH_BEGIN phase_hyena_pre(BIG, a.in[12], a.in[13], VT, MIXO, lds, gw, ngw, wave, lane);
            PH_END
            PH_BEGIN
            phase_hyena(VT, MIXO, (const bf16*)(ws + WS_KF), a.in[20], lds, vcu, G, wave, lane, tid); PH_END
            PH_BEGIN phase_hyena_post(BIG, a.in[12], a.in[13], VT, MIXO, lds, gw, ngw, wave, lane);
            PH_END
        }
        PH_BEGIN { pg8::Gemm g{MIXO, wl + W_OUT / 2, MTOK, DM, DM}; pg8::StaticOrder S; S.init(MTOK, DM, G, bx); pg8::EpiResNorm E{a.out, XN, SS, DM};
                   pg8::gemm_phase<pg8::EpiResNorm, pg8::StaticOrder, true, true>(lds, g, S, E); } PH_END
        PH_BEGIN { pg8::Gemm g{XN, wl + W_13 / 2, MTOK, NW13, DM}; pg8::StaticOrder S; S.init(MTOK, NW13, G, bx); pg8::EpiSwiGLU E{BIG, FFH, (const LAS float*)(lds + RST_OFF)}; fill_row_scales(S, SS, (LAS float*)(lds + RST_OFF), tid);
                   pg8::gemm_phase<pg8::EpiSwiGLU, pg8::StaticOrder, true, true>(lds, g, S, E);
 } PH_END
        PH_BEGIN { pg8::Gemm g{BIG, wl + W_2 / 2, MTOK, DM, FFH}; pg8::StaticOrder S; S.init(MTOK, DM, G, bx); pg8::EpiResNormT<(L == NLAYER - 1)> E{a.out, XN, SS, DM};
                   pg8::gemm_phase<pg8::EpiResNormT<(L == NLAYER - 1)>, pg8::StaticOrder, true, true>(lds, g, S, E); } PH_END
        }
    { constexpr int L = 3;

        constexpr int kind = L % 3;
        const bf16* wl = (const bf16*)(ws + WS_W + (size_t)L * W_LAYER);
        PH_BEGIN { pg8::Gemm g{XN, wl + W_IN / 2, MTOK, NQKV, DM}; pg8::StaticOrder S; S.init(MTOK, NQKV, G, bx); pg8::EpiBf16PT<(kind == 1)> E{BIG, NQKV, (const LAS float*)(lds + RST_OFF), (float*)(ws + WS_KSS), MTOK}; fill_row_scales(S, SS, (LAS float*)(lds + RST_OFF), tid);
                   pg8::gemm_phase<pg8::EpiBf16PT<(kind == 1)>, pg8::StaticOrder, true, true>(lds, g, S, E);
 } PH_END
        if (kind == 0) {
            PH_BEGIN phase_shortconv(BIG, a.in[4] + (size_t)(L / 3) * 3 * DM, MIXO, vcu * NTHREADS + tid, G * NTHREADS);
            PH_END
        } else if (kind == 1) {
            PH_BEGIN
            phase_natten3(BIG, a.in[7], a.in[8], a.in[9], (const float*)(ws + WS_KSS), MIXO, lds, vcu, G, wave, lane, tid); PH_END
        } else {
            PH_BEGIN phase_hyena_pre(BIG, a.in[12], a.in[13], VT, MIXO, lds, gw, ngw, wave, lane);
            PH_END
            PH_BEGIN
            phase_hyena(VT, MIXO, (const bf16*)(ws + WS_KF), a.in[20], lds, vcu, G, wave, lane, tid); PH_END
            PH_BEGIN phase_hyena_post(BIG, a.in[12], a.in[13], VT, MIXO, lds, gw, ngw, wave, lane);
            PH_END
        }
        PH_BEGIN { pg8::Gemm g{MIXO, wl + W_OUT / 2, MTOK, DM, DM}; pg8::StaticOrder S; S.init(MTOK, DM, G, bx); pg8::EpiResNorm E{a.out, XN, SS, DM};
                   pg8::gemm_phase<pg8::EpiResNorm, pg8::StaticOrder, true, true>(lds, g, S, E); } PH_END
        PH_BEGIN { pg8::Gemm g{XN, wl + W_13 / 2, MTOK, NW13, DM}; pg8::StaticOrder S; S.init(MTOK, NW13, G, bx); pg8::EpiSwiGLU E{BIG, FFH, (const LAS float*)(lds + RST_OFF)}; fill_row_scales(S, SS, (LAS float*)(lds + RST_OFF), tid);
                   pg8::gemm_phase<pg8::EpiSwiGLU, pg8::StaticOrder, true, true>(lds, g, S, E);
 } PH_END
        PH_BEGIN { pg8::Gemm g{BIG, wl + W_2 / 2, MTOK, DM, FFH}; pg8::StaticOrder S; S.init(MTOK, DM, G, bx); pg8::EpiResNormT<(L == NLAYER - 1)> E{a.out, XN, SS, DM};
                   pg8::gemm_phase<pg8::EpiResNormT<(L == NLAYER - 1)>, pg8::StaticOrder, true, true>(lds, g, S, E); } PH_END
        }
#undef PH_BEGIN
#undef PH_END
}
#ifndef MK_NPH
#define MK_NPH (2 + 5 + 5 + 7 + 5)
#endif
constexpr int N_PHASES = MK_NPH;

extern "C" void kernel_launch(void* const* d_in, const int* in_sizes, int n_in, void* d_out, int out_size, void* d_ws, size_t ws_size, hipStream_t stream) {
    static int grid = 0;
    if (grid == 0) {
        if (n_in != 24 || out_size != MTOK * DM || ws_size < WS_END) { fprintf(stderr, "kernel_launch: unexpected shapes (n_in %d, out %d, ws %zu); nothing launched\n", n_in, out_size, ws_size); grid = -1; return; }
        int dev = 0, cus = 0, per_cu = 0;
        if (hipGetDevice(&dev) != hipSuccess || hipDeviceGetAttribute(&cus, hipDeviceAttributeMultiprocessorCount, dev) != hipSuccess) { grid = -1; return; }
        if (hipFuncSetAttribute((const void*)mk_fwd, hipFuncAttributeMaxDynamicSharedMemorySize, LDS_BYTES) != hipSuccess) { fprintf(stderr, "kernel_launch: hipFuncSetAttribute failed\n"); grid = -1; return; }
        if (hipOccupancyMaxActiveBlocksPerMultiprocessor(&per_cu, (const void*)mk_fwd, NTHREADS, LDS_BYTES) != hipSuccess || per_cu < 1) { fprintf(stderr, "kernel_launch: occupancy query gives %d\n", per_cu); per_cu = 1; }
        (void)hipGetLastError();
        grid = cus;
    }
    if (grid < 0) return;
    Args a{};
    for (int i = 0; i < 24; ++i) a.in[i] = (const float*)d_in[i];
    a.out = (float*)d_out; a.ws = (unsigned char*)d_ws;
    if (hipMemsetAsync(d_ws, 0, CTL_ZERO_BYTES, stream) != hipSuccess) { fprintf(stderr, "kernel_launch: memset of the control words failed\n"); return; }
#if MK_N_LAUNCHES == 1
    a.ph_lo = 0; a.ph_hi = N_PHASES;
    { void* args[] = {&a}; hipError_t e = hipLaunchCooperativeKernel((const void*)mk_fwd, dim3(grid), dim3(NTHREADS), args, LDS_BYTES, stream);
      if (e != hipSuccess) fprintf(stderr, "kernel_launch: cooperative launch failed: %s (grid %d)\n", hipGetErrorString(e), grid); }
#else
    for (int p = 0; p < N_PHASES; ++p) { a.ph_lo = p; a.ph_hi = p + 1; void* args[] = {&a};
        hipError_t e = hipLaunchCooperativeKernel((const void*)mk_fwd, dim3(grid), dim3(NTHREADS), args, LDS_BYTES, stream);
        if (e != hipSuccess) { fprintf(stderr, "kernel_launch: launch %d failed: %s\n", p, hipGetErrorString(e)); break; } }
#endif
}
```

```cpp
#include <hip/hip_runtime.h>
#include <hip/hip_cooperative_groups.h>
#include <cstdio>
#include <cstdint>
namespace cg = cooperative_groups;
namespace pg8 {
#define PG8_LAS __attribute__((address_space(3)))
typedef unsigned short bf16_t;
typedef short bf16x8 __attribute__((ext_vector_type(8)));
typedef float f32x4 __attribute__((ext_vector_type(4)));
typedef unsigned u32x4 __attribute__((ext_vector_type(4)));
constexpr int BM = 256, BK = 64, HALF = 128, HTB = HALF * BK * 2  , STAGE_BYTES = 8 * HTB, NXCD = 8, WGM = 8;

__host__ __device__ __forceinline__ int lds_byte(int r, int c) { const int st = (r >> 4) * 2 + (c >> 5), rr = r & 15, cc = c & 31, ob = rr * 64 + cc * 2; return st * 1024 + (ob ^ (((ob >> 9) & 1) << 5)); }
__host__ __device__ __forceinline__ void stage_rc(int b, int& R, int& C) { const int st = b / 1024, sb = b % 1024, swz = sb ^ (((sb >> 9) & 1) << 5); R = (st >> 1) * 16 + swz / 64; C = (st & 1) * 32 + (swz % 64) / 2; }
__host__ __device__ __forceinline__ int perm32(int rho) { const int n = rho >> 4, i = rho & 15; return 8 * (i >> 2) + 4 * n + (i & 3); }

struct Unit { int pm, pn, idx; };
struct Gemm { const bf16_t* A; const bf16_t* Bt; int M, N, K; };

struct StaticOrder {
    int nM, nN, nwg, G, c;
    __host__ __device__ void init(int M, int N, int G_, int c_) { nM = M / BM; nN = N / BM; nwg = nM * nN; G = G_; c = c_; }
    __host__ __device__ bool next(int i, Unit& u) const {
        const long L = (long)i * G + c; if (L >= nwg) return false;
        int wgid = (int)L; { const int q = nwg / NXCD, r = nwg % NXCD, xcd = wgid % NXCD, off = wgid / NXCD; wgid = (xcd < r ? xcd * (q + 1) : r * (q + 1) + (xcd - r) * q) + off; }
        const int nig = WGM * nN, gid = wgid / nig, fm = gid * WGM, gsz = (nM - fm) < WGM ? (nM - fm) : WGM;
        u.pm = fm + ((wgid % nig) % gsz); u.pn = (wgid % nig) / gsz; u.idx = i; return true;
    }
    __device__ __forceinline__ void a_ready(const Unit&) const {}
    __device__ __forceinline__ void done(const Unit&) const {}
};
__device__ __forceinline__ unsigned cvt_pk_bf16(float lo, float hi) { unsigned r; asm volatile("v_cvt_pk_bf16_f32 %0, %1, %2" : "=v"(r) : "v"(lo), "v"(hi)); return r; }
__device__ __forceinline__ float row_rscale(const float* ss, int row) { const f32x4* p = (const f32x4*)(ss + (size_t)row * 16); const f32x4 a = (p[0] + p[1]) + (p[2] + p[3]);
    return __builtin_amdgcn_rsqf(((a[0] + a[1]) + (a[2] + a[3])) * (1.0f / 1024.0f) + 1e-6f); }
template <bool KSS = false> struct EpiBf16PT {
    static constexpr bool PERM = true, AFTER_DRAIN = false;
    bf16_t* O; int ldc; const PG8_LAS float* rst; float* kss; int mrows;
    __device__ __forceinline__ void operator()(const f32x4 (&acc)[2][2][4][2], const Unit& u, int wr, int wc, int fr, int fq) const {
        const int row0 = u.pm * BM + wr * 64 + fr, col0 = u.pn * BM + wc * 32 + 8 * fq;
        const bool kt = KSS && u.pn >= 4 && u.pn < 8;
#pragma unroll
        for (int ai = 0; ai < 2; ++ai)
#pragma unroll
            for (int m = 0; m < 4; ++m) { const int row = row0 + ai * HALF + m * 16; bf16_t* rowp = O + (size_t)row * ldc + col0; const float rs = rst[u.idx * 256 + wr * 64 + fr + ai * HALF + m * 16];
#pragma unroll
                for (int bj = 0; bj < 2; ++bj) { const f32x4 v0 = acc[ai][bj][m][0] * rs, v1 = acc[ai][bj][m][1] * rs;
                    u32x4 w; w.x = cvt_pk_bf16(v0[0], v0[1]); w.y = cvt_pk_bf16(v0[2], v0[3]); w.z = cvt_pk_bf16(v1[0], v1[1]); w.w = cvt_pk_bf16(v1[2], v1[3]);
                    *(u32x4*)(rowp + bj * HALF) = w;
                    if (kt) { float q = ((v0[0] * v0[0] + v0[1] * v0[1]) + (v0[2] * v0[2] + v0[3] * v0[3])) + ((v1[0] * v1[0] + v1[1] * v1[1]) + (v1[2] * v1[2] + v1[3] * v1[3]));
                        q += __shfl_xor(q, 16); q += __shfl_xor(q, 32);
                        if (fq == 0) kss[(size_t)((u.pn - 4) * 8 + bj * 4 + wc) * mrows + row] = q; } }
                if (KSS) asm volatile("" ::: "memory"); }
    }
};
typedef EpiBf16PT<false> EpiBf16P;
__device__ __forceinline__ float silu_mul(float g, float u) { return g * __builtin_amdgcn_rcpf(1.0f + __expf(-g)) * u; }
struct EpiSwiGLU {
    static constexpr bool PERM = true, AFTER_DRAIN = false;
    bf16_t* H; int ldh; const PG8_LAS float* rst;
    __device__ __forceinline__ void operator()(const f32x4 (&acc)[2][2][4][2], const Unit& u, int wr, int wc, int fr, int fq) const {
        const int row0 = u.pm * BM + wr * 64 + fr, col0 = u.pn * HALF + wc * 32 + 8 * fq;
#pragma unroll
        for (int ai = 0; ai < 2; ++ai)
#pragma unroll
            for (int m = 0; m < 4; ++m) { bf16_t* rowp = H + (size_t)(row0 + ai * HALF + m * 16) * ldh + col0; const float rs = rst[u.idx * 256 + wr * 64 + fr + ai * HALF + m * 16];
                const f32x4 g0 = acc[ai][0][m][0] * rs, g1 = acc[ai][0][m][1] * rs, u0 = acc[ai][1][m][0] * rs, u1 = acc[ai][1][m][1] * rs;
                u32x4 w; w.x = cvt_pk_bf16(silu_mul(g0[0], u0[0]), silu_mul(g0[1], u0[1])); w.y = cvt_pk_bf16(silu_mul(g0[2], u0[2]), silu_mul(g0[3], u0[3]));
                w.z = cvt_pk_bf16(silu_mul(g1[0], u1[0]), silu_mul(g1[1], u1[1])); w.w = cvt_pk_bf16(silu_mul(g1[2], u1[2]), silu_mul(g1[3], u1[3]));
                *(u32x4*)rowp = w; }
    }
};
typedef unsigned u32x2 __attribute__((ext_vector_type(2)));
template <bool LAST = false> struct EpiResNormT {
    static constexpr bool PERM = true, AFTER_DRAIN = false;
    float* out; bf16_t* xb; float* ss; int ldc;
    __device__ __forceinline__ void operator()(const f32x4 (&acc)[2][2][4][2], const Unit& u, int wr, int wc, int fr, int fq) const {
        const int row0 = u.pm * BM + wr * 64 + fr, col0 = u.pn * BM + wc * 32 + 8 * fq;
#pragma unroll
        for (int ai = 0; ai < 2; ++ai)
#pragma unroll
            for (int m = 0; m < 4; ++m) { const int row = row0 + ai * HALF + m * 16; const size_t off = (size_t)row * ldc + col0; float s = 0.f;
#pragma unroll
                for (int bj = 0; bj < 2; ++bj) { const size_t o = off + bj * HALF; const u32x4 b = *(const u32x4*)(xb + o);
                    f32x4 r0, r1;
                    r0[0] = __uint_as_float(b.x << 16) + acc[ai][bj][m][0][0]; r0[1] = __uint_as_float(b.x & 0xffff0000u) + acc[ai][bj][m][0][1];
                    r0[2] = __uint_as_float(b.y << 16) + acc[ai][bj][m][0][2]; r0[3] = __uint_as_float(b.y & 0xffff0000u) + acc[ai][bj][m][0][3];
                    r1[0] = __uint_as_float(b.z << 16) + acc[ai][bj][m][1][0]; r1[1] = __uint_as_float(b.z & 0xffff0000u) + acc[ai][bj][m][1][1];
                    r1[2] = __uint_as_float(b.w << 16) + acc[ai][bj][m][1][2]; r1[3] = __uint_as_float(b.w & 0xffff0000u) + acc[ai][bj][m][1][3];
                    if (LAST) { *(f32x4*)(out + o) = r0; *(f32x4*)(out + o + 4) = r1; }
                    else { s += ((r0[0] * r0[0] + r0[1] * r0[1]) + (r0[2] * r0[2] + r0[3] * r0[3])) + ((r1[0] * r1[0] + r1[1] * r1[1]) + (r1[2] * r1[2] + r1[3] * r1[3]));
                        u32x4 w; w.x = cvt_pk_bf16(r0[0], r0[1]); w.y = cvt_pk_bf16(r0[2], r0[3]); w.z = cvt_pk_bf16(r1[0], r1[1]); w.w = cvt_pk_bf16(r1[2], r1[3]); *(u32x4*)(xb + o) = w; } }
                if (!LAST) { s += __shfl_xor(s, 16); s += __shfl_xor(s, 32); if (fq == 0) ss[(size_t)row * 16 + u.pn * 4 + wc] = s; }
                asm volatile("" ::: "memory"); }
    }
};
typedef EpiResNormT<false> EpiResNorm;
template <class Epi, class Sched, bool ALIGN_EPI = false, bool SP2 = false>
__device__ __forceinline__ void gemm_phase(PG8_LAS unsigned char* lds, const Gemm g, const Sched& S, const Epi& E) {
    const int tid = threadIdx.x, wid = __builtin_amdgcn_readfirstlane(tid >> 6), lane = tid & 63, wr = wid >> 2, wc = wid & 3, fr = lane & 15, fq = lane >> 4;
    const int K = g.K, nt = K / BK;
    unsigned voffA[2], voffB[2];
#pragma unroll
    for (int i = 0; i < 2; ++i) { int R, C; stage_rc(tid * 16 + i * 8192, R, C); const int Rb = Epi::PERM ? ((R & ~31) + perm32(R & 31)) : R;
        voffA[i] = (unsigned)(R * K + C) * 2u; voffB[i] = (unsigned)(Rb * K + C) * 2u; }
    const size_t kstep = (size_t)(BK * 2);
    const size_t hstep = (size_t)HALF * K * 2;
    const size_t tstep = 2 * hstep;
    const unsigned ldsw = (unsigned)wid * 1024u;
    const int aoff = lds_byte(wr * 64 + fr, fq * 8), boff = lds_byte(wc * 32 + fr, fq * 8);
#define PG8_SA(b, h) (((b) * 2 + (h)) * HTB)
#define PG8_SB(b, h) ((4 + (b) * 2 + (h)) * HTB)
#define PG8_STAGE(bufoff, gbase, voff) do { _Pragma("unroll") for (int _i = 0; _i < 2; ++_i) \
        __builtin_amdgcn_global_load_lds((const unsigned*)((const char*)(gbase) + (voff)[_i]), (PG8_LAS unsigned*)(lds + (bufoff) + ldsw + _i * 8192), 16, 0, 0); } while (0)
#define PG8_LDA(dst, b, h) do { _Pragma("unroll") for (int m = 0; m < 4; ++m) _Pragma("unroll") for (int k = 0; k < 2; ++k) dst[m][k] = *(const PG8_LAS bf16x8*)(lds + PG8_SA(b, h) + aoff + m * 2048 + k * 1024); } while (0)
#define PG8_LDB(dst, b, h) do { _Pragma("unroll") for (int n = 0; n < 2; ++n) _Pragma("unroll") for (int k = 0; k < 2; ++k) dst[n][k] = *(const PG8_LAS bf16x8*)(lds + PG8_SB(b, h) + boff + n * 2048 + k * 1024); } while (0)
#define PG8_MMA(ai, bj, At, Bt) do { __builtin_amdgcn_s_setprio(1); _Pragma("unroll") for (int m = 0; m < 4; ++m) _Pragma("unroll") for (int n = 0; n < 2; ++n) _Pragma("unroll") for (int k = 0; k < 2; ++k) \
        acc[ai][bj][m][n] = __builtin_amdgcn_mfma_f32_16x16x32_bf16(Bt[n][k], At[m][k], acc[ai][bj][m][n], 0, 0, 0); __builtin_amdgcn_s_setprio(0); } while (0)
#define PG8_WAIT_V(n) asm volatile("s_waitcnt vmcnt(" #n ")" ::: "memory")
#define PG8_WAIT_L(n) asm volatile("s_waitcnt lgkmcnt(" #n ")" ::: "memory")
#define PG8_BAR __builtin_amdgcn_s_barrier()
#define PG8_SCHED __builtin_amdgcn_sched_barrier(0)
    Unit cur, nxt; int ui = 0;
    if (!S.next(0, cur)) return;
    f32x4 acc[2][2][4][2];
#pragma unroll
    for (int a = 0; a < 2; ++a)
#pragma unroll
        for (int b = 0; b < 2; ++b)
#pragma unroll
            for (int m = 0; m < 4; ++m)
#pragma unroll
                for (int n = 0; n < 2; ++n) acc[a][b][m][n] = (f32x4){0.f, 0.f, 0.f, 0.f};
    bf16x8 At[4][2], B0[2][2], B1[2][2];
    const char* cA = (const char*)g.A + (size_t)cur.pm * tstep; const char* cB = (const char*)g.Bt + (size_t)cur.pn * tstep;
    S.a_ready(cur);
    if constexpr (SP2) {
        PG8_STAGE(PG8_SB(0, 0), cB, voffB); PG8_STAGE(PG8_SB(0, 1), cB + hstep, voffB); PG8_STAGE(PG8_SA(0, 0), cA, voffA); PG8_STAGE(PG8_SA(0, 1), cA + hstep, voffA);
        if (wr == 1) PG8_BAR;
        PG8_WAIT_V(2); PG8_BAR;
        PG8_STAGE(PG8_SB(1, 0), cB + kstep, voffB); PG8_STAGE(PG8_SA(1, 0), cA + kstep, voffA); PG8_STAGE(PG8_SB(1, 1), cB + hstep + kstep, voffB);
        PG8_WAIT_V(6); PG8_BAR;
    } else {
        PG8_STAGE(PG8_SB(0, 0), cB, voffB); PG8_STAGE(PG8_SA(0, 0), cA, voffA); PG8_STAGE(PG8_SB(0, 1), cB + hstep, voffB); PG8_STAGE(PG8_SA(0, 1), cA + hstep, voffA);
        if (wr == 1) PG8_BAR;
        PG8_WAIT_V(4); PG8_BAR;
        PG8_STAGE(PG8_SB(1, 0), cB + kstep, voffB); PG8_STAGE(PG8_SA(1, 0), cA + kstep, voffA); PG8_STAGE(PG8_SB(1, 1), cB + hstep + kstep, voffB);
        PG8_WAIT_V(6); PG8_BAR;
    }
    for (;;) {
        const bool has_next = S.next(ui + 1, nxt);
        const char* nA = has_next ? (const char*)g.A + (size_t)nxt.pm * tstep : cA; const char* nB = has_next ? (const char*)g.Bt + (size_t)nxt.pn * tstep : cB;
        for (int t = 0; t < nt; t += 2) {
            const bool last = (t == nt - 2);
            const char* a1 = cA + (size_t)(t + 1) * kstep;
            const char* a2 = last ? nA : cA + (size_t)(t + 2) * kstep; const char* b2 = last ? nB : cB + (size_t)(t + 2) * kstep;
            const char* a3 = a2 + kstep; const char* b3 = b2 + kstep;
            if (last && has_next) S.a_ready(nxt);
            if constexpr (SP2) {
            PG8_LDB(B0, 0, 0); PG8_LDB(B1, 0, 1); PG8_SCHED; PG8_LDA(At, 0, 0); PG8_STAGE(PG8_SA(1, 1), a1 + hstep, voffA);
            PG8_WAIT_V(8); PG8_WAIT_L(0); PG8_BAR; PG8_MMA(0, 0, At, B0); PG8_MMA(0, 1, At, B1); PG8_BAR; PG8_SCHED;
            PG8_LDA(At, 0, 1); PG8_STAGE(PG8_SB(0, 0), b2, voffB); PG8_STAGE(PG8_SB(0, 1), b2 + hstep, voffB); PG8_STAGE(PG8_SA(0, 0), a2, voffA);
            PG8_WAIT_V(8); PG8_WAIT_L(0); PG8_BAR; PG8_MMA(1, 0, At, B0); PG8_MMA(1, 1, At, B1); PG8_BAR; PG8_SCHED;
            PG8_LDB(B0, 1, 0); PG8_LDB(B1, 1, 1); PG8_SCHED; PG8_LDA(At, 1, 0); PG8_STAGE(PG8_SA(0, 1), a2 + hstep, voffA);
            PG8_WAIT_V(8); PG8_WAIT_L(0); PG8_BAR; PG8_MMA(0, 0, At, B0); PG8_MMA(0, 1, At, B1); PG8_BAR; PG8_SCHED;
            PG8_LDA(At, 1, 1); PG8_STAGE(PG8_SB(1, 0), b3, voffB); PG8_STAGE(PG8_SB(1, 1), b3 + hstep, voffB); PG8_STAGE(PG8_SA(1, 0), a3, voffA);
            PG8_WAIT_V(8); PG8_WAIT_L(0); PG8_BAR; PG8_MMA(1, 0, At, B0); PG8_MMA(1, 1, At, B1); PG8_BAR; PG8_SCHED;
            } else {
            PG8_LDB(B0, 0, 0); PG8_SCHED; PG8_LDA(At, 0, 0); PG8_STAGE(PG8_SA(1, 1), a1 + hstep, voffA);
            PG8_WAIT_L(8); PG8_BAR; PG8_WAIT_L(0); PG8_MMA(0, 0, At, B0); PG8_BAR; PG8_SCHED;
            PG8_LDB(B1, 0, 1); PG8_STAGE(PG8_SB(0, 0), b2, voffB);
            PG8_BAR; PG8_WAIT_L(0); PG8_MMA(0, 1, At, B1); PG8_BAR;
            PG8_LDA(At, 0, 1); PG8_STAGE(PG8_SA(0, 0), a2, voffA);
            PG8_BAR; PG8_WAIT_L(0); PG8_MMA(1, 0, At, B0); PG8_BAR; PG8_SCHED;
            PG8_STAGE(PG8_SB(0, 1), b2 + hstep, voffB);
            PG8_WAIT_V(6); PG8_BAR; PG8_MMA(1, 1, At, B1); PG8_BAR;
            PG8_LDB(B0, 1, 0); PG8_SCHED; PG8_LDA(At, 1, 0); PG8_STAGE(PG8_SA(0, 1), a2 + hstep, voffA);
            PG8_WAIT_L(8); PG8_BAR; PG8_WAIT_L(0); PG8_MMA(0, 0, At, B0); PG8_BAR; PG8_SCHED;
            PG8_LDB(B1, 1, 1); PG8_STAGE(PG8_SB(1, 0), b3, voffB);
            PG8_BAR; PG8_WAIT_L(0); PG8_MMA(0, 1, At, B1); PG8_BAR;
            PG8_LDA(At, 1, 1); PG8_STAGE(PG8_SA(1, 0), a3, voffA);
            PG8_BAR; PG8_WAIT_L(0); PG8_MMA(1, 0, At, B0); PG8_BAR; PG8_SCHED;
            PG8_STAGE(PG8_SB(1, 1), b3 + hstep, voffB);
            PG8_WAIT_V(6); PG8_BAR; PG8_MMA(1, 1, At, B1); PG8_BAR;
            }
        }
        if constexpr (ALIGN_EPI) { if (wr == 0) PG8_BAR; }
        if constexpr (!Epi::AFTER_DRAIN) { E(acc, cur, wr, wc, fr, fq); S.done(cur); }
        if (!has_next) break;
#pragma unroll
        for (int a = 0; a < 2; ++a)
#pragma unroll
            for (int b = 0; b < 2; ++b)
#pragma unroll
                for (int m = 0; m < 4; ++m)
#pragma unroll
                    for (int n = 0; n < 2; ++n) acc[a][b][m][n] = (f32x4){0.f, 0.f, 0.f, 0.f};
        cur = nxt; cA = nA; cB = nB; ++ui;
        if constexpr (ALIGN_EPI) { if (wr == 1) PG8_BAR; }
    }
    PG8_WAIT_V(0);
    if constexpr (!ALIGN_EPI) { if (wr == 0) PG8_BAR; }
    PG8_BAR;
    if constexpr (Epi::AFTER_DRAIN) { E.fused(acc, cur, wr, wc, fr, fq, lds, wid, lane); S.done(cur); }
#undef PG8_SA
#undef PG8_SB
#undef PG8_STAGE
#undef PG8_LDA
#undef PG8_LDB
#undef PG8_MMA
#undef PG8_WAIT_V
#undef PG8_WAIT_L
#undef PG8_BAR
#undef PG8_SCHED
}
}

#ifndef MK_N_LAUNCHES
#define MK_N_LAUNCHES 1
#endif
constexpr int NB = 16, SEQ = 2048, DM = 1024, MTOK = NB * SEQ, NQKV = 3072, FFH = 2816, NW13 = 2 * FFH, NLAYER = 4;
constexpr float RMS_EPS = 1e-6f;
constexpr int NWAVES = 8, NTHREADS = 512;
constexpr size_t MiB = 1u << 20;
constexpr size_t WS_W = 1 * MiB, W_LAYER = 49 * MiB / 2;
constexpr size_t W_IN = 0, W_OUT = 6 * MiB, W_13 = 8 * MiB, W_2 = 19 * MiB;
constexpr size_t WS_SS = 439 * MiB;
constexpr size_t WS_HID = 100 * MiB;
constexpr size_t WS_KF = 102 * MiB;
constexpr int KF_LEN = 4112;
constexpr size_t WS_XN = 119 * MiB;
constexpr size_t WS_MIXO = 183 * MiB;
constexpr size_t WS_BIG = 247 * MiB;
constexpr size_t WS_VT = 441 * MiB;
constexpr size_t WS_KSS = 505 * MiB;
constexpr size_t WS_END = 509 * MiB;
constexpr int MISC_OFF = 163776, RST_OFF = 131072;
constexpr size_t WS_BAR = 16384, CTL_ZERO_BYTES = 65536;
constexpr int LDS_BYTES = 163840;
#define LAS __attribute__((address_space(3)))
typedef unsigned short bf16;
typedef unsigned v4u __attribute__((ext_vector_type(4)));
typedef unsigned v2u __attribute__((ext_vector_type(2)));
typedef float f32x4 __attribute__((ext_vector_type(4)));
typedef short bf16x8 __attribute__((ext_vector_type(8)));
typedef short v4i16_t __attribute__((ext_vector_type(4)));
#define LDS_WAIT() asm volatile("s_waitcnt lgkmcnt(0)" ::: "memory")
typedef float f32x2_cv __attribute__((ext_vector_type(2))); typedef __bf16 bf16x2_cv __attribute__((ext_vector_type(2)));
__device__ __forceinline__ unsigned pk2c(float lo, float hi) { const f32x2_cv v = {lo, hi}; const bf16x2_cv b = __builtin_convertvector(v, bf16x2_cv); return __builtin_bit_cast(unsigned, b); }
__device__ __forceinline__ unsigned pk2(float lo, float hi) { return pg8::cvt_pk_bf16(lo, hi); }
__device__ __forceinline__ float bflo(unsigned w) { return __uint_as_float(w << 16); }
__device__ __forceinline__ float bfhi(unsigned w) { return __uint_as_float(w & 0xffff0000u); }
__device__ __forceinline__ float bf2f(unsigned short b) { return __uint_as_float(((unsigned)b) << 16); }
__device__ __forceinline__ unsigned short f2bf(float f) { return (unsigned short)(pk2(f, 0.f) & 0xffffu); }
__device__ __forceinline__ float wave_sum(float v) {
#pragma unroll
    for (int o = 1; o < 64; o <<= 1) v += __shfl_xor(v, o);
    return v;
}

#define RLX_AGENT __ATOMIC_RELAXED, __HIP_MEMORY_SCOPE_AGENT
#define XB_TMO      128
#define XB_XCNT(j)  (256  + 64 * (j))
#define XB_XSUB(j)  (1280 + 64 * (j))
#define XB_XGEN(j)  (2304 + 64 * (j))
#define XB_TOP      3328
#define XB_TOPGEN   3392
#define XCD_BAR_WORDS 3456
#define XB_SPIN_CAP (1u << 18)

__device__ __forceinline__ unsigned xb_ld(unsigned* p)              { return __hip_atomic_load(p, __ATOMIC_RELAXED, __HIP_MEMORY_SCOPE_AGENT); }
__device__ __forceinline__ unsigned xb_add(unsigned* p, unsigned v) { return __hip_atomic_fetch_add(p, v, __ATOMIC_RELAXED, __HIP_MEMORY_SCOPE_AGENT); }
__device__ __forceinline__ unsigned xb_xcc_id() { return (unsigned)__builtin_amdgcn_s_getreg((3 << 11) | 20) & 0xFu; }
#define XB_SPIN(cond, bar) do { unsigned _sp = 0; while (cond) { __builtin_amdgcn_s_sleep(1); \
    if ((++_sp & 255u) == 0u) { if (xb_ld(&(bar)[XB_TMO])) break; if (_sp > XB_SPIN_CAP) { atomicAdd(&(bar)[XB_TMO], 1u); break; } } } } while (0)

struct XcdBarrier {
    unsigned* bar; unsigned x;
    volatile LAS unsigned* st;
};

__device__ __forceinline__ XcdBarrier xcd_barrier_post(unsigned* bar, volatile LAS unsigned* st) {
    XcdBarrier b; b.bar = bar; b.x = xb_xcc_id(); b.st = st;
    if (threadIdx.x == 0) (void)xb_add(&bar[XB_XCNT(b.x)], 1u);
    return b;
}
__device__ __forceinline__ void xcd_barrier_complete(unsigned* bar, unsigned x, unsigned& nloc, unsigned& nx) {
    const unsigned G = gridDim.x * gridDim.y * gridDim.z;
    unsigned sum, cnt, mine, sp = 0u;
    for (;;) {
        sum = 0u; cnt = 0u; mine = 0u;
#pragma unroll
        for (unsigned j = 0; j < 16; ++j) { const unsigned c = xb_ld(&bar[XB_XCNT(j)]); sum += c; cnt += (c > 0u) ? 1u : 0u; mine = (j == x) ? c : mine; }
        if (sum == G) break;
        __builtin_amdgcn_s_sleep(1);
        if ((++sp & 255u) == 0u) { if (xb_ld(&bar[XB_TMO])) break; if (sp > XB_SPIN_CAP) { atomicAdd(&bar[XB_TMO], 1u); break; } }
    }
    nloc = mine > 0u ? mine : 1u; nx = cnt > 0u ? cnt : 1u;
}

__device__ __forceinline__ void xcd_barrier(const XcdBarrier& b) {
    asm volatile("s_waitcnt vmcnt(0)" ::: "memory");
    __syncthreads();
    if (threadIdx.x == 0) {
        unsigned* bar = b.bar;
        __builtin_amdgcn_s_waitcnt(0);
        unsigned nloc = b.st[0], nx = b.st[1];
        if (nloc == 0u) { xcd_barrier_complete(bar, b.x, nloc, nx); b.st[0] = nloc; b.st[1] = nx; }
        const unsigned old = xb_add(&bar[XB_XSUB(b.x)], 1u);
        const unsigned gen = old / nloc;
        if (old + 1u == (gen + 1u) * nloc) {
            __builtin_amdgcn_fence(__ATOMIC_RELEASE, "agent");
            asm volatile("s_waitcnt vmcnt(0)" ::: "memory");
            const unsigned og = xb_add(&bar[XB_TOP], 1u);
            const unsigned tg = og / nx;
            if (og + 1u == (tg + 1u) * nx) xb_add(&bar[XB_TOPGEN], 1u);
            else XB_SPIN(xb_ld(&bar[XB_TOPGEN]) == tg, bar);
            __builtin_amdgcn_fence(__ATOMIC_ACQUIRE, "agent");
            xb_add(&bar[XB_XGEN(b.x)], 1u);
            asm volatile("s_waitcnt vmcnt(0)" ::: "memory");
        } else {
            XB_SPIN(xb_ld(&bar[XB_XGEN(b.x)]) == gen, bar);
            __builtin_amdgcn_fence(__ATOMIC_ACQUIRE, "agent");
            asm volatile("s_waitcnt vmcnt(0)" ::: "memory");
        }
    }
    __syncthreads();
}

__device__ __forceinline__ void transpose_item(const float* __restrict__ W, int K, int N, const float* __restrict__ gain, bf16* WT, int dst_row0, LAS float* scr, int k0, int n0, int lane) {
    float tv[32];
#pragma unroll
    for (int i = 0; i < 32; ++i) { const int kk = 2 * i + (lane >> 5); tv[i] = W[(size_t)(k0 + kk) * N + n0 + (lane & 31)]; }
#pragma unroll
    for (int i = 0; i < 32; ++i) { const int kk = 2 * i + (lane >> 5); float v = tv[i]; if (gain) v *= gain[k0 + kk]; scr[kk * 33 + (lane & 31)] = v; }
    LDS_WAIT();
    const int c = lane & 7;
#pragma unroll
    for (int j = 0; j < 4; ++j) { const int n = (lane >> 3) + 8 * j; const LAS float* s = scr + (8 * c) * 33 + n;
        v4u o; o.x = pk2(s[0 * 33], s[1 * 33]); o.y = pk2(s[2 * 33], s[3 * 33]); o.z = pk2(s[4 * 33], s[5 * 33]); o.w = pk2(s[6 * 33], s[7 * 33]);
        *(v4u*)(WT + (size_t)(dst_row0 + n) * K + k0 + 8 * c) = o; }
    LDS_WAIT();
}

struct Args { const float* in[24]; float* out; unsigned char* ws; int ph_lo, ph_hi; };

__device__ __forceinline__ void phase_prologue(const Args& a, LAS unsigned char* lds, int gw, int ngw, int wave, int lane) {
    LAS float* scr = (LAS float*)(lds + wave * 16384);
    constexpr int I_IN = 16 * 96, I_OUT = 16 * 32, I_13 = 16 * 176, I_2 = 44 * 32, I_L = I_IN + I_OUT + I_13 + I_2;
    for (int it = gw; it < NLAYER * I_L; it += ngw) {
        const int L = it / I_L; int r = it - L * I_L;
        const float* win = (L == 1) ? a.in[6] : (L == 2) ? a.in[11] : (L == 0 ? a.in[3] : a.in[3] + (size_t)DM * NQKV);
        const float* wout = (L == 1) ? a.in[10] : (L == 2) ? a.in[21] : (L == 0 ? a.in[5] : a.in[5] + (size_t)DM * DM);
        bf16* wl = (bf16*)(a.ws + WS_W + (size_t)L * W_LAYER);
        if (r < I_IN) { const int kb = r / 96, nb = r % 96; transpose_item(win, DM, NQKV, a.in[1] + L * DM, wl + W_IN / 2, 32 * nb, scr, 64 * kb, 32 * nb, lane); continue; }
        r -= I_IN;
        if (r < I_OUT) { const int kb = r / 32, nb = r % 32; transpose_item(wout, DM, DM, nullptr, wl + W_OUT / 2, 32 * nb, scr, 64 * kb, 32 * nb, lane); continue; }
        r -= I_OUT;
        if (r < I_13) { const int kb = r / 176, nb = r % 176, n0 = 32 * nb, half = n0 / FFH, j = n0 % FFH, dst = 256 * (j / 128) + 128 * half + (j % 128);
            transpose_item(a.in[22] + (size_t)L * DM * NW13, DM, NW13, a.in[2] + L * DM, wl + W_13 / 2, dst, scr, 64 * kb, n0, lane); continue; }
        r -= I_13;
        { const int kb = r / 32, nb = r % 32; transpose_item(a.in[23] + (size_t)L * FFH * DM, FFH, DM, nullptr, wl + W_2 / 2, 32 * nb, scr, 64 * kb, 32 * nb, lane); }
    }
    const float* w1 = a.in[14]; const float* b1 = a.in[15]; const float* w2 = a.in[16]; const float* b2 = a.in[17]; const float* fr = a.in[19];
    float* hid = (float*)(a.ws + WS_HID);
    for (int t = gw; t < SEQ; t += ngw) {
        float zv = 0.f;
        if (lane == 0) zv = (float)t / (float)(SEQ - 1);
        else if (lane <= 32) { const int k = (lane - 1) & 15; const float band = 1e-4f + (float)k * ((15.0f - 1e-4f) / 15.0f);
            const float ang = ((6.283185307179586f * (float)t) / (float)SEQ) * band; zv = (lane <= 16) ? cosf(ang) : -sinf(ang); }
        float a1 = b1[lane];
        for (int e = 0; e < 33; ++e) a1 += __shfl(zv, e) * w1[e * 64 + lane];
        const float f = fr[lane];
        const float h1 = sinf(f * a1);
        float a2 = b2[lane];
        for (int i = 0; i < 64; ++i) a2 += __shfl(h1, i) * w2[i * 64 + lane];
        hid[t * 64 + lane] = sinf(f * a2);
    }
}

__device__ __forceinline__ void phase_filters(const Args& a, int gw, int ngw, int lane) {
    const float* hid = (const float*)(a.ws + WS_HID); const float* w3 = a.in[18]; bf16* KF = (bf16*)(a.ws + WS_KF);
    for (int p = gw; p < 2 * DM; p += ngw) {
        const int o = p >> 10, d = p & 1023, cf = o * 2048 + d, cr = cf + 1024;
        const float delta = 4.605170185988091f * (1.0f / 1.5f + (float)d * ((1.0f / 0.3f - 1.0f / 1.5f) / 1023.0f));
        float inv = 0.f;
        bf16* kf = KF + (size_t)p * KF_LEN;
        float wf[64], wr[64];
#pragma unroll
        for (int j = 0; j < 64; ++j) { wf[j] = w3[(size_t)j * 4096 + cf]; wr[j] = w3[(size_t)j * 4096 + cr]; }
#pragma unroll 1
        for (int pass = 0; pass < 2; ++pass) {
            float asum = 0.f;
#pragma unroll 1
            for (int it = 0; it < 32; ++it) {
                const int t = lane + 64 * it; const f32x4* hr = (const f32x4*)(hid + t * 64);
                float af = 0.f, ar = 0.f;
#pragma unroll
                for (int j4 = 0; j4 < 16; ++j4) { const f32x4 h = hr[j4];
                    af += h[0] * wf[4 * j4] + h[1] * wf[4 * j4 + 1] + h[2] * wf[4 * j4 + 2] + h[3] * wf[4 * j4 + 3];
                    ar += h[0] * wr[4 * j4] + h[1] * wr[4 * j4 + 1] + h[2] * wr[4 * j4 + 2] + h[3] * wr[4 * j4 + 3]; }
                const float dec = __expf(-((float)t / (float)(SEQ - 1)) * delta);
                af *= dec; ar *= dec;
                if (pass == 0) asum += (t == 0) ? fabsf(af + ar) : (fabsf(af) + fabsf(ar));
                else { if (t == 0) kf[2048] = f2bf((af + ar) * inv); else { kf[2048 - t] = f2bf(af * inv); kf[2048 + t] = f2bf(ar * inv); } }
            }
            if (pass == 0) inv = 1.0f / wave_sum(asum);
        }
        if (lane < 17) kf[lane == 0 ? 0 : 4095 + lane] = 0;
    }
}

__device__ __forceinline__ void phase_norm0(const float* __restrict__ x, bf16* __restrict__ xn, float* __restrict__ ss, int gw, int ngw, int lane) {
    for (int m = gw; m < MTOK; m += ngw) {
        const f32x4* xr = (const f32x4*)(x + (size_t)m * DM) + lane;
        f32x4 v[4]; float s = 0.f;
#pragma unroll
        for (int j = 0; j < 4; ++j) { v[j] = xr[64 * j]; s += (v[j].x * v[j].x + v[j].y * v[j].y) + (v[j].z * v[j].z + v[j].w * v[j].w); }
        s = wave_sum(s);
        if (lane < 16) ss[(size_t)m * 16 + lane] = (lane == 0) ? s : 0.f;
        unsigned long long* o8 = (unsigned long long*)(xn + (size_t)m * DM) + lane;
#pragma unroll
        for (int j = 0; j < 4; ++j) o8[64 * j] = (unsigned long long)pk2(v[j].x, v[j].y) | ((unsigned long long)pk2(v[j].z, v[j].w) << 32);
    }
}

__device__ __forceinline__ void fill_row_scales(const pg8::StaticOrder& S, const float* ss, LAS float* rst, int tid) {
    for (int idx = tid; idx < 11 * 256; idx += NTHREADS) { pg8::Unit u; if (!S.next(idx >> 8, u)) break; rst[idx] = pg8::row_rscale(ss, u.pm * 256 + (idx & 255)); }
    __syncthreads();
}

__device__ __forceinline__ void phase_shortconv(const bf16* __restrict__ big, const float* __restrict__ cw, bf16* __restrict__ outp, int gtid, int ngt) {
    for (int idx = gtid; idx < MTOK * 128; idx += ngt) {
        const int m = idx >> 7, d0 = (idx & 127) * 8, t = m & (SEQ - 1);
        const bf16* row = big + (size_t)m * NQKV + d0;
        const v4u bv = *(const v4u*)row, c1 = *(const v4u*)(row + DM), u1 = *(const v4u*)(row + 2 * DM);
        v4u c0 = {0u, 0u, 0u, 0u}, u0 = c0, c2 = c0, u2 = c0;
        if (t > 0) { c0 = *(const v4u*)(row - NQKV + DM); u0 = *(const v4u*)(row - NQKV + 2 * DM); }
        if (t < SEQ - 1) { c2 = *(const v4u*)(row + NQKV + DM); u2 = *(const v4u*)(row + NQKV + 2 * DM); }
        const f32x4 wa0 = *(const f32x4*)(cw + d0), wa1 = *(const f32x4*)(cw + d0 + 4), wb0 = *(const f32x4*)(cw + DM + d0), wb1 = *(const f32x4*)(cw + DM + d0 + 4),
                    wc0 = *(const f32x4*)(cw + 2 * DM + d0), wc1 = *(const f32x4*)(cw + 2 * DM + d0 + 4);
        v4u o;
#pragma unroll
        for (int k = 0; k < 4; ++k) {
            const float w0l = (k < 2) ? wa0[2 * k] : wa1[2 * k - 4], w0h = (k < 2) ? wa0[2 * k + 1] : wa1[2 * k - 3];
            const float w1l = (k < 2) ? wb0[2 * k] : wb1[2 * k - 4], w1h = (k < 2) ? wb0[2 * k + 1] : wb1[2 * k - 3];
            const float w2l = (k < 2) ? wc0[2 * k] : wc1[2 * k - 4], w2h = (k < 2) ? wc0[2 * k + 1] : wc1[2 * k - 3];
            const float lo = bflo(bv[k]) * (w0l * (bflo(c0[k]) * bflo(u0[k])) + w1l * (bflo(c1[k]) * bflo(u1[k])) + w2l * (bflo(c2[k]) * bflo(u2[k])));
            const float hi = bfhi(bv[k]) * (w0h * (bfhi(c0[k]) * bfhi(u0[k])) + w1h * (bfhi(c1[k]) * bfhi(u1[k])) + w2h * (bfhi(c2[k]) * bfhi(u2[k])));
            o[k] = pk2(lo, hi);
        }
        *(v4u*)(outp + (size_t)m * DM + d0) = o;
    }
}

__device__ __forceinline__ void norm_frag(const v4u r0, const v4u r1, const LAS float* g, int quad, float extra, bf16x8& f0, bf16x8& f1) {
    float x[16];
#pragma unroll
    for (int k = 0; k < 4; ++k) { x[2 * k] = bflo(r0[k]); x[2 * k + 1] = bfhi(r0[k]); x[8 + 2 * k] = bflo(r1[k]); x[9 + 2 * k] = bfhi(r1[k]); }
    float ss = 0.f;
#pragma unroll
    for (int k = 0; k < 16; ++k) ss += x[k] * x[k];
    ss += __shfl_xor(ss, 16); ss += __shfl_xor(ss, 32);
    const float r = rsqrtf(ss * (1.0f / 64.0f) + RMS_EPS) * extra;
    v4u o0, o1;
#pragma unroll
    for (int k = 0; k < 4; ++k) { o0[k] = pk2c(x[2 * k] * r * g[8 * quad + 2 * k], x[2 * k + 1] * r * g[8 * quad + 2 * k + 1]);
        o1[k] = pk2c(x[8 + 2 * k] * r * g[32 + 8 * quad + 2 * k], x[9 + 2 * k] * r * g[32 + 8 * quad + 2 * k + 1]); }
    f0 = __builtin_bit_cast(bf16x8, o0); f1 = __builtin_bit_cast(bf16x8, o1);
}

constexpr int AR_SLOT = 16640, AR_V = 8192, AR_RK = 16384, AR_NSLOT = 9, AR_RPB = AR_NSLOT * AR_SLOT, AR_G = AR_RPB + 1920;
__device__ __forceinline__ int ar_off(int k, int c) { return k * 128 + ((c ^ (k & 7)) << 4); }

constexpr int A3_NSLOT = 8, A3_RPB = A3_NSLOT * AR_SLOT, A3_G = A3_RPB + 1920, A3_CMB = A3_G + 256, A3_CMB_BYTES = 4608;
static_assert(A3_CMB + 4 * A3_CMB_BYTES <= MISC_OFF, "attention LDS map");
__device__ __forceinline__ void phase_natten3(const bf16* qkv, const float* qg, const float* kg, const float* rpb, const float* kss, bf16* outp, LAS unsigned char* lds, int vcu, int G, int wave, int lane, int tid) {
    LAS float* rpb_l = (LAS float*)(lds + A3_RPB); LAS float* g_l = (LAS float*)(lds + A3_G);
    const int n = lane & 15, quad = lane >> 4, qq = (lane >> 2) & 3, p = lane & 3;
    const int cb = wave & 3, kh = wave >> 2;
    LAS unsigned char* cmb = lds + A3_CMB + cb * A3_CMB_BYTES;
    const int lk = (tid >> 3) & 63, lc = tid & 7;
    for (int unit = vcu; unit < NB * 16; unit += G) {
        const int b = unit >> 4, h = unit & 15;
        const bf16* kvbase = qkv + (size_t)b * SEQ * NQKV + DM + h * 64 + lc * 8 + (size_t)lk * NQKV;
        const float* ksbase = kss + (size_t)(2 * h) * MTOK + (size_t)b * SEQ + tid;
        __syncthreads();
        for (int i = tid; i < 15 * 31; i += NTHREADS) rpb_l[i] = rpb[h * (15 * 31) + i];
        if (tid < 64) g_l[tid] = qg[tid] * kg[tid];
        {   v4u rk_[8], rv_[8]; float rs_[8];
#pragma unroll
            for (int rho = 0; rho < 8; ++rho) { const bf16* pp = kvbase + (size_t)rho * 64 * NQKV; rk_[rho] = *(const v4u*)pp; rv_[rho] = *(const v4u*)(pp + DM);
                rs_[rho] = (tid < 64) ? ksbase[rho * 64] + ksbase[MTOK + rho * 64] : 0.f; }
#pragma unroll
            for (int rho = 0; rho < 8; ++rho) { LAS unsigned char* slot = lds + rho * AR_SLOT; *(LAS v4u*)(slot + ar_off(lk, lc)) = rk_[rho]; *(LAS v4u*)(slot + AR_V + ar_off(lk, lc)) = rv_[rho];
                if (tid < 64) *(LAS float*)(slot + AR_RK + 4 * tid) = __builtin_amdgcn_rsqf(rs_[rho] * (1.0f / 64.0f) + RMS_EPS); } }
        int start = cb * 16 - 8; start = start < 0 ? 0 : (start > 32 ? 32 : start);
        const int qc = cb * 16 + n; int cs = qc - 8; cs = cs < 0 ? 0 : (cs > 48 ? 48 : cs);
        const bf16* qbase = qkv + (size_t)(b * SEQ + cb * 16 + n) * NQKV + h * 64 + 8 * quad;
        v4u qr0 = *(const v4u*)qbase, qr1 = *(const v4u*)(qbase + 32);
        __syncthreads();
#pragma unroll 1
        for (int r = 0; r < 32; ++r) {
            int rs = r - 4; rs = rs < 0 ? 0 : (rs > 24 ? 24 : rs);
            int rsn = r - 3; rsn = rsn < 0 ? 0 : (rsn > 24 ? 24 : rsn);
            const bool slide = (r < 31) && (rsn != rs);
            v4u nk = {0u, 0u, 0u, 0u}, nv = nk; float nss = 0.f;
            if (slide) { const bf16* pp = kvbase + (size_t)(rs + 8) * 64 * NQKV; nk = *(const v4u*)pp; nv = *(const v4u*)(pp + DM); if (tid < 64) nss = ksbase[(rs + 8) * 64] + ksbase[MTOK + (rs + 8) * 64]; }
            bf16x8 qf0, qf1;
            norm_frag(qr0, qr1, g_l, quad, 0.125f, qf0, qf1);
            if (r < 31) { const bf16* qp = qbase + (size_t)(r + 1) * 64 * NQKV; qr0 = *(const v4u*)qp; qr1 = *(const v4u*)(qp + 32); }
            f32x4 st[4][2];
#pragma unroll
            for (int jj = 0; jj < 4; ++jj) { const LAS unsigned char* slot = lds + ((rs + 4 * kh + jj) & 7) * AR_SLOT;
#pragma unroll
                for (int kt = 0; kt < 2; ++kt) { const int k = start + 16 * kt + n;
                    const bf16x8 kf0 = *(const LAS bf16x8*)(slot + ar_off(k, quad)), kf1 = *(const LAS bf16x8*)(slot + ar_off(k, quad + 4));
                    f32x4 sacc = {0.f, 0.f, 0.f, 0.f};
                    sacc = __builtin_amdgcn_mfma_f32_16x16x32_bf16(kf0, qf0, sacc, 0, 0, 0);
                    sacc = __builtin_amdgcn_mfma_f32_16x16x32_bf16(kf1, qf1, sacc, 0, 0, 0);
                    st[jj][kt] = sacc; } }
            float mx = -3.0e38f;
#pragma unroll
            for (int jj = 0; jj < 4; ++jj) { const int dr = rs + 4 * kh + jj - r + 7; const LAS unsigned char* slot = lds + ((rs + 4 * kh + jj) & 7) * AR_SLOT;
#pragma unroll
                for (int kt = 0; kt < 2; ++kt) { const f32x4 rk = *(const LAS f32x4*)(slot + AR_RK + 4 * (start + 16 * kt + 4 * quad));
#pragma unroll
                    for (int i = 0; i < 4; ++i) { const int kc = start + 16 * kt + 4 * quad + i; int dc = kc - qc + 15; dc = dc < 0 ? 0 : (dc > 30 ? 30 : dc);
                        const bool valid = (kc >= cs) && (kc < cs + 16);
                        const float v = valid ? st[jj][kt][i] * rk[i] + rpb_l[dr * 31 + dc] : -3.0e38f;
                        st[jj][kt][i] = v; mx = fmaxf(mx, v); } } }
            mx = fmaxf(mx, __shfl_xor(mx, 16)); mx = fmaxf(mx, __shfl_xor(mx, 32));
            float sum = 0.f;
#pragma unroll
            for (int jj = 0; jj < 4; ++jj)
#pragma unroll
                for (int kt = 0; kt < 2; ++kt)
#pragma unroll
                    for (int i = 0; i < 4; ++i) { const float e = __expf(st[jj][kt][i] - mx); st[jj][kt][i] = e; sum += e; }
            sum += __shfl_xor(sum, 16); sum += __shfl_xor(sum, 32);
            f32x4 oacc[4];
#pragma unroll
            for (int dt = 0; dt < 4; ++dt) oacc[dt] = (f32x4){0.f, 0.f, 0.f, 0.f};
            const int kl = start + 4 * quad + qq;
            v4i16_t lo[4][4], hi[4][4];
#pragma unroll
            for (int jj = 0; jj < 4; ++jj) {
                const unsigned vs = (unsigned)(unsigned long long)(lds + ((rs + 4 * kh + jj) & 7) * AR_SLOT + AR_V) + 8 * (p & 1);
#pragma unroll
                for (int dt = 0; dt < 4; ++dt) { const unsigned a_lo = vs + ar_off(kl, 2 * dt + (p >> 1)), a_hi = vs + ar_off(kl + 16, 2 * dt + (p >> 1));
                    asm volatile("ds_read_b64_tr_b16 %0, %1" : "=v"(lo[jj][dt]) : "v"(a_lo) : "memory");
                    asm volatile("ds_read_b64_tr_b16 %0, %1" : "=v"(hi[jj][dt]) : "v"(a_hi) : "memory"); } }
            bf16x8 pf[4];
#pragma unroll
            for (int jj = 0; jj < 4; ++jj) { const f32x4 s0 = st[jj][0], s1 = st[jj][1];
                v4u pw; pw.x = pk2c(s0[0], s0[1]); pw.y = pk2c(s0[2], s0[3]); pw.z = pk2c(s1[0], s1[1]); pw.w = pk2c(s1[2], s1[3]); pf[jj] = __builtin_bit_cast(bf16x8, pw); }
            asm volatile("s_waitcnt lgkmcnt(0)" ::: "memory"); __builtin_amdgcn_sched_barrier(0);
#pragma unroll
            for (int jj = 0; jj < 4; ++jj)
#pragma unroll
                for (int dt = 0; dt < 4; ++dt) {
                    const bf16x8 vf = (bf16x8){lo[jj][dt][0], lo[jj][dt][1], lo[jj][dt][2], lo[jj][dt][3], hi[jj][dt][0], hi[jj][dt][1], hi[jj][dt][2], hi[jj][dt][3]};
                    oacc[dt] = __builtin_amdgcn_mfma_f32_16x16x32_bf16(vf, pf[jj], oacc[dt], 0, 0, 0);
                }
            if (kh == 1) {
#pragma unroll
                for (int dt = 0; dt < 4; ++dt) *(LAS f32x4*)(cmb + (dt * 64 + lane) * 16) = oacc[dt];
                *(LAS float*)(cmb + 4096 + lane * 8) = mx; *(LAS float*)(cmb + 4096 + lane * 8 + 4) = sum;
            }
            __syncthreads();
            if (kh == 0) {
                const float mb = *(const LAS float*)(cmb + 4096 + lane * 8), lb = *(const LAS float*)(cmb + 4096 + lane * 8 + 4);
                const float M = fmaxf(mx, mb), fa = __expf(mx - M), fb = __expf(mb - M), inv = 1.0f / (sum * fa + lb * fb), wa = fa * inv, wb = fb * inv;
                bf16* op = outp + (size_t)(b * SEQ + r * 64 + cb * 16 + n) * DM + h * 64 + 4 * quad;
#pragma unroll
                for (int dt = 0; dt < 4; ++dt) { const f32x4 ob = *(const LAS f32x4*)(cmb + (dt * 64 + lane) * 16); const f32x4 o = oacc[dt] * wa + ob * wb;
                    v2u w; w.x = pk2c(o[0], o[1]); w.y = pk2c(o[2], o[3]); *(v2u*)(op + 16 * dt) = w; }
            }
            if (slide) { LAS unsigned char* slot = lds + ((rs + 8) & 7) * AR_SLOT; *(LAS v4u*)(slot + ar_off(lk, lc)) = nk; *(LAS v4u*)(slot + AR_V + ar_off(lk, lc)) = nv;
                if (tid < 64) *(LAS float*)(slot + AR_RK + 4 * tid) = __builtin_amdgcn_rsqf(nss * (1.0f / 64.0f) + RMS_EPS); }
            __syncthreads();
        }
    }
}

constexpr int CT_STRIDE = 144, CT_BYTES = 66 * CT_STRIDE;
__device__ __forceinline__ void hyena_pre_fetch(const bf16* big, int id, int lane, v4u (&v)[9]) {
    const int ct = id & 31, tt = id >> 5, b = tt >> 5, t0 = (tt & 31) * 64, c0 = ct * 64;
#pragma unroll
    for (int ps = 0; ps < 9; ++ps) { const int rr = ps * 8 + (lane >> 3), part = lane & 7, t = t0 - 1 + rr;
        v[ps] = (v4u){0u, 0u, 0u, 0u};
        if (rr < 66 && t >= 0 && t < SEQ) v[ps] = *(const v4u*)(big + (size_t)(b * SEQ + t) * NQKV + c0 + part * 8); }
}
__device__ __forceinline__ void phase_hyena_pre(const bf16* big, const float* sw, const float* sb, bf16* VTp, bf16* X1Tp, LAS unsigned char* lds, int gw, int ngw, int wave, int lane) {
    LAS unsigned char* scr = lds + wave * 16384;
    v4u vin[9];
    if (gw < 512 * 32) hyena_pre_fetch(big, gw, lane, vin);
    for (int id = gw; id < 512 * 32; id += ngw) {
        const int ct = id & 31, tt = id >> 5, b = tt >> 5, t0 = (tt & 31) * 64, c0 = ct * 64;
#pragma unroll
        for (int ps = 0; ps < 9; ++ps) { const int rr = ps * 8 + (lane >> 3), part = lane & 7; if (rr < 66) *(LAS v4u*)(scr + rr * CT_STRIDE + part * 16) = vin[ps]; }
        if (id + ngw < 512 * 32) hyena_pre_fetch(big, id + ngw, lane, vin);
        LDS_WAIT();
        const int cg = c0 + lane; const float w0 = sw[cg], w1 = sw[NQKV + cg], w2 = sw[2 * NQKV + cg], bias = sb[cg];
        const LAS unsigned short* col = (const LAS unsigned short*)(scr + 2 * lane);
        float pa = bf2f(col[0]), pb = bf2f(col[CT_STRIDE / 2]);
        v4u o[8];
#pragma unroll
        for (int g8 = 0; g8 < 8; ++g8) { float y[8];
#pragma unroll
            for (int k = 0; k < 8; ++k) { const float pc = bf2f(col[(g8 * 8 + k + 2) * (CT_STRIDE / 2)]); y[k] = w0 * pa + w1 * pb + w2 * pc + bias; pa = pb; pb = pc; }
            o[g8].x = pk2(y[0], y[1]); o[g8].y = pk2(y[2], y[3]); o[g8].z = pk2(y[4], y[5]); o[g8].w = pk2(y[6], y[7]); }
        LDS_WAIT();
#pragma unroll
        for (int g8 = 0; g8 < 8; ++g8) *(LAS v4u*)(scr + lane * CT_STRIDE + g8 * 16) = o[g8];
        LDS_WAIT();
#pragma unroll
        for (int ps = 0; ps < 8; ++ps) { const int cl = ps * 8 + (lane >> 3), part = lane & 7, cc = c0 + cl;
            const v4u v = *(const LAS v4u*)(scr + cl * CT_STRIDE + part * 16);
            bf16* op = (cc < DM ? VTp + (size_t)cc * NB * SEQ : X1Tp + (size_t)(cc - DM) * NB * SEQ) + (size_t)b * SEQ + t0 + part * 8;
            *(v4u*)op = v; }
        LDS_WAIT();
    }
}
constexpr int U_STRIDE = 4112, U_BYTES = 16 * U_STRIDE, CP_OFF = U_BYTES, CP_STRIDE = 8224;
struct HyFilt { v4u a, b; };
__device__ __forceinline__ HyFilt hyena_fetch_filter(const bf16* kf, int tid) { HyFilt f; const v4u* src = (const v4u*)kf; f.a = src[tid]; f.b = (tid < 2) ? src[512 + tid] : (v4u){0u, 0u, 0u, 0u}; return f; }
__device__ __forceinline__ void hyena_put_filter(LAS unsigned char* lds, const HyFilt& f, int tid) {
    *(LAS v4u*)(lds + CP_OFF + 16 * tid) = f.a;
    if (tid < 2) *(LAS v4u*)(lds + CP_OFF + 16 * (512 + tid)) = f.b;
    __syncthreads();
    const v4u lo = *(LAS v4u*)(lds + CP_OFF + 16 * tid), hi = *(LAS v4u*)(lds + CP_OFF + 16 * tid + 16);
    const unsigned s[8] = {lo.x, lo.y, lo.z, lo.w, hi.x, hi.y, hi.z, hi.w};
#pragma unroll
    for (int r = 1; r < 8; ++r) { v4u o;
#pragma unroll
        for (int w = 0; w < 4; ++w) { const int q = w + r / 2; o[w] = (r & 1) ? ((s[q] >> 16) | (s[q + 1] << 16)) : s[q]; }
        *(LAS v4u*)(lds + CP_OFF + r * CP_STRIDE + 16 * tid) = o; }
    __syncthreads();
}
__device__ __forceinline__ void hyena_conv(LAS unsigned char* lds, f32x4 (&acc)[16], unsigned toep0, unsigned uaddr0) {
#pragma unroll
    for (int ti = 0; ti < 16; ++ti) acc[ti] = (f32x4){0.f, 0.f, 0.f, 0.f};
#pragma unroll 1
    for (int k4 = 0; k4 < 16; ++k4) {
        bf16x8 uf[4];
#pragma unroll
        for (int s = 0; s < 4; ++s) uf[s] = *(const LAS bf16x8*)(lds + uaddr0 + 256 * k4 + 64 * s);
#pragma unroll
        for (int x = 0; x < 22; ++x) {
            const bf16x8 tf = *(const LAS bf16x8*)(lds + toep0 + 256 * k4 + 32 * x);
#pragma unroll
            for (int s = 0; s < 4; ++s) { const int ti = 15 + 2 * s - x; if (ti >= 0 && ti < 16) acc[ti] = __builtin_amdgcn_mfma_f32_16x16x32_bf16(tf, uf[s], acc[ti], 0, 0, 0); }
        }
    }
}
__device__ __forceinline__ void phase_hyena(bf16* VT, const bf16* X1T, const bf16* KF, const float* skip, LAS unsigned char* lds, int vcu, int G, int wave, int lane, int tid) {
    const int n = lane & 15, quad = lane >> 4, rho = (-n) & 7;
    const int base = 2048 - 256 * wave - n + 8 * quad;
    const unsigned toep0 = CP_OFF + rho * CP_STRIDE + 16 * ((base >> 3) - 30);
    const unsigned uaddr0 = n * U_STRIDE + 16 * quad;
    v4u ur[8]; HyFilt f0;
    if (vcu < DM) { const v4u* src = (const v4u*)(VT + (size_t)vcu * NB * SEQ);
#pragma unroll
        for (int k = 0; k < 8; ++k) ur[k] = src[tid + 512 * k];
        f0 = hyena_fetch_filter(KF + (size_t)vcu * KF_LEN, tid); }
    for (int d = vcu; d < DM; d += G) {
        bf16* vrow = VT + (size_t)d * NB * SEQ;
#pragma unroll
        for (int k = 0; k < 8; ++k) { const int c = tid + 512 * k; *(LAS v4u*)(lds + (c >> 8) * U_STRIDE + 16 * (c & 255)) = ur[k]; }
        hyena_put_filter(lds, f0, tid);
        const HyFilt f1 = hyena_fetch_filter(KF + (size_t)(DM + d) * KF_LEN, tid);
        v2u xx[16];
#pragma unroll
        for (int ti = 0; ti < 16; ++ti) xx[ti] = *(const v2u*)(X1T + ((size_t)d * NB + n) * SEQ + 256 * wave + 16 * ti + 4 * quad);
        f32x4 acc[16];
        hyena_conv(lds, acc, toep0, uaddr0);
        const float sk0 = skip[d], sk1 = skip[DM + d];
        v2u z[16];
#pragma unroll
        for (int ti = 0; ti < 16; ++ti) { const int t = 256 * wave + 16 * ti + 4 * quad;
            const v2u vv = *(const LAS v2u*)(lds + n * U_STRIDE + 2 * t);
            const float z0 = bflo(xx[ti].x) * (acc[ti][0] + sk0 * bflo(vv.x)), z1 = bfhi(xx[ti].x) * (acc[ti][1] + sk0 * bfhi(vv.x));
            const float z2 = bflo(xx[ti].y) * (acc[ti][2] + sk0 * bflo(vv.y)), z3 = bfhi(xx[ti].y) * (acc[ti][3] + sk0 * bfhi(vv.y));
            z[ti].x = pk2(z0, z1); z[ti].y = pk2(z2, z3); }
        __syncthreads();
#pragma unroll
        for (int ti = 0; ti < 16; ++ti) { const int t = 256 * wave + 16 * ti + 4 * quad; *(LAS v2u*)(lds + n * U_STRIDE + 2 * t) = z[ti]; }
        hyena_put_filter(lds, f1, tid);
        if (d + G < DM) { const v4u* src = (const v4u*)(VT + (size_t)(d + G) * NB * SEQ);
#pragma unroll
            for (int k = 0; k < 8; ++k) ur[k] = src[tid + 512 * k];
            f0 = hyena_fetch_filter(KF + (size_t)(d + G) * KF_LEN, tid); }
        hyena_conv(lds, acc, toep0, uaddr0);
        __syncthreads();
#pragma unroll
        for (int ti = 0; ti < 16; ++ti) { const int t = 256 * wave + 16 * ti + 4 * quad;
            const float o0 = acc[ti][0] + sk1 * bflo(z[ti].x), o1 = acc[ti][1] + sk1 * bfhi(z[ti].x), o2 = acc[ti][2] + sk1 * bflo(z[ti].y), o3 = acc[ti][3] + sk1 * bfhi(z[ti].y);
            v2u w; w.x = pk2(o0, o1); w.y = pk2(o2, o3); *(LAS v2u*)(lds + n * U_STRIDE + 2 * t) = w; }
        __syncthreads();
        {   v4u* dst = (v4u*)vrow;
#pragma unroll
            for (int k = 0; k < 8; ++k) { const int c = tid + 512 * k; dst[c] = *(const LAS v4u*)(lds + (c >> 8) * U_STRIDE + 16 * (c & 255)); } }
        __syncthreads();
    }
}
constexpr int C5_STRIDE = 132;
__device__ __forceinline__ void phase_hyena_post(const bf16* big, const float* sw, const float* sb, const bf16* ZT, bf16* outp, LAS unsigned char* lds, int gw, int ngw, int wave, int lane) {
    LAS unsigned char* scr = lds + wave * 16384;
    for (int id = gw; id < 512 * 16; id += ngw) {
        const int dtile = id & 15, tt = id >> 4, b = tt >> 5, t0 = (tt & 31) * 64, d0 = dtile * 64;
        const int cg = 2 * DM + d0 + lane; const float w0 = sw[cg], w1 = sw[NQKV + cg], w2 = sw[2 * NQKV + cg], bias = sb[cg];
        const bf16* pp = big + (size_t)(b * SEQ + t0) * NQKV + cg;
        unsigned short pr[66];
#pragma unroll
        for (int k = 0; k < 66; ++k) { const int t = t0 - 1 + k; pr[k] = (t >= 0 && t < SEQ) ? pp[(long)(k - 1) * NQKV] : (unsigned short)0; }
        v4u zv[8];
#pragma unroll
        for (int ps = 0; ps < 8; ++ps) { const int dd = ps * 8 + (lane >> 3), part = lane & 7; zv[ps] = *(const v4u*)(ZT + ((size_t)(d0 + dd) * NB + b) * SEQ + t0 + part * 8); }
#pragma unroll
        for (int ps = 0; ps < 8; ++ps) { const int dd = ps * 8 + (lane >> 3), part = lane & 7;
            LAS unsigned* w = (LAS unsigned*)(scr + dd * C5_STRIDE + part * 16); w[0] = zv[ps].x; w[1] = zv[ps].y; w[2] = zv[ps].z; w[3] = zv[ps].w; }
        LDS_WAIT();
        const LAS unsigned short* zr = (const LAS unsigned short*)(scr + lane * C5_STRIDE);
        bf16* op = outp + (size_t)(b * SEQ + t0) * DM + d0 + lane;
#pragma unroll
        for (int k = 0; k < 64; ++k) { const float y = (w0 * bf2f(pr[k]) + w1 * bf2f(pr[k + 1]) + w2 * bf2f(pr[k + 2]) + bias) * bf2f(zr[k]); op[(size_t)k * DM] = f2bf(y); }
        LDS_WAIT();
    }
}

__global__ void __launch_bounds__(NTHREADS, 2) mk_fwd(Args a) {
    extern __shared__ __attribute__((aligned(16))) unsigned char lds_raw[];
    LAS unsigned char* lds = (LAS unsigned char*)lds_raw;
    cg::grid_group grid = cg::this_grid();
    const int tid = threadIdx.x, lane = tid & 63, wave = __builtin_amdgcn_readfirstlane(tid >> 6);
    const int G = gridDim.x, bx = blockIdx.x;
    const int vcu = (G % 8 == 0) ? (bx % 8) * (G / 8) + bx / 8 : bx;
    const int gw = vcu * NWAVES + wave, ngw = G * NWAVES;
    unsigned char* ws = a.ws;
    float* SS = (float*)(ws + WS_SS); bf16* XN = (bf16*)(ws + WS_XN); bf16* VT = (bf16*)(ws + WS_VT); bf16* MIXO = (bf16*)(ws + WS_MIXO); bf16* BIG = (bf16*)(ws + WS_BIG);
    const int lo = a.ph_lo, hi = a.ph_hi; int ph = 0;
    volatile LAS unsigned* MISC = (volatile LAS unsigned*)(lds + MISC_OFF);
    if (tid < 16) MISC[tid] = 0u;
    __syncthreads();
    XcdBarrier xbar = xcd_barrier_post((unsigned*)(ws + WS_BAR), MISC);
#define PH_BEGIN if (ph >= lo && ph < hi) {
#define PH_END   if (ph + 1 < hi) { if (ph == 0) grid.sync(); else xcd_barrier(xbar); } } ++ph;

    PH_BEGIN phase_prologue(a, lds, gw, ngw, wave, lane);
    PH_END
    PH_BEGIN { const int gw4 = vcu * 4 + (wave & 3), ngw4 = G * 4;
        if (wave < 4) phase_filters(a, gw4, ngw4, lane); else phase_norm0(a.in[0], XN, SS, gw4, ngw4, lane); } PH_END

    { constexpr int L = 0;

        constexpr int kind = L % 3;
        const bf16* wl = (const bf16*)(ws + WS_W + (size_t)L * W_LAYER);
        PH_BEGIN { pg8::Gemm g{XN, wl + W_IN / 2, MTOK, NQKV, DM}; pg8::StaticOrder S; S.init(MTOK, NQKV, G, bx); pg8::EpiBf16PT<(kind == 1)> E{BIG, NQKV, (const LAS float*)(lds + RST_OFF), (float*)(ws + WS_KSS), MTOK}; fill_row_scales(S, SS, (LAS float*)(lds + RST_OFF), tid);
                   pg8::gemm_phase<pg8::EpiBf16PT<(kind == 1)>, pg8::StaticOrder, true, true>(lds, g, S, E);
 } PH_END
        if (kind == 0) {
            PH_BEGIN phase_shortconv(BIG, a.in[4] + (size_t)(L / 3) * 3 * DM, MIXO, vcu * NTHREADS + tid, G * NTHREADS);
            PH_END
        } else if (kind == 1) {
            PH_BEGIN
            phase_natten3(BIG, a.in[7], a.in[8], a.in[9], (const float*)(ws + WS_KSS), MIXO, lds, vcu, G, wave, lane, tid); PH_END
        } else {
            PH_BEGIN phase_hyena_pre(BIG, a.in[12], a.in[13], VT, MIXO, lds, gw, ngw, wave, lane);
            PH_END
            PH_BEGIN
            phase_hyena(VT, MIXO, (const bf16*)(ws + WS_KF), a.in[20], lds, vcu, G, wave, lane, tid); PH_END
            PH_BEGIN phase_hyena_post(BIG, a.in[12], a.in[13], VT, MIXO, lds, gw, ngw, wave, lane);
            PH_END
        }
        PH_BEGIN { pg8::Gemm g{MIXO, wl + W_OUT / 2, MTOK, DM, DM}; pg8::StaticOrder S; S.init(MTOK, DM, G, bx); pg8::EpiResNorm E{a.out, XN, SS, DM};
                   pg8::gemm_phase<pg8::EpiResNorm, pg8::StaticOrder, true, true>(lds, g, S, E); } PH_END
        PH_BEGIN { pg8::Gemm g{XN, wl + W_13 / 2, MTOK, NW13, DM}; pg8::StaticOrder S; S.init(MTOK, NW13, G, bx); pg8::EpiSwiGLU E{BIG, FFH, (const LAS float*)(lds + RST_OFF)}; fill_row_scales(S, SS, (LAS float*)(lds + RST_OFF), tid);
                   pg8::gemm_phase<pg8::EpiSwiGLU, pg8::StaticOrder, true, true>(lds, g, S, E);
 } PH_END
        PH_BEGIN { pg8::Gemm g{BIG, wl + W_2 / 2, MTOK, DM, FFH}; pg8::StaticOrder S; S.init(MTOK, DM, G, bx); pg8::EpiResNormT<(L == NLAYER - 1)> E{a.out, XN, SS, DM};
                   pg8::gemm_phase<pg8::EpiResNormT<(L == NLAYER - 1)>, pg8::StaticOrder, true, true>(lds, g, S, E); } PH_END
        }
    { constexpr int L = 1;

        constexpr int kind = L % 3;
        const bf16* wl = (const bf16*)(ws + WS_W + (size_t)L * W_LAYER);
        PH_BEGIN { pg8::Gemm g{XN, wl + W_IN / 2, MTOK, NQKV, DM}; pg8::StaticOrder S; S.init(MTOK, NQKV, G, bx); pg8::EpiBf16PT<(kind == 1)> E{BIG, NQKV, (const LAS float*)(lds + RST_OFF), (float*)(ws + WS_KSS), MTOK}; fill_row_scales(S, SS, (LAS float*)(lds + RST_OFF), tid);
                   pg8::gemm_phase<pg8::EpiBf16PT<(kind == 1)>, pg8::StaticOrder, true, true>(lds, g, S, E);
 } PH_END
        if (kind == 0) {
            PH_BEGIN phase_shortconv(BIG, a.in[4] + (size_t)(L / 3) * 3 * DM, MIXO, vcu * NTHREADS + tid, G * NTHREADS);
            PH_END
        } else if (kind == 1) {
            PH_BEGIN
            phase_natten3(BIG, a.in[7], a.in[8], a.in[9], (const float*)(ws + WS_KSS), MIXO, lds, vcu, G, wave, lane, tid); PH_END
        } else {
            PH_BEGIN phase_hyena_pre(BIG, a.in[12], a.in[13], VT, MIXO, lds, gw, ngw, wave, lane);
            PH_END
            PH_BEGIN
            phase_hyena(VT, MIXO, (const bf16*)(ws + WS_KF), a.in[20], lds, vcu, G, wave, lane, tid); PH_END
            PH_BEGIN phase_hyena_post(BIG, a.in[12], a.in[13], VT, MIXO, lds, gw, ngw, wave, lane);
            PH_END
        }
        PH_BEGIN { pg8::Gemm g{MIXO, wl + W_OUT / 2, MTOK, DM, DM}; pg8::StaticOrder S; S.init(MTOK, DM, G, bx); pg8::EpiResNorm E{a.out, XN, SS, DM};
                   pg8::gemm_phase<pg8::EpiResNorm, pg8::StaticOrder, true, true>(lds, g, S, E); } PH_END
        PH_BEGIN { pg8::Gemm g{XN, wl + W_13 / 2, MTOK, NW13, DM}; pg8::StaticOrder S; S.init(MTOK, NW13, G, bx); pg8::EpiSwiGLU E{BIG, FFH, (const LAS float*)(lds + RST_OFF)}; fill_row_scales(S, SS, (LAS float*)(lds + RST_OFF), tid);
                   pg8::gemm_phase<pg8::EpiSwiGLU, pg8::StaticOrder, true, true>(lds, g, S, E);
 } PH_END
        PH_BEGIN { pg8::Gemm g{BIG, wl + W_2 / 2, MTOK, DM, FFH}; pg8::StaticOrder S; S.init(MTOK, DM, G, bx); pg8::EpiResNormT<(L == NLAYER - 1)> E{a.out, XN, SS, DM};
                   pg8::gemm_phase<pg8::EpiResNormT<(L == NLAYER - 1)>, pg8::StaticOrder, true, true>(lds, g, S, E); } PH_END
        }
    { constexpr int L = 2;

        constexpr int kind = L % 3;
        const bf16* wl = (const bf16*)(ws + WS_W + (size_t)L * W_LAYER);
        PH_BEGIN { pg8::Gemm g{XN, wl + W_IN / 2, MTOK, NQKV, DM}; pg8::StaticOrder S; S.init(MTOK, NQKV, G, bx); pg8::EpiBf16PT<(kind == 1)> E{BIG, NQKV, (const LAS float*)(lds + RST_OFF), (float*)(ws + WS_KSS), MTOK}; fill_row_scales(S, SS, (LAS float*)(lds + RST_OFF), tid);
                   pg8::gemm_phase<pg8::EpiBf16PT<(kind == 1)>, pg8::StaticOrder, true, true>(lds, g, S, E);
 } PH_END
        if (kind == 0) {
            PH_BEGIN phase_shortconv(BIG, a.in[4] + (size_t)(L / 3) * 3 * DM, MIXO, vcu * NTHREADS + tid, G * NTHREADS);
            PH_END
        } else if (kind == 1) {
            PH_BEGIN
            phase_natten3(BIG, a.in[7], a.in[8], a.in[9], (const float*)(ws + WS_KSS), MIXO, lds, vcu, G, wave, lane, tid); PH_END
        } else {
            PH_BEGIN phase_hyena_pre(BIG, a.in[12], a.in[13], VT, MIXO, lds, gw, ngw, wave, lane);
            PH_END
            PH_BEGIN
            phase_hyena(VT, MIXO, (const bf16*)(ws + WS_KF), a.in[20], lds, vcu, G, wave, lane, tid); PH_END
            PH_BEGIN phase_hyena_post(BIG, a.in[12], a.in[13], VT, MIXO, lds, gw, ngw, wave, lane);
            PH_END
        }
        PH_BEGIN { pg8::Gemm g{MIXO, wl + W_OUT / 2, MTOK, DM, DM}; pg8::StaticOrder S; S.init(MTOK, DM, G, bx); pg8::EpiResNorm E{a.out, XN, SS, DM};
                   pg8::gemm_phase<pg8::EpiResNorm, pg8::StaticOrder, true, true>(lds, g, S, E); } PH_END
        PH_BEGIN { pg8::Gemm g{XN, wl + W_13 / 2, MTOK, NW13, DM}; pg8::StaticOrder S; S.init(MTOK, NW13, G, bx); pg8::EpiSwiGLU E{BIG, FFH, (const LAS float*)(lds + RST_OFF)}; fill_row_scales(S, SS, (LAS float*)(lds + RST_OFF), tid);
                   pg8::gemm_phase<pg8::EpiSwiGLU, pg8::StaticOrder, true, true>(lds, g, S, E);
 } PH_END
        PH_BEGIN { pg8::Gemm g{BIG, wl + W_2 / 2, MTOK, DM, FFH}; pg8::StaticOrder S; S.init(MTOK, DM, G, bx); pg8::EpiResNormT<(L == NLAYER - 1)> E{a.out, XN, SS, DM};
                   pg8::gemm_phase<pg8::EpiResNormT<(L == NLAYER - 1)>, pg8::StaticOrder, true, true>(lds, g, S, E); } PH_END
        }
    { constexpr int L = 3;

        constexpr int kind = L % 3;
        const bf16* wl = (const bf16*)(ws + WS_W + (size_t)L * W_LAYER);
        PH_BEGIN { pg8::Gemm g{XN, wl + W_IN / 2, MTOK, NQKV, DM}; pg8::StaticOrder S; S.init(MTOK, NQKV, G, bx); pg8::EpiBf16PT<(kind == 1)> E{BIG, NQKV, (const LAS float*)(lds + RST_OFF), (float*)(ws + WS_KSS), MTOK}; fill_row_scales(S, SS, (LAS float*)(lds + RST_OFF), tid);
                   pg8::gemm_phase<pg8::EpiBf16PT<(kind == 1)>, pg8::StaticOrder, true, true>(lds, g, S, E);
 } PH_END
        if (kind == 0) {
            PH_BEGIN phase_shortconv(BIG, a.in[4] + (size_t)(L / 3) * 3 * DM, MIXO, vcu * NTHREADS + tid, G * NTHREADS);
            PH_END
        } else if (kind == 1) {
            PH_BEGIN
            phase_natten3(BIG, a.in[7], a.in[8], a.in[9], (const float*)(ws + WS_KSS), MIXO, lds, vcu, G, wave, lane, tid); PH_END
        } else {
            PH_BEGIN phase_hyena_pre(BIG, a.in[12], a.in[13], VT, MIXO, lds, gw, ngw, wave, lane);
            PH_END
            PH_BEGIN
            phase_hyena(VT, MIXO, (const bf16*)(ws + WS_KF), a.in[20], lds, vcu, G, wave, lane, tid); PH_END
            PH_BEGIN phase_hyena_post(BIG, a.in[12], a.in[13], VT, MIXO, lds, gw, ngw, wave, lane);
            PH_END
        }
        PH_BEGIN { pg8::Gemm g{MIXO, wl + W_OUT / 2, MTOK, DM, DM}; pg8::StaticOrder S; S.init(MTOK, DM, G, bx); pg8::EpiResNorm E{a.out, XN, SS, DM};
                   pg8::gemm_phase<pg8::EpiResNorm, pg8::StaticOrder, true, true>(lds, g, S, E); } PH_END
        PH_BEGIN { pg8::Gemm g{XN, wl + W_13 / 2, MTOK, NW13, DM}; pg8::StaticOrder S; S.init(MTOK, NW13, G, bx); pg8::EpiSwiGLU E{BIG, FFH, (const LAS float*)(lds + RST_OFF)}; fill_row_scales(S, SS, (LAS float*)(lds + RST_OFF), tid);
                   pg8::gemm_phase<pg8::EpiSwiGLU, pg8::StaticOrder, true, true>(lds, g, S, E);
 } PH_END
        PH_BEGIN { pg8::Gemm g{BIG, wl + W_2 / 2, MTOK, DM, FFH}; pg8::StaticOrder S; S.init(MTOK, DM, G, bx); pg8::EpiResNormT<(L == NLAYER - 1)> E{a.out, XN, SS, DM};
                   pg8::gemm_phase<pg8::EpiResNormT<(L == NLAYER - 1)>, pg8::StaticOrder, true, true>(lds, g, S, E); } PH_END
        }
#undef PH_BEGIN
#undef PH_END
}
#ifndef MK_NPH
#define MK_NPH (2 + 5 + 5 + 7 + 5)
#endif
constexpr int N_PHASES = MK_NPH;

extern "C" void kernel_launch(void* const* d_in, const int* in_sizes, int n_in, void* d_out, int out_size, void* d_ws, size_t ws_size, hipStream_t stream) {
    static int grid = 0;
    if (grid == 0) {
        if (n_in != 24 || out_size != MTOK * DM || ws_size < WS_END) { fprintf(stderr, "kernel_launch: unexpected shapes (n_in %d, out %d, ws %zu); nothing launched\n", n_in, out_size, ws_size); grid = -1; return; }
        int dev = 0, cus = 0, per_cu = 0;
        if (hipGetDevice(&dev) != hipSuccess || hipDeviceGetAttribute(&cus, hipDeviceAttributeMultiprocessorCount, dev) != hipSuccess) { grid = -1; return; }
        if (hipFuncSetAttribute((const void*)mk_fwd, hipFuncAttributeMaxDynamicSharedMemorySize, LDS_BYTES) != hipSuccess) { fprintf(stderr, "kernel_launch: hipFuncSetAttribute failed\n"); grid = -1; return; }
        if (hipOccupancyMaxActiveBlocksPerMultiprocessor(&per_cu, (const void*)mk_fwd, NTHREADS, LDS_BYTES) != hipSuccess || per_cu < 1) { fprintf(stderr, "kernel_launch: occupancy query gives %d\n", per_cu); per_cu = 1; }
        (void)hipGetLastError();
        grid = cus;
    }
    if (grid < 0) return;
    Args a{};
    for (int i = 0; i < 24; ++i) a.in[i] = (const float*)d_in[i];
    a.out = (float*)d_out; a.ws = (unsigned char*)d_ws;
    if (hipMemsetAsync(d_ws, 0, CTL_ZERO_BYTES, stream) != hipSuccess) { fprintf(stderr, "kernel_launch: memset of the control words failed\n"); return; }
#if MK_N_LAUNCHES == 1
    a.ph_lo = 0; a.ph_hi = N_PHASES;
    { void* args[] = {&a}; hipError_t e = hipLaunchCooperativeKernel((const void*)mk_fwd, dim3(grid), dim3(NTHREADS), args, LDS_BYTES, stream);
      if (e != hipSuccess) fprintf(stderr, "kernel_launch: cooperative launch failed: %s (grid %d)\n", hipGetErrorString(e), grid); }
#else
    for (int p = 0; p < N_PHASES; ++p) { a.ph_lo = p; a.ph_hi = p + 1; void* args[] = {&a};
        hipError_t e = hipLaunchCooperativeKernel((const void*)mk_fwd, dim3(grid), dim3(NTHREADS), args, LDS_BYTES, stream);
        if (e != hipSuccess) { fprintf(stderr, "kernel_launch: launch %d failed: %s\n", p, hipGetErrorString(e)); break; } }
#endif
}
```

```cpp
#include <hip/hip_runtime.h>
#include <hip/hip_cooperative_groups.h>
#include <cstdio>
#include <cstdint>
namespace cg = cooperative_groups;
namespace pg8 {
#define PG8_LAS __attribute__((address_space(3)))
typedef unsigned short bf16_t;
typedef short bf16x8 __attribute__((ext_vector_type(8)));
typedef float f32x4 __attribute__((ext_vector_type(4)));
typedef unsigned u32x4 __attribute__((ext_vector_type(4)));
constexpr int BM = 256, BK = 64, HALF = 128, HTB = HALF * BK * 2  , STAGE_BYTES = 8 * HTB, NXCD = 8, WGM = 8;

__host__ __device__ __forceinline__ int lds_byte(int r, int c) { const int st = (r >> 4) * 2 + (c >> 5), rr = r & 15, cc = c & 31, ob = rr * 64 + cc * 2; return st * 1024 + (ob ^ (((ob >> 9) & 1) << 5)); }
__host__ __device__ __forceinline__ void stage_rc(int b, int& R, int& C) { const int st = b / 1024, sb = b % 1024, swz = sb ^ (((sb >> 9) & 1) << 5); R = (st >> 1) * 16 + swz / 64; C = (st & 1) * 32 + (swz % 64) / 2; }
__host__ __device__ __forceinline__ int perm32(int rho) { const int n = rho >> 4, i = rho & 15; return 8 * (i >> 2) + 4 * n + (i & 3); }

struct Unit { int pm, pn, idx; };
struct Gemm { const bf16_t* A; const bf16_t* Bt; int M, N, K; };

struct StaticOrder {
    int nM, nN, nwg, G, c;
    __host__ __device__ void init(int M, int N, int G_, int c_) { nM = M / BM; nN = N / BM; nwg = nM * nN; G = G_; c = c_; }
    __host__ __device__ bool next(int i, Unit& u) const {
        const long L = (long)i * G + c; if (L >= nwg) return false;
        int wgid = (int)L; { const int q = nwg / NXCD, r = nwg % NXCD, xcd = wgid % NXCD, off = wgid / NXCD; wgid = (xcd < r ? xcd * (q + 1) : r * (q + 1) + (xcd - r) * q) + off; }
        const int nig = WGM * nN, gid = wgid / nig, fm = gid * WGM, gsz = (nM - fm) < WGM ? (nM - fm) : WGM;
        u.pm = fm + ((wgid % nig) % gsz); u.pn = (wgid % nig) / gsz; u.idx = i; return true;
    }
    __device__ __forceinline__ void a_ready(const Unit&) const {}
    __device__ __forceinline__ void done(const Unit&) const {}
};
__device__ __forceinline__ unsigned cvt_pk_bf16(float lo, float hi) { unsigned r; asm volatile("v_cvt_pk_bf16_f32 %0, %1, %2" : "=v"(r) : "v"(lo), "v"(hi)); return r; }
__device__ __forceinline__ float row_rscale(const float* ss, int row) { const f32x4* p = (const f32x4*)(ss + (size_t)row * 16); const f32x4 a = (p[0] + p[1]) + (p[2] + p[3]);
    return __builtin_amdgcn_rsqf(((a[0] + a[1]) + (a[2] + a[3])) * (1.0f / 1024.0f) + 1e-6f); }
template <bool KSS = false> struct EpiBf16PT {
    static constexpr bool PERM = true, AFTER_DRAIN = false;
    bf16_t* O; int ldc; const PG8_LAS float* rst; float* kss; int mrows;
    __device__ __forceinline__ void operator()(const f32x4 (&acc)[2][2][4][2], const Unit& u, int wr, int wc, int fr, int fq) const {
        const int row0 = u.pm * BM + wr * 64 + fr, col0 = u.pn * BM + wc * 32 + 8 * fq;
        const bool kt = KSS && u.pn >= 4 && u.pn < 8;
#pragma unroll
        for (int ai = 0; ai < 2; ++ai)
#pragma unroll
            for (int m = 0; m < 4; ++m) { const int row = row0 + ai * HALF + m * 16; bf16_t* rowp = O + (size_t)row * ldc + col0; const float rs = rst[u.idx * 256 + wr * 64 + fr + ai * HALF + m * 16];
#pragma unroll
                for (int bj = 0; bj < 2; ++bj) { const f32x4 v0 = acc[ai][bj][m][0] * rs, v1 = acc[ai][bj][m][1] * rs;
                    u32x4 w; w.x = cvt_pk_bf16(v0[0], v0[1]); w.y = cvt_pk_bf16(v0[2], v0[3]); w.z = cvt_pk_bf16(v1[0], v1[1]); w.w = cvt_pk_bf16(v1[2], v1[3]);
                    *(u32x4*)(rowp + bj * HALF) = w;
                    if (kt) { float q = ((v0[0] * v0[0] + v0[1] * v0[1]) + (v0[2] * v0[2] + v0[3] * v0[3])) + ((v1[0] * v1[0] + v1[1] * v1[1]) + (v1[2] * v1[2] + v1[3] * v1[3]));
                        q += __shfl_xor(q, 16); q += __shfl_xor(q, 32);
                        if (fq == 0) kss[(size_t)((u.pn - 4) * 8 + bj * 4 + wc) * mrows + row] = q; } }
                if (KSS) asm volatile("" ::: "memory"); }
    }
};
typedef EpiBf16PT<false> EpiBf16P;
__device__ __forceinline__ float silu_mul(float g, float u) { return g * __builtin_amdgcn_rcpf(1.0f + __expf(-g)) * u; }
struct EpiSwiGLU {
    static constexpr bool PERM = true, AFTER_DRAIN = false;
    bf16_t* H; int ldh; const PG8_LAS float* rst;
    __device__ __forceinline__ void operator()(const f32x4 (&acc)[2][2][4][2], const Unit& u, int wr, int wc, int fr, int fq) const {
        const int row0 = u.pm * BM + wr * 64 + fr, col0 = u.pn * HALF + wc * 32 + 8 * fq;
#pragma unroll
        for (int ai = 0; ai < 2; ++ai)
#pragma unroll
            for (int m = 0; m < 4; ++m) { bf16_t* rowp = H + (size_t)(row0 + ai * HALF + m * 16) * ldh + col0; const float rs = rst[u.idx * 256 + wr * 64 + fr + ai * HALF + m * 16];
                const f32x4 g0 = acc[ai][0][m][0] * rs, g1 = acc[ai][0][m][1] * rs, u0 = acc[ai][1][m][0] * rs, u1 = acc[ai][1][m][1] * rs;
                u32x4 w; w.x = cvt_pk_bf16(silu_mul(g0[0], u0[0]), silu_mul(g0[1], u0[1])); w.y = cvt_pk_bf16(silu_mul(g0[2], u0[2]), silu_mul(g0[3], u0[3]));
                w.z = cvt_pk_bf16(silu_mul(g1[0], u1[0]), silu_mul(g1[1], u1[1])); w.w = cvt_pk_bf16(silu_mul(g1[2], u1[2]), silu_mul(g1[3], u1[3]));
                *(u32x4*)rowp = w; }
    }
};
typedef unsigned u32x2 __attribute__((ext_vector_type(2)));
template <bool LAST = false> struct EpiResNormT {
    static constexpr bool PERM = true, AFTER_DRAIN = false;
    float* out; bf16_t* xb; float* ss; int ldc;
    __device__ __forceinline__ void operator()(const f32x4 (&acc)[2][2][4][2], const Unit& u, int wr, int wc, int fr, int fq) const {
        const int row0 = u.pm * BM + wr * 64 + fr, col0 = u.pn * BM + wc * 32 + 8 * fq;
#pragma unroll
        for (int ai = 0; ai < 2; ++ai)
#pragma unroll
            for (int m = 0; m < 4; ++m) { const int row = row0 + ai * HALF + m * 16; const size_t off = (size_t)row * ldc + col0; float s = 0.f;
#pragma unroll
                for (int bj = 0; bj < 2; ++bj) { const size_t o = off + bj * HALF; const u32x4 b = *(const u32x4*)(xb + o);
                    f32x4 r0, r1;
                    r0[0] = __uint_as_float(b.x << 16) + acc[ai][bj][m][0][0]; r0[1] = __uint_as_float(b.x & 0xffff0000u) + acc[ai][bj][m][0][1];
                    r0[2] = __uint_as_float(b.y << 16) + acc[ai][bj][m][0][2]; r0[3] = __uint_as_float(b.y & 0xffff0000u) + acc[ai][bj][m][0][3];
                    r1[0] = __uint_as_float(b.z << 16) + acc[ai][bj][m][1][0]; r1[1] = __uint_as_float(b.z & 0xffff0000u) + acc[ai][bj][m][1][1];
                    r1[2] = __uint_as_float(b.w << 16) + acc[ai][bj][m][1][2]; r1[3] = __uint_as_float(b.w & 0xffff0000u) + acc[ai][bj][m][1][3];
                    if (LAST) { *(f32x4*)(out + o) = r0; *(f32x4*)(out + o + 4) = r1; }
                    else { s += ((r0[0] * r0[0] + r0[1] * r0[1]) + (r0[2] * r0[2] + r0[3] * r0[3])) + ((r1[0] * r1[0] + r1[1] * r1[1]) + (r1[2] * r1[2] + r1[3] * r1[3]));
                        u32x4 w; w.x = cvt_pk_bf16(r0[0], r0[1]); w.y = cvt_pk_bf16(r0[2], r0[3]); w.z = cvt_pk_bf16(r1[0], r1[1]); w.w = cvt_pk_bf16(r1[2], r1[3]); *(u32x4*)(xb + o) = w; } }
                if (!LAST) { s += __shfl_xor(s, 16); s += __shfl_xor(s, 32); if (fq == 0) ss[(size_t)row * 16 + u.pn * 4 + wc] = s; }
                asm volatile("" ::: "memory"); }
    }
};
typedef EpiResNormT<false> EpiResNorm;
template <class Epi, class Sched, bool ALIGN_EPI = false, bool SP2 = false>
__device__ __forceinline__ void gemm_phase(PG8_LAS unsigned char* lds, const Gemm g, const Sched& S, const Epi& E) {
    const int tid = threadIdx.x, wid = __builtin_amdgcn_readfirstlane(tid >> 6), lane = tid & 63, wr = wid >> 2, wc = wid & 3, fr = lane & 15, fq = lane >> 4;
    const int K = g.K, nt = K / BK;
    unsigned voffA[2], voffB[2];
#pragma unroll
    for (int i = 0; i < 2; ++i) { int R, C; stage_rc(tid * 16 + i * 8192, R, C); const int Rb = Epi::PERM ? ((R & ~31) + perm32(R & 31)) : R;
        voffA[i] = (unsigned)(R * K + C) * 2u; voffB[i] = (unsigned)(Rb * K + C) * 2u; }
    const size_t kstep = (size_t)(BK * 2);
    const size_t hstep = (size_t)HALF * K * 2;
    const size_t tstep = 2 * hstep;
    const unsigned ldsw = (unsigned)wid * 1024u;
    const int aoff = lds_byte(wr * 64 + fr, fq * 8), boff = lds_byte(wc * 32 + fr, fq * 8);
#define PG8_SA(b, h) (((b) * 2 + (h)) * HTB)
#define PG8_SB(b, h) ((4 + (b) * 2 + (h)) * HTB)
#define PG8_STAGE(bufoff, gbase, voff) do { _Pragma("unroll") for (int _i = 0; _i < 2; ++_i) \
        __builtin_amdgcn_global_load_lds((const unsigned*)((const char*)(gbase) + (voff)[_i]), (PG8_LAS unsigned*)(lds + (bufoff) + ldsw + _i * 8192), 16, 0, 0); } while (0)
#define PG8_LDA(dst, b, h) do { _Pragma("unroll") for (int m = 0; m < 4; ++m) _Pragma("unroll") for (int k = 0; k < 2; ++k) dst[m][k] = *(const PG8_LAS bf16x8*)(lds + PG8_SA(b, h) + aoff + m * 2048 + k * 1024); } while (0)
#define PG8_LDB(dst, b, h) do { _Pragma("unroll") for (int n = 0; n < 2; ++n) _Pragma("unroll") for (int k = 0; k < 2; ++k) dst[n][k] = *(const PG8_LAS bf16x8*)(lds + PG8_SB(b, h) + boff + n * 2048 + k * 1024); } while (0)
#define PG8_MMA(ai, bj, At, Bt) do { __builtin_amdgcn_s_setprio(1); _Pragma("unroll") for (int m = 0; m < 4; ++m) _Pragma("unroll") for (int n = 0; n < 2; ++n) _Pragma("unroll") for (int k = 0; k < 2; ++k) \
        acc[ai][bj][m][n] = __builtin_amdgcn_mfma_f32_16x16x32_bf16(Bt[n][k], At[m][k], acc[ai][bj][m][n], 0, 0, 0); __builtin_amdgcn_s_setprio(0); } while (0)
#define PG8_WAIT_V(n) asm volatile("s_waitcnt vmcnt(" #n ")" ::: "memory")
#define PG8_WAIT_L(n) asm volatile("s_waitcnt lgkmcnt(" #n ")" ::: "memory")
#define PG8_BAR __builtin_amdgcn_s_barrier()
#define PG8_SCHED __builtin_amdgcn_sched_barrier(0)
    Unit cur, nxt; int ui = 0;
    if (!S.next(0, cur)) return;
    f32x4 acc[2][2][4][2];
#pragma unroll
    for (int a = 0; a < 2; ++a)
#pragma unroll
        for (int b = 0; b < 2; ++b)
#pragma unroll
            for (int m = 0; m < 4; ++m)
#pragma unroll
                for (int n = 0; n < 2; ++n) acc[a][b][m][n] = (f32x4){0.f, 0.f, 0.f, 0.f};
    bf16x8 At[4][2], B0[2][2], B1[2][2];
    const char* cA = (const char*)g.A + (size_t)cur.pm * tstep; const char* cB = (const char*)g.Bt + (size_t)cur.pn * tstep;
    S.a_ready(cur);
    if constexpr (SP2) {
        PG8_STAGE(PG8_SB(0, 0), cB, voffB); PG8_STAGE(PG8_SB(0, 1), cB + hstep, voffB); PG8_STAGE(PG8_SA(0, 0), cA, voffA); PG8_STAGE(PG8_SA(0, 1), cA + hstep, voffA);
        if (wr == 1) PG8_BAR;
        PG8_WAIT_V(2); PG8_BAR;
        PG8_STAGE(PG8_SB(1, 0), cB + kstep, voffB); PG8_STAGE(PG8_SA(1, 0), cA + kstep, voffA); PG8_STAGE(PG8_SB(1, 1), cB + hstep + kstep, voffB);
        PG8_WAIT_V(6); PG8_BAR;
    } else {
        PG8_STAGE(PG8_SB(0, 0), cB, voffB); PG8_STAGE(PG8_SA(0, 0), cA, voffA); PG8_STAGE(PG8_SB(0, 1), cB + hstep, voffB); PG8_STAGE(PG8_SA(0, 1), cA + hstep, voffA);
        if (wr == 1) PG8_BAR;
        PG8_WAIT_V(4); PG8_BAR;
        PG8_STAGE(PG8_SB(1, 0), cB + kstep, voffB); PG8_STAGE(PG8_SA(1, 0), cA + kstep, voffA); PG8_STAGE(PG8_SB(1, 1), cB + hstep + kstep, voffB);
        PG8_WAIT_V(6); PG8_BAR;
    }
    for (;;) {
        const bool has_next = S.next(ui + 1, nxt);
        const char* nA = has_next ? (const char*)g.A + (size_t)nxt.pm * tstep : cA; const char* nB = has_next ? (const char*)g.Bt + (size_t)nxt.pn * tstep : cB;
        for (int t = 0; t < nt; t += 2) {
            const bool last = (t == nt - 2);
            const char* a1 = cA + (size_t)(t + 1) * kstep;
            const char* a2 = last ? nA : cA + (size_t)(t + 2) * kstep; const char* b2 = last ? nB : cB + (size_t)(t + 2) * kstep;
            const char* a3 = a2 + kstep; const char* b3 = b2 + kstep;
            if (last && has_next) S.a_ready(nxt);
            if constexpr (SP2) {
            PG8_LDB(B0, 0, 0); PG8_LDB(B1, 0, 1); PG8_SCHED; PG8_LDA(At, 0, 0); PG8_STAGE(PG8_SA(1, 1), a1 + hstep, voffA);
            PG8_WAIT_V(8); PG8_WAIT_L(0); PG8_BAR; PG8_MMA(0, 0, At, B0); PG8_MMA(0, 1, At, B1); PG8_BAR; PG8_SCHED;
            PG8_LDA(At, 0, 1); PG8_STAGE(PG8_SB(0, 0), b2, voffB); PG8_STAGE(PG8_SB(0, 1), b2 + hstep, voffB); PG8_STAGE(PG8_SA(0, 0), a2, voffA);
            PG8_WAIT_V(8); PG8_WAIT_L(0); PG8_BAR; PG8_MMA(1, 0, At, B0); PG8_MMA(1, 1, At, B1); PG8_BAR; PG8_SCHED;
            PG8_LDB(B0, 1, 0); PG8_LDB(B1, 1, 1); PG8_SCHED; PG8_LDA(At, 1, 0); PG8_STAGE(PG8_SA(0, 1), a2 + hstep, voffA);
            PG8_WAIT_V(8); PG8_WAIT_L(0); PG8_BAR; PG8_MMA(0, 0, At, B0); PG8_MMA(0, 1, At, B1); PG8_BAR; PG8_SCHED;
            PG8_LDA(At, 1, 1); PG8_STAGE(PG8_SB(1, 0), b3, voffB); PG8_STAGE(PG8_SB(1, 1), b3 + hstep, voffB); PG8_STAGE(PG8_SA(1, 0), a3, voffA);
            PG8_WAIT_V(8); PG8_WAIT_L(0); PG8_BAR; PG8_MMA(1, 0, At, B0); PG8_MMA(1, 1, At, B1); PG8_BAR; PG8_SCHED;
            } else {
            PG8_LDB(B0, 0, 0); PG8_SCHED; PG8_LDA(At, 0, 0); PG8_STAGE(PG8_SA(1, 1), a1 + hstep, voffA);
            PG8_WAIT_L(8); PG8_BAR; PG8_WAIT_L(0); PG8_MMA(0, 0, At, B0); PG8_BAR; PG8_SCHED;
            PG8_LDB(B1, 0, 1); PG8_STAGE(PG8_SB(0, 0), b2, voffB);
            PG8_BAR; PG8_WAIT_L(0); PG8_MMA(0, 1, At, B1); PG8_BAR;
            PG8_LDA(At, 0, 1); PG8_STAGE(PG8_SA(0, 0), a2, voffA);
            PG8_BAR; PG8_WAIT_L(0); PG8_MMA(1, 0, At, B0); PG8_BAR; PG8_SCHED;
            PG8_STAGE(PG8_SB(0, 1), b2 + hstep, voffB);
            PG8_WAIT_V(6); PG8_BAR; PG8_MMA(1, 1, At, B1); PG8_BAR;
            PG8_LDB(B0, 1, 0); PG8_SCHED; PG8_LDA(At, 1, 0); PG8_STAGE(PG8_SA(0, 1), a2 + hstep, voffA);
            PG8_WAIT_L(8); PG8_BAR; PG8_WAIT_L(0); PG8_MMA(0, 0, At, B0); PG8_BAR; PG8_SCHED;
            PG8_LDB(B1, 1, 1); PG8_STAGE(PG8_SB(1, 0), b3, voffB);
            PG8_BAR; PG8_WAIT_L(0); PG8_MMA(0, 1, At, B1); PG8_BAR;
            PG8_LDA(At, 1, 1); PG8_STAGE(PG8_SA(1, 0), a3, voffA);
            PG8_BAR; PG8_WAIT_L(0); PG8_MMA(1, 0, At, B0); PG8_BAR; PG8_SCHED;
            PG8_STAGE(PG8_SB(1, 1), b3 + hstep, voffB);
            PG8_WAIT_V(6); PG8_BAR; PG8_MMA(1, 1, At, B1); PG8_BAR;
            }
        }
        if constexpr (ALIGN_EPI) { if (wr == 0) PG8_BAR; }
        if constexpr (!Epi::AFTER_DRAIN) { E(acc, cur, wr, wc, fr, fq); S.done(cur); }
        if (!has_next) break;
#pragma unroll
        for (int a = 0; a < 2; ++a)
#pragma unroll
            for (int b = 0; b < 2; ++b)
#pragma unroll
                for (int m = 0; m < 4; ++m)
#pragma unroll
                    for (int n = 0; n < 2; ++n) acc[a][b][m][n] = (f32x4){0.f, 0.f, 0.f, 0.f};
        cur = nxt; cA = nA; cB = nB; ++ui;
        if constexpr (ALIGN_EPI) { if (wr == 1) PG8_BAR; }
    }
    PG8_WAIT_V(0);
    if constexpr (!ALIGN_EPI) { if (wr == 0) PG8_BAR; }
    PG8_BAR;
    if constexpr (Epi::AFTER_DRAIN) { E.fused(acc, cur, wr, wc, fr, fq, lds, wid, lane); S.done(cur); }
#undef PG8_SA
#undef PG8_SB
#undef PG8_STAGE
#undef PG8_LDA
#undef PG8_LDB
#undef PG8_MMA
#undef PG8_WAIT_V
#undef PG8_WAIT_L
#undef PG8_BAR
#undef PG8_SCHED
}
}

#ifndef MK_N_LAUNCHES
#define MK_N_LAUNCHES 1
#endif
constexpr int NB = 16, SEQ = 2048, DM = 1024, MTOK = NB * SEQ, NQKV = 3072, FFH = 2816, NW13 = 2 * FFH, NLAYER = 4;
constexpr float RMS_EPS = 1e-6f;
constexpr int NWAVES = 8, NTHREADS = 512;
constexpr size_t MiB = 1u << 20;
constexpr size_t WS_W = 1 * MiB, W_LAYER = 49 * MiB / 2;
constexpr size_t W_IN = 0, W_OUT = 6 * MiB, W_13 = 8 * MiB, W_2 = 19 * MiB;
constexpr size_t WS_SS = 439 * MiB;
constexpr size_t WS_HID = 100 * MiB;
constexpr size_t WS_KF = 102 * MiB;
constexpr int KF_LEN = 4112;
constexpr size_t WS_XN = 119 * MiB;
constexpr size_t WS_MIXO = 183 * MiB;
constexpr size_t WS_BIG = 247 * MiB;
constexpr size_t WS_VT = 441 * MiB;
constexpr size_t WS_KSS = 505 * MiB;
constexpr size_t WS_END = 509 * MiB;
constexpr int MISC_OFF = 163776, RST_OFF = 131072;
constexpr size_t WS_BAR = 16384, CTL_ZERO_BYTES = 65536;
constexpr int LDS_BYTES = 163840;
#define LAS __attribute__((address_space(3)))
typedef unsigned short bf16;
typedef unsigned v4u __attribute__((ext_vector_type(4)));
typedef unsigned v2u __attribute__((ext_vector_type(2)));
typedef float f32x4 __attribute__((ext_vector_type(4)));
typedef short bf16x8 __attribute__((ext_vector_type(8)));
typedef short v4i16_t __attribute__((ext_vector_type(4)));
#define LDS_WAIT() asm volatile("s_waitcnt lgkmcnt(0)" ::: "memory")
typedef float f32x2_cv __attribute__((ext_vector_type(2))); typedef __bf16 bf16x2_cv __attribute__((ext_vector_type(2)));
__device__ __forceinline__ unsigned pk2c(float lo, float hi) { const f32x2_cv v = {lo, hi}; const bf16x2_cv b = __builtin_convertvector(v, bf16x2_cv); return __builtin_bit_cast(unsigned, b); }
__device__ __forceinline__ unsigned pk2(float lo, float hi) { return pg8::cvt_pk_bf16(lo, hi); }
__device__ __forceinline__ float bflo(unsigned w) { return __uint_as_float(w << 16); }
__device__ __forceinline__ float bfhi(unsigned w) { return __uint_as_float(w & 0xffff0000u); }
__device__ __forceinline__ float bf2f(unsigned short b) { return __uint_as_float(((unsigned)b) << 16); }
__device__ __forceinline__ unsigned short f2bf(float f) { return (unsigned short)(pk2(f, 0.f) & 0xffffu); }
__device__ __forceinline__ float wave_sum(float v) {
#pragma unroll
    for (int o = 1; o < 64; o <<= 1) v += __shfl_xor(v, o);
    return v;
}

#define RLX_AGENT __ATOMIC_RELAXED, __HIP_MEMORY_SCOPE_AGENT
#define XB_TMO      128
#define XB_XCNT(j)  (256  + 64 * (j))
#define XB_XSUB(j)  (1280 + 64 * (j))
#define XB_XGEN(j)  (2304 + 64 * (j))
#define XB_TOP      3328
#define XB_TOPGEN   3392
#define XCD_BAR_WORDS 3456
#define XB_SPIN_CAP (1u << 18)

__device__ __forceinline__ unsigned xb_ld(unsigned* p)              { return __hip_atomic_load(p, __ATOMIC_RELAXED, __HIP_MEMORY_SCOPE_AGENT); }
__device__ __forceinline__ unsigned xb_add(unsigned* p, unsigned v) { return __hip_atomic_fetch_add(p, v, __ATOMIC_RELAXED, __HIP_MEMORY_SCOPE_AGENT); }
__device__ __forceinline__ unsigned xb_xcc_id() { return (unsigned)__builtin_amdgcn_s_getreg((3 << 11) | 20) & 0xFu; }
#define XB_SPIN(cond, bar) do { unsigned _sp = 0; while (cond) { __builtin_amdgcn_s_sleep(1); \
    if ((++_sp & 255u) == 0u) { if (xb_ld(&(bar)[XB_TMO])) break; if (_sp > XB_SPIN_CAP) { atomicAdd(&(bar)[XB_TMO], 1u); break; } } } } while (0)

struct XcdBarrier {
    unsigned* bar; unsigned x;
    volatile LAS unsigned* st;
};

__device__ __forceinline__ XcdBarrier xcd_barrier_post(unsigned* bar, volatile LAS unsigned* st) {
    XcdBarrier b; b.bar = bar; b.x = xb_xcc_id(); b.st = st;
    if (threadIdx.x == 0) (void)xb_add(&bar[XB_XCNT(b.x)], 1u);
    return b;
}
__device__ __forceinline__ void xcd_barrier_complete(unsigned* bar, unsigned x, unsigned& nloc, unsigned& nx) {
    const unsigned G = gridDim.x * gridDim.y * gridDim.z;
    unsigned sum, cnt, mine, sp = 0u;
    for (;;) {
        sum = 0u; cnt = 0u; mine = 0u;
#pragma unroll
        for (unsigned j = 0; j < 16; ++j) { const unsigned c = xb_ld(&bar[XB_XCNT(j)]); sum += c; cnt += (c > 0u) ? 1u : 0u; mine = (j == x) ? c : mine; }
        if (sum == G) break;
        __builtin_amdgcn_s_sleep(1);
        if ((++sp & 255u) == 0u) { if (xb_ld(&bar[XB_TMO])) break; if (sp > XB_SPIN_CAP) { atomicAdd(&bar[XB_TMO], 1u); break; } }
    }
    nloc = mine > 0u ? mine : 1u; nx = cnt > 0u ? cnt : 1u;
}

__device__ __forceinline__ void xcd_barrier(const XcdBarrier& b) {
    asm volatile("s_waitcnt vmcnt(0)" ::: "memory");
    __syncthreads();
    if (threadIdx.x == 0) {
        unsigned* bar = b.bar;
        __builtin_amdgcn_s_waitcnt(0);
        unsigned nloc = b.st[0], nx = b.st[1];
        if (nloc == 0u) { xcd_barrier_complete(bar, b.x, nloc, nx); b.st[0] = nloc; b.st[1] = nx; }
        const unsigned old = xb_add(&bar[XB_XSUB(b.x)], 1u);
        const unsigned gen = old / nloc;
        if (old + 1u == (gen + 1u) * nloc) {
            __builtin_amdgcn_fence(__ATOMIC_RELEASE, "agent");
            asm volatile("s_waitcnt vmcnt(0)" ::: "memory");
            const unsigned og = xb_add(&bar[XB_TOP], 1u);
            const unsigned tg = og / nx;
            if (og + 1u == (tg + 1u) * nx) xb_add(&bar[XB_TOPGEN], 1u);
            else XB_SPIN(xb_ld(&bar[XB_TOPGEN]) == tg, bar);
            __builtin_amdgcn_fence(__ATOMIC_ACQUIRE, "agent");
            xb_add(&bar[XB_XGEN(b.x)], 1u);
            asm volatile("s_waitcnt vmcnt(0)" ::: "memory");
        } else {
            XB_SPIN(xb_ld(&bar[XB_XGEN(b.x)]) == gen, bar);
            __builtin_amdgcn_fence(__ATOMIC_ACQUIRE, "agent");
            asm volatile("s_waitcnt vmcnt(0)" ::: "memory");
        }
    }
    __syncthreads();
}

__device__ __forceinline__ void transpose_item(const float* __restrict__ W, int K, int N, const float* __restrict__ gain, bf16* WT, int dst_row0, LAS float* scr, int k0, int n0, int lane) {
    float tv[32];
#pragma unroll
    for (int i = 0; i < 32; ++i) { const int kk = 2 * i + (lane >> 5); tv[i] = W[(size_t)(k0 + kk) * N + n0 + (lane & 31)]; }
#pragma unroll
    for (int i = 0; i < 32; ++i) { const int kk = 2 * i + (lane >> 5); float v = tv[i]; if (gain) v *= gain[k0 + kk]; scr[kk * 33 + (lane & 31)] = v; }
    LDS_WAIT();
    const int c = lane & 7;
#pragma unroll
    for (int j = 0; j < 4; ++j) { const int n = (lane >> 3) + 8 * j; const LAS float* s = scr + (8 * c) * 33 + n;
        v4u o; o.x = pk2(s[0 * 33], s[1 * 33]); o.y = pk2(s[2 * 33], s[3 * 33]); o.z = pk2(s[4 * 33], s[5 * 33]); o.w = pk2(s[6 * 33], s[7 * 33]);
        *(v4u*)(WT + (size_t)(dst_row0 + n) * K + k0 + 8 * c) = o; }
    LDS_WAIT();
}

struct Args { const float* in[24]; float* out; unsigned char* ws; int ph_lo, ph_hi; };

__device__ __forceinline__ void phase_prologue(const Args& a, LAS unsigned char* lds, int gw, int ngw, int wave, int lane) {
    LAS float* scr = (LAS float*)(lds + wave * 16384);
    constexpr int I_IN = 16 * 96, I_OUT = 16 * 32, I_13 = 16 * 176, I_2 = 44 * 32, I_L = I_IN + I_OUT + I_13 + I_2;
    for (int it = gw; it < NLAYER * I_L; it += ngw) {
        const int L = it / I_L; int r = it - L * I_L;
        const float* win = (L == 1) ? a.in[6] : (L == 2) ? a.in[11] : (L == 0 ? a.in[3] : a.in[3] + (size_t)DM * NQKV);
        const float* wout = (L == 1) ? a.in[10] : (L == 2) ? a.in[21] : (L == 0 ? a.in[5] : a.in[5] + (size_t)DM * DM);
        bf16* wl = (bf16*)(a.ws + WS_W + (size_t)L * W_LAYER);
        if (r < I_IN) { const int kb = r / 96, nb = r % 96; transpose_item(win, DM, NQKV, a.in[1] + L * DM, wl + W_IN / 2, 32 * nb, scr, 64 * kb, 32 * nb, lane); continue; }
        r -= I_IN;
        if (r < I_OUT) { const int kb = r / 32, nb = r % 32; transpose_item(wout, DM, DM, nullptr, wl + W_OUT / 2, 32 * nb, scr, 64 * kb, 32 * nb, lane); continue; }
        r -= I_OUT;
        if (r < I_13) { const int kb = r / 176, nb = r % 176, n0 = 32 * nb, half = n0 / FFH, j = n0 % FFH, dst = 256 * (j / 128) + 128 * half + (j % 128);
            transpose_item(a.in[22] + (size_t)L * DM * NW13, DM, NW13, a.in[2] + L * DM, wl + W_13 / 2, dst, scr, 64 * kb, n0, lane); continue; }
        r -= I_13;
        { const int kb = r / 32, nb = r % 32; transpose_item(a.in[23] + (size_t)L * FFH * DM, FFH, DM, nullptr, wl + W_2 / 2, 32 * nb, scr, 64 * kb, 32 * nb, lane); }
    }
    const float* w1 = a.in[14]; const float* b1 = a.in[15]; const float* w2 = a.in[16]; const float* b2 = a.in[17]; const float* fr = a.in[19];
    float* hid = (float*)(a.ws + WS_HID);
    for (int t = gw; t < SEQ; t += ngw) {
        float zv = 0.f;
        if (lane == 0) zv = (float)t / (float)(SEQ - 1);
        else if (lane <= 32) { const int k = (lane - 1) & 15; const float band = 1e-4f + (float)k * ((15.0f - 1e-4f) / 15.0f);
            const float ang = ((6.283185307179586f * (float)t) / (float)SEQ) * band; zv = (lane <= 16) ? cosf(ang) : -sinf(ang); }
        float a1 = b1[lane];
        for (int e = 0; e < 33; ++e) a1 += __shfl(zv, e) * w1[e * 64 + lane];
        const float f = fr[lane];
        const float h1 = sinf(f * a1);
        float a2 = b2[lane];
        for (int i = 0; i < 64; ++i) a2 += __shfl(h1, i) * w2[i * 64 + lane];
        hid[t * 64 + lane] = sinf(f * a2);
    }
}

__device__ __forceinline__ void phase_filters(const Args& a, LAS unsigned char* lds, int vcu, int G, int wave, int lane, int tid) {
    const float* hid = (const float*)(a.ws + WS_HID); const float* w3 = a.in[18]; bf16* KF = (bf16*)(a.ws + WS_KF);
    constexpr int HS = 272;
    for (int p0 = vcu * NWAVES; p0 < 2 * DM; p0 += G * NWAVES) {
        const int p = p0 + wave, o = p >> 10, d = p & 1023, cf = o * 2048 + d, cr = cf + 1024;
        const float delta = 4.605170185988091f * (1.0f / 1.5f + (float)d * ((1.0f / 0.3f - 1.0f / 1.5f) / 1023.0f));
        bf16* kf = KF + (size_t)p * KF_LEN;
        LAS float* wcol = (LAS float*)(lds + 17408 + NWAVES * 16384 + wave * 512);
        wcol[lane] = w3[(size_t)lane * 4096 + cf]; wcol[64 + lane] = w3[(size_t)lane * 4096 + cr];
        float asum = 0.f;
        LAS float* vals = (LAS float*)(lds + 17408 + wave * 16384);
        v4u hreg[2];
#pragma unroll
        for (int i = 0; i < 2; ++i) { const int idx = tid + 512 * i; hreg[i] = *(const v4u*)(hid + (size_t)(idx >> 4) * 64 + (idx & 15) * 4); }
#pragma unroll 1
        for (int tb = 0; tb < 32; ++tb) {
            __syncthreads();
#pragma unroll
            for (int i = 0; i < 2; ++i) { const int idx = tid + 512 * i; *(LAS v4u*)(lds + (idx >> 4) * HS + (idx & 15) * 16) = hreg[i]; }
            if (tb < 31) {
#pragma unroll
                for (int i = 0; i < 2; ++i) { const int idx = tid + 512 * i; hreg[i] = *(const v4u*)(hid + (size_t)((tb + 1) * 64 + (idx >> 4)) * 64 + (idx & 15) * 4); } }
            __syncthreads();
            const int t = tb * 64 + lane; const LAS f32x4* hr = (const LAS f32x4*)(lds + lane * HS);
            float af = 0.f, ar = 0.f;
#pragma unroll
            for (int j4 = 0; j4 < 16; ++j4) { const f32x4 h = hr[j4]; const f32x4 a4 = ((const LAS f32x4*)wcol)[j4], b4 = ((const LAS f32x4*)wcol)[16 + j4];
                af += h[0] * a4[0] + h[1] * a4[1] + h[2] * a4[2] + h[3] * a4[3];
                ar += h[0] * b4[0] + h[1] * b4[1] + h[2] * b4[2] + h[3] * b4[3]; }
            const float dec = __expf(-((float)t / (float)(SEQ - 1)) * delta);
            af *= dec; ar *= dec; vals[(2 * tb) * 64 + lane] = af; vals[(2 * tb + 1) * 64 + lane] = ar;
            asum += (t == 0) ? fabsf(af + ar) : (fabsf(af) + fabsf(ar));
        }
        const float inv = 1.0f / wave_sum(asum);
#pragma unroll 4
        for (int tb = 0; tb < 32; ++tb) { const int t = tb * 64 + lane; const float vf = vals[(2 * tb) * 64 + lane], vr = vals[(2 * tb + 1) * 64 + lane];
            if (t == 0) kf[2048] = f2bf((vf + vr) * inv); else { kf[2048 - t] = f2bf(vf * inv); kf[2048 + t] = f2bf(vr * inv); } }
        if (lane < 17) kf[lane == 0 ? 0 : 4095 + lane] = 0;
    }
    __syncthreads();
}

__device__ __forceinline__ void phase_norm0(const float* __restrict__ x, bf16* __restrict__ xn, float* __restrict__ ss, int gw, int ngw, int lane) {
    for (int m = gw; m < MTOK; m += ngw) {
        const f32x4* xr = (const f32x4*)(x + (size_t)m * DM) + lane;
        f32x4 v[4]; float s = 0.f;
#pragma unroll
        for (int j = 0; j < 4; ++j) { v[j] = xr[64 * j]; s += (v[j].x * v[j].x + v[j].y * v[j].y) + (v[j].z * v[j].z + v[j].w * v[j].w); }
        s = wave_sum(s);
        if (lane < 16) ss[(size_t)m * 16 + lane] = (lane == 0) ? s : 0.f;
        unsigned long long* o8 = (unsigned long long*)(xn + (size_t)m * DM) + lane;
#pragma unroll
        for (int j = 0; j < 4; ++j) o8[64 * j] = (unsigned long long)pk2(v[j].x, v[j].y) | ((unsigned long long)pk2(v[j].z, v[j].w) << 32);
    }
}

__device__ __forceinline__ void fill_row_scales(const pg8::StaticOrder& S, const float* ss, LAS float* rst, int tid) {
    for (int idx = tid; idx < 11 * 256; idx += NTHREADS) { pg8::Unit u; if (!S.next(idx >> 8, u)) break; rst[idx] = pg8::row_rscale(ss, u.pm * 256 + (idx & 255)); }
    __syncthreads();
}

__device__ __forceinline__ void phase_shortconv(const bf16* __restrict__ big, const float* __restrict__ cw, bf16* __restrict__ outp, int gtid, int ngt) {
    for (int idx = gtid; idx < MTOK * 128; idx += ngt) {
        const int m = idx >> 7, d0 = (idx & 127) * 8, t = m & (SEQ - 1);
        const bf16* row = big + (size_t)m * NQKV + d0;
        const v4u bv = *(const v4u*)row, c1 = *(const v4u*)(row + DM), u1 = *(const v4u*)(row + 2 * DM);
        v4u c0 = {0u, 0u, 0u, 0u}, u0 = c0, c2 = c0, u2 = c0;
        if (t > 0) { c0 = *(const v4u*)(row - NQKV + DM); u0 = *(const v4u*)(row - NQKV + 2 * DM); }
        if (t < SEQ - 1) { c2 = *(const v4u*)(row + NQKV + DM); u2 = *(const v4u*)(row + NQKV + 2 * DM); }
        const f32x4 wa0 = *(const f32x4*)(cw + d0), wa1 = *(const f32x4*)(cw + d0 + 4), wb0 = *(const f32x4*)(cw + DM + d0), wb1 = *(const f32x4*)(cw + DM + d0 + 4),
                    wc0 = *(const f32x4*)(cw + 2 * DM + d0), wc1 = *(const f32x4*)(cw + 2 * DM + d0 + 4);
        v4u o;
#pragma unroll
        for (int k = 0; k < 4; ++k) {
            const float w0l = (k < 2) ? wa0[2 * k] : wa1[2 * k - 4], w0h = (k < 2) ? wa0[2 * k + 1] : wa1[2 * k - 3];
            const float w1l = (k < 2) ? wb0[2 * k] : wb1[2 * k - 4], w1h = (k < 2) ? wb0[2 * k + 1] : wb1[2 * k - 3];
            const float w2l = (k < 2) ? wc0[2 * k] : wc1[2 * k - 4], w2h = (k < 2) ? wc0[2 * k + 1] : wc1[2 * k - 3];
            const float lo = bflo(bv[k]) * (w0l * (bflo(c0[k]) * bflo(u0[k])) + w1l * (bflo(c1[k]) * bflo(u1[k])) + w2l * (bflo(c2[k]) * bflo(u2[k])));
            const float hi = bfhi(bv[k]) * (w0h * (bfhi(c0[k]) * bfhi(u0[k])) + w1h * (bfhi(c1[k]) * bfhi(u1[k])) + w2h * (bfhi(c2[k]) * bfhi(u2[k])));
            o[k] = pk2(lo, hi);
        }
        *(v4u*)(outp + (size_t)m * DM + d0) = o;
    }
}

__device__ __forceinline__ void norm_frag(const v4u r0, const v4u r1, const LAS float* g, int quad, float extra, bf16x8& f0, bf16x8& f1) {
    float x[16];
#pragma unroll
    for (int k = 0; k < 4; ++k) { x[2 * k] = bflo(r0[k]); x[2 * k + 1] = bfhi(r0[k]); x[8 + 2 * k] = bflo(r1[k]); x[9 + 2 * k] = bfhi(r1[k]); }
    float ss = 0.f;
#pragma unroll
    for (int k = 0; k < 16; ++k) ss += x[k] * x[k];
    ss += __shfl_xor(ss, 16); ss += __shfl_xor(ss, 32);
    const float r = rsqrtf(ss * (1.0f / 64.0f) + RMS_EPS) * extra;
    v4u o0, o1;
#pragma unroll
    for (int k = 0; k < 4; ++k) { o0[k] = pk2c(x[2 * k] * r * g[8 * quad + 2 * k], x[2 * k + 1] * r * g[8 * quad + 2 * k + 1]);
        o1[k] = pk2c(x[8 + 2 * k] * r * g[32 + 8 * quad + 2 * k], x[9 + 2 * k] * r * g[32 + 8 * quad + 2 * k + 1]); }
    f0 = __builtin_bit_cast(bf16x8, o0); f1 = __builtin_bit_cast(bf16x8, o1);
}

constexpr int AR_SLOT = 16640, AR_V = 8192, AR_RK = 16384, AR_NSLOT = 9, AR_RPB = AR_NSLOT * AR_SLOT, AR_G = AR_RPB + 1920;
__device__ __forceinline__ int ar_off(int k, int c) { return k * 128 + ((c ^ (k & 7)) << 4); }

constexpr int A3_NSLOT = 8, A3_RPB = A3_NSLOT * AR_SLOT, A3_G = A3_RPB + 1920, A3_CMB = A3_G + 256, A3_CMB_BYTES = 4608;
static_assert(A3_CMB + 4 * A3_CMB_BYTES <= MISC_OFF, "attention LDS map");
__device__ __forceinline__ void phase_natten3(const bf16* qkv, const float* qg, const float* kg, const float* rpb, const float* kss, bf16* outp, LAS unsigned char* lds, int vcu, int G, int wave, int lane, int tid) {
    LAS float* rpb_l = (LAS float*)(lds + A3_RPB); LAS float* g_l = (LAS float*)(lds + A3_G);
    const int n = lane & 15, quad = lane >> 4, qq = (lane >> 2) & 3, p = lane & 3;
    const int cb = wave & 3, kh = wave >> 2;
    LAS unsigned char* cmb = lds + A3_CMB + cb * A3_CMB_BYTES;
    const int lk = (tid >> 3) & 63, lc = tid & 7;
    for (int unit = vcu; unit < NB * 16; unit += G) {
        const int b = unit >> 4, h = unit & 15;
        const bf16* kvbase = qkv + (size_t)b * SEQ * NQKV + DM + h * 64 + lc * 8 + (size_t)lk * NQKV;
        const float* ksbase = kss + (size_t)(2 * h) * MTOK + (size_t)b * SEQ + tid;
        __syncthreads();
        for (int i = tid; i < 15 * 31; i += NTHREADS) rpb_l[i] = rpb[h * (15 * 31) + i];
        if (tid < 64) g_l[tid] = qg[tid] * kg[tid];
        {   v4u rk_[8], rv_[8]; float rs_[8];
#pragma unroll
            for (int rho = 0; rho < 8; ++rho) { const bf16* pp = kvbase + (size_t)rho * 64 * NQKV; rk_[rho] = *(const v4u*)pp; rv_[rho] = *(const v4u*)(pp + DM);
                rs_[rho] = (tid < 64) ? ksbase[rho * 64] + ksbase[MTOK + rho * 64] : 0.f; }
#pragma unroll
            for (int rho = 0; rho < 8; ++rho) { LAS unsigned char* slot = lds + rho * AR_SLOT; *(LAS v4u*)(slot + ar_off(lk, lc)) = rk_[rho]; *(LAS v4u*)(slot + AR_V + ar_off(lk, lc)) = rv_[rho];
                if (tid < 64) *(LAS float*)(slot + AR_RK + 4 * tid) = __builtin_amdgcn_rsqf(rs_[rho] * (1.0f / 64.0f) + RMS_EPS); } }
        int start = cb * 16 - 8; start = start < 0 ? 0 : (start > 32 ? 32 : start);
        const int qc = cb * 16 + n; int cs = qc - 8; cs = cs < 0 ? 0 : (cs > 48 ? 48 : cs);
        const bf16* qbase = qkv + (size_t)(b * SEQ + cb * 16 + n) * NQKV + h * 64 + 8 * quad;
        v4u qr0 = *(const v4u*)qbase, qr1 = *(const v4u*)(qbase + 32);
        __syncthreads();
#pragma unroll 1
        for (int r = 0; r < 32; ++r) {
            int rs = r - 4; rs = rs < 0 ? 0 : (rs > 24 ? 24 : rs);
            int rsn = r - 3; rsn = rsn < 0 ? 0 : (rsn > 24 ? 24 : rsn);
            const bool slide = (r < 31) && (rsn != rs);
            v4u nk = {0u, 0u, 0u, 0u}, nv = nk; float nss = 0.f;
            if (slide) { const bf16* pp = kvbase + (size_t)(rs + 8) * 64 * NQKV; nk = *(const v4u*)pp; nv = *(const v4u*)(pp + DM); if (tid < 64) nss = ksbase[(rs + 8) * 64] + ksbase[MTOK + (rs + 8) * 64]; }
            bf16x8 qf0, qf1;
            norm_frag(qr0, qr1, g_l, quad, 0.125f, qf0, qf1);
            if (r < 31) { const bf16* qp = qbase + (size_t)(r + 1) * 64 * NQKV; qr0 = *(const v4u*)qp; qr1 = *(const v4u*)(qp + 32); }
            f32x4 st[4][2];
#pragma unroll
            for (int jj = 0; jj < 4; ++jj) { const LAS unsigned char* slot = lds + ((rs + 4 * kh + jj) & 7) * AR_SLOT;
#pragma unroll
                for (int kt = 0; kt < 2; ++kt) { const int k = start + 16 * kt + n;
                    const bf16x8 kf0 = *(const LAS bf16x8*)(slot + ar_off(k, quad)), kf1 = *(const LAS bf16x8*)(slot + ar_off(k, quad + 4));
                    f32x4 sacc = {0.f, 0.f, 0.f, 0.f};
                    sacc = __builtin_amdgcn_mfma_f32_16x16x32_bf16(kf0, qf0, sacc, 0, 0, 0);
                    sacc = __builtin_amdgcn_mfma_f32_16x16x32_bf16(kf1, qf1, sacc, 0, 0, 0);
                    st[jj][kt] = sacc; } }
            float mx = -3.0e38f;
#pragma unroll
            for (int jj = 0; jj < 4; ++jj) { const int dr = rs + 4 * kh + jj - r + 7; const LAS unsigned char* slot = lds + ((rs + 4 * kh + jj) & 7) * AR_SLOT;
#pragma unroll
                for (int kt = 0; kt < 2; ++kt) { const f32x4 rk = *(const LAS f32x4*)(slot + AR_RK + 4 * (start + 16 * kt + 4 * quad));
#pragma unroll
                    for (int i = 0; i < 4; ++i) { const int kc = start + 16 * kt + 4 * quad + i; int dc = kc - qc + 15; dc = dc < 0 ? 0 : (dc > 30 ? 30 : dc);
                        const bool valid = (kc >= cs) && (kc < cs + 16);
                        const float v = valid ? st[jj][kt][i] * rk[i] + rpb_l[dr * 31 + dc] : -3.0e38f;
                        st[jj][kt][i] = v; mx = fmaxf(mx, v); } } }
            mx = fmaxf(mx, __shfl_xor(mx, 16)); mx = fmaxf(mx, __shfl_xor(mx, 32));
            float sum = 0.f;
#pragma unroll
            for (int jj = 0; jj < 4; ++jj)
#pragma unroll
                for (int kt = 0; kt < 2; ++kt)
#pragma unroll
                    for (int i = 0; i < 4; ++i) { const float e = __expf(st[jj][kt][i] - mx); st[jj][kt][i] = e; sum += e; }
            sum += __shfl_xor(sum, 16); sum += __shfl_xor(sum, 32);
            f32x4 oacc[4];
#pragma unroll
            for (int dt = 0; dt < 4; ++dt) oacc[dt] = (f32x4){0.f, 0.f, 0.f, 0.f};
            const int kl = start + 4 * quad + qq;
            v4i16_t lo[4][4], hi[4][4];
#pragma unroll
            for (int jj = 0; jj < 4; ++jj) {
                const unsigned vs = (unsigned)(unsigned long long)(lds + ((rs + 4 * kh + jj) & 7) * AR_SLOT + AR_V) + 8 * (p & 1);
#pragma unroll
                for (int dt = 0; dt < 4; ++dt) { const unsigned a_lo = vs + ar_off(kl, 2 * dt + (p >> 1)), a_hi = vs + ar_off(kl + 16, 2 * dt + (p >> 1));
                    asm volatile("ds_read_b64_tr_b16 %0, %1" : "=v"(lo[jj][dt]) : "v"(a_lo) : "memory");
                    asm volatile("ds_read_b64_tr_b16 %0, %1" : "=v"(hi[jj][dt]) : "v"(a_hi) : "memory"); } }
            bf16x8 pf[4];
#pragma unroll
            for (int jj = 0; jj < 4; ++jj) { const f32x4 s0 = st[jj][0], s1 = st[jj][1];
                v4u pw; pw.x = pk2c(s0[0], s0[1]); pw.y = pk2c(s0[2], s0[3]); pw.z = pk2c(s1[0], s1[1]); pw.w = pk2c(s1[2], s1[3]); pf[jj] = __builtin_bit_cast(bf16x8, pw); }
            asm volatile("s_waitcnt lgkmcnt(0)" ::: "memory"); __builtin_amdgcn_sched_barrier(0);
#pragma unroll
            for (int jj = 0; jj < 4; ++jj)
#pragma unroll
                for (int dt = 0; dt < 4; ++dt) {
                    const bf16x8 vf = (bf16x8){lo[jj][dt][0], lo[jj][dt][1], lo[jj][dt][2], lo[jj][dt][3], hi[jj][dt][0], hi[jj][dt][1], hi[jj][dt][2], hi[jj][dt][3]};
                    oacc[dt] = __builtin_amdgcn_mfma_f32_16x16x32_bf16(vf, pf[jj], oacc[dt], 0, 0, 0);
                }
            if (kh == 1) {
#pragma unroll
                for (int dt = 0; dt < 4; ++dt) *(LAS f32x4*)(cmb + (dt * 64 + lane) * 16) = oacc[dt];
                *(LAS float*)(cmb + 4096 + lane * 8) = mx; *(LAS float*)(cmb + 4096 + lane * 8 + 4) = sum;
            }
            __syncthreads();
            if (kh == 0) {
                const float mb = *(const LAS float*)(cmb + 4096 + lane * 8), lb = *(const LAS float*)(cmb + 4096 + lane * 8 + 4);
                const float M = fmaxf(mx, mb), fa = __expf(mx - M), fb = __expf(mb - M), inv = 1.0f / (sum * fa + lb * fb), wa = fa * inv, wb = fb * inv;
                bf16* op = outp + (size_t)(b * SEQ + r * 64 + cb * 16 + n) * DM + h * 64 + 4 * quad;
#pragma unroll
                for (int dt = 0; dt < 4; ++dt) { const f32x4 ob = *(const LAS f32x4*)(cmb + (dt * 64 + lane) * 16); const f32x4 o = oacc[dt] * wa + ob * wb;
                    v2u w; w.x = pk2c(o[0], o[1]); w.y = pk2c(o[2], o[3]); *(v2u*)(op + 16 * dt) = w; }
            }
            if (slide) { LAS unsigned char* slot = lds + ((rs + 8) & 7) * AR_SLOT; *(LAS v4u*)(slot + ar_off(lk, lc)) = nk; *(LAS v4u*)(slot + AR_V + ar_off(lk, lc)) = nv;
                if (tid < 64) *(LAS float*)(slot + AR_RK + 4 * tid) = __builtin_amdgcn_rsqf(nss * (1.0f / 64.0f) + RMS_EPS); }
            __syncthreads();
        }
    }
}

constexpr int CT_STRIDE = 144, CT_BYTES = 66 * CT_STRIDE;
__device__ __forceinline__ void hyena_pre_fetch(const bf16* big, int id, int lane, v4u (&v)[9]) {
    const int ct = id & 31, tt = id >> 5, b = tt >> 5, t0 = (tt & 31) * 64, c0 = ct * 64;
#pragma unroll
    for (int ps = 0; ps < 9; ++ps) { const int rr = ps * 8 + (lane >> 3), part = lane & 7, t = t0 - 1 + rr;
        v[ps] = (v4u){0u, 0u, 0u, 0u};
        if (rr < 66 && t >= 0 && t < SEQ) v[ps] = *(const v4u*)(big + (size_t)(b * SEQ + t) * NQKV + c0 + part * 8); }
}
__device__ __forceinline__ void phase_hyena_pre(const bf16* big, const float* sw, const float* sb, bf16* VTp, bf16* X1Tp, LAS unsigned char* lds, int gw, int ngw, int wave, int lane) {
    LAS unsigned char* scr = lds + wave * 16384;
    v4u vin[9];
    if (gw < 512 * 32) hyena_pre_fetch(big, gw, lane, vin);
    for (int id = gw; id < 512 * 32; id += ngw) {
        const int ct = id & 31, tt = id >> 5, b = tt >> 5, t0 = (tt & 31) * 64, c0 = ct * 64;
#pragma unroll
        for (int ps = 0; ps < 9; ++ps) { const int rr = ps * 8 + (lane >> 3), part = lane & 7; if (rr < 66) *(LAS v4u*)(scr + rr * CT_STRIDE + part * 16) = vin[ps]; }
        if (id + ngw < 512 * 32) hyena_pre_fetch(big, id + ngw, lane, vin);
        LDS_WAIT();
        const int cg = c0 + lane; const float w0 = sw[cg], w1 = sw[NQKV + cg], w2 = sw[2 * NQKV + cg], bias = sb[cg];
        const LAS unsigned short* col = (const LAS unsigned short*)(scr + 2 * lane);
        float pa = bf2f(col[0]), pb = bf2f(col[CT_STRIDE / 2]);
        v4u o[8];
#pragma unroll
        for (int g8 = 0; g8 < 8; ++g8) { float y[8];
#pragma unroll
            for (int k = 0; k < 8; ++k) { const float pc = bf2f(col[(g8 * 8 + k + 2) * (CT_STRIDE / 2)]); y[k] = w0 * pa + w1 * pb + w2 * pc + bias; pa = pb; pb = pc; }
            o[g8].x = pk2(y[0], y[1]); o[g8].y = pk2(y[2], y[3]); o[g8].z = pk2(y[4], y[5]); o[g8].w = pk2(y[6], y[7]); }
        LDS_WAIT();
#pragma unroll
        for (int g8 = 0; g8 < 8; ++g8) *(LAS v4u*)(scr + lane * CT_STRIDE + g8 * 16) = o[g8];
        LDS_WAIT();
#pragma unroll
        for (int ps = 0; ps < 8; ++ps) { const int cl = ps * 8 + (lane >> 3), part = lane & 7, cc = c0 + cl;
            const v4u v = *(const LAS v4u*)(scr + cl * CT_STRIDE + part * 16);
            bf16* op = (cc < DM ? VTp + (size_t)cc * NB * SEQ : X1Tp + (size_t)(cc - DM) * NB * SEQ) + (size_t)b * SEQ + t0 + part * 8;
            *(v4u*)op = v; }
        LDS_WAIT();
    }
}
constexpr int U_STRIDE = 4112, U_BYTES = 16 * U_STRIDE, CP_OFF = U_BYTES, CP_STRIDE = 8224;
struct HyFilt { v4u a, b; };
__device__ __forceinline__ HyFilt hyena_fetch_filter(const bf16* kf, int tid) { HyFilt f; const v4u* src = (const v4u*)kf; f.a = src[tid]; f.b = (tid < 2) ? src[512 + tid] : (v4u){0u, 0u, 0u, 0u}; return f; }
__device__ __forceinline__ void hyena_put_filter(LAS unsigned char* lds, const HyFilt& f, int tid) {
    *(LAS v4u*)(lds + CP_OFF + 16 * tid) = f.a;
    if (tid < 2) *(LAS v4u*)(lds + CP_OFF + 16 * (512 + tid)) = f.b;
    __syncthreads();
    const v4u lo = *(LAS v4u*)(lds + CP_OFF + 16 * tid), hi = *(LAS v4u*)(lds + CP_OFF + 16 * tid + 16);
    const unsigned s[8] = {lo.x, lo.y, lo.z, lo.w, hi.x, hi.y, hi.z, hi.w};
#pragma unroll
    for (int r = 1; r < 8; ++r) { v4u o;
#pragma unroll
        for (int w = 0; w < 4; ++w) { const int q = w + r / 2; o[w] = (r & 1) ? ((s[q] >> 16) | (s[q + 1] << 16)) : s[q]; }
        *(LAS v4u*)(lds + CP_OFF + r * CP_STRIDE + 16 * tid) = o; }
    __syncthreads();
}
__device__ __forceinline__ void hyena_conv(LAS unsigned char* lds, f32x4 (&acc)[16], unsigned toep0, unsigned uaddr0) {
#pragma unroll
    for (int ti = 0; ti < 16; ++ti) acc[ti] = (f32x4){0.f, 0.f, 0.f, 0.f};
#pragma unroll 1
    for (int k4 = 0; k4 < 16; ++k4) {
        bf16x8 uf[4];
#pragma unroll
        for (int s = 0; s < 4; ++s) uf[s] = *(const LAS bf16x8*)(lds + uaddr0 + 256 * k4 + 64 * s);
#pragma unroll
        for (int x = 0; x < 22; ++x) {
            const bf16x8 tf = *(const LAS bf16x8*)(lds + toep0 + 256 * k4 + 32 * x);
#pragma unroll
            for (int s = 0; s < 4; ++s) { const int ti = 15 + 2 * s - x; if (ti >= 0 && ti < 16) acc[ti] = __builtin_amdgcn_mfma_f32_16x16x32_bf16(tf, uf[s], acc[ti], 0, 0, 0); }
        }
    }
}
__device__ __forceinline__ void phase_hyena(bf16* VT, const bf16* X1T, const bf16* KF, const float* skip, LAS unsigned char* lds, int vcu, int G, int wave, int lane, int tid) {
    const int n = lane & 15, quad = lane >> 4, rho = (-n) & 7;
    const int base = 2048 - 256 * wave - n + 8 * quad;
    const unsigned toep0 = CP_OFF + rho * CP_STRIDE + 16 * ((base >> 3) - 30);
    const unsigned uaddr0 = n * U_STRIDE + 16 * quad;
    v4u ur[8]; HyFilt f0;
    if (vcu < DM) { const v4u* src = (const v4u*)(VT + (size_t)vcu * NB * SEQ);
#pragma unroll
        for (int k = 0; k < 8; ++k) ur[k] = src[tid + 512 * k];
        f0 = hyena_fetch_filter(KF + (size_t)vcu * KF_LEN, tid); }
    for (int d = vcu; d < DM; d += G) {
        bf16* vrow = VT + (size_t)d * NB * SEQ;
#pragma unroll
        for (int k = 0; k < 8; ++k) { const int c = tid + 512 * k; *(LAS v4u*)(lds + (c >> 8) * U_STRIDE + 16 * (c & 255)) = ur[k]; }
        hyena_put_filter(lds, f0, tid);
        const HyFilt f1 = hyena_fetch_filter(KF + (size_t)(DM + d) * KF_LEN, tid);
        v2u xx[16];
#pragma unroll
        for (int ti = 0; ti < 16; ++ti) xx[ti] = *(const v2u*)(X1T + ((size_t)d * NB + n) * SEQ + 256 * wave + 16 * ti + 4 * quad);
        f32x4 acc[16];
        hyena_conv(lds, acc, toep0, uaddr0);
        const float sk0 = skip[d], sk1 = skip[DM + d];
        v2u z[16];
#pragma unroll
        for (int ti = 0; ti < 16; ++ti) { const int t = 256 * wave + 16 * ti + 4 * quad;
            const v2u vv = *(const LAS v2u*)(lds + n * U_STRIDE + 2 * t);
            const float z0 = bflo(xx[ti].x) * (acc[ti][0] + sk0 * bflo(vv.x)), z1 = bfhi(xx[ti].x) * (acc[ti][1] + sk0 * bfhi(vv.x));
            const float z2 = bflo(xx[ti].y) * (acc[ti][2] + sk0 * bflo(vv.y)), z3 = bfhi(xx[ti].y) * (acc[ti][3] + sk0 * bfhi(vv.y));
            z[ti].x = pk2(z0, z1); z[ti].y = pk2(z2, z3); }
        __syncthreads();
#pragma unroll
        for (int ti = 0; ti < 16; ++ti) { const int t = 256 * wave + 16 * ti + 4 * quad; *(LAS v2u*)(lds + n * U_STRIDE + 2 * t) = z[ti]; }
        hyena_put_filter(lds, f1, tid);
        if (d + G < DM) { const v4u* src = (const v4u*)(VT + (size_t)(d + G) * NB * SEQ);
#pragma unroll
            for (int k = 0; k < 8; ++k) ur[k] = src[tid + 512 * k];
            f0 = hyena_fetch_filter(KF + (size_t)(d + G) * KF_LEN, tid); }
        hyena_conv(lds, acc, toep0, uaddr0);
        __syncthreads();
#pragma unroll
        for (int ti = 0; ti < 16; ++ti) { const int t = 256 * wave + 16 * ti + 4 * quad;
            const float o0 = acc[ti][0] + sk1 * bflo(z[ti].x), o1 = acc[ti][1] + sk1 * bfhi(z[ti].x), o2 = acc[ti][2] + sk1 * bflo(z[ti].y), o3 = acc[ti][3] + sk1 * bfhi(z[ti].y);
            v2u w; w.x = pk2(o0, o1); w.y = pk2(o2, o3); *(LAS v2u*)(lds + n * U_STRIDE + 2 * t) = w; }
        __syncthreads();
        {   v4u* dst = (v4u*)vrow;
#pragma unroll
            for (int k = 0; k < 8; ++k) { const int c = tid + 512 * k; dst[c] = *(const LAS v4u*)(lds + (c >> 8) * U_STRIDE + 16 * (c & 255)); } }
        __syncthreads();
    }
}
constexpr int C5_STRIDE = 132;
__device__ __forceinline__ void phase_hyena_post(const bf16* big, const float* sw, const float* sb, const bf16* ZT, bf16* outp, LAS unsigned char* lds, int gw, int ngw, int wave, int lane) {
    LAS unsigned char* scr = lds + wave * 16384;
    for (int id = gw; id < 512 * 16; id += ngw) {
        const int dtile = id & 15, tt = id >> 4, b = tt >> 5, t0 = (tt & 31) * 64, d0 = dtile * 64;
        const int cg = 2 * DM + d0 + lane; const float w0 = sw[cg], w1 = sw[NQKV + cg], w2 = sw[2 * NQKV + cg], bias = sb[cg];
        const bf16* pp = big + (size_t)(b * SEQ + t0) * NQKV + cg;
        unsigned short pr[66];
#pragma unroll
        for (int k = 0; k < 66; ++k) { const int t = t0 - 1 + k; pr[k] = (t >= 0 && t < SEQ) ? pp[(long)(k - 1) * NQKV] : (unsigned short)0; }
        v4u zv[8];
#pragma unroll
        for (int ps = 0; ps < 8; ++ps) { const int dd = ps * 8 + (lane >> 3), part = lane & 7; zv[ps] = *(const v4u*)(ZT + ((size_t)(d0 + dd) * NB + b) * SEQ + t0 + part * 8); }
#pragma unroll
        for (int ps = 0; ps < 8; ++ps) { const int dd = ps * 8 + (lane >> 3), part = lane & 7;
            LAS unsigned* w = (LAS unsigned*)(scr + dd * C5_STRIDE + part * 16); w[0] = zv[ps].x; w[1] = zv[ps].y; w[2] = zv[ps].z; w[3] = zv[ps].w; }
        LDS_WAIT();
        const LAS unsigned short* zr = (const LAS unsigned short*)(scr + lane * C5_STRIDE);
        bf16* op = outp + (size_t)(b * SEQ + t0) * DM + d0 + lane;
#pragma unroll
        for (int k = 0; k < 64; ++k) { const float y = (w0 * bf2f(pr[k]) + w1 * bf2f(pr[k + 1]) + w2 * bf2f(pr[k + 2]) + bias) * bf2f(zr[k]); op[(size_t)k * DM] = f2bf(y); }
        LDS_WAIT();
    }
}

__global__ void __launch_bounds__(NTHREADS, 2) mk_fwd(Args a) {
    extern __shared__ __attribute__((aligned(16))) unsigned char lds_raw[];
    LAS unsigned char* lds = (LAS unsigned char*)lds_raw;
    cg::grid_group grid = cg::this_grid();
    const int tid = threadIdx.x, lane = tid & 63, wave = __builtin_amdgcn_readfirstlane(tid >> 6);
    const int G = gridDim.x, bx = blockIdx.x;
    const int vcu = (G % 8 == 0) ? (bx % 8) * (G / 8) + bx / 8 : bx;
    const int gw = vcu * NWAVES + wave, ngw = G * NWAVES;
    unsigned char* ws = a.ws;
    float* SS = (float*)(ws + WS_SS); bf16* XN = (bf16*)(ws + WS_XN); bf16* VT = (bf16*)(ws + WS_VT); bf16* MIXO = (bf16*)(ws + WS_MIXO); bf16* BIG = (bf16*)(ws + WS_BIG);
    const int lo = a.ph_lo, hi = a.ph_hi; int ph = 0;
    volatile LAS unsigned* MISC = (volatile LAS unsigned*)(lds + MISC_OFF);
    if (tid < 16) MISC[tid] = 0u;
    __syncthreads();
    XcdBarrier xbar = xcd_barrier_post((unsigned*)(ws + WS_BAR), MISC);
#define PH_BEGIN if (ph >= lo && ph < hi) {
#define PH_END   if (ph + 1 < hi) { if (ph == 0) grid.sync(); else xcd_barrier(xbar); } } ++ph;

    PH_BEGIN phase_prologue(a, lds, gw, ngw, wave, lane);
    PH_END
    PH_BEGIN phase_filters(a, lds, vcu, G, wave, lane, tid); phase_norm0(a.in[0], XN, SS, gw, ngw, lane); PH_END

    { constexpr int L = 0;

        constexpr int kind = L % 3;
        const bf16* wl = (const bf16*)(ws + WS_W + (size_t)L * W_LAYER);
        PH_BEGIN { pg8::Gemm g{XN, wl + W_IN / 2, MTOK, NQKV, DM}; pg8::StaticOrder S; S.init(MTOK, NQKV, G, bx); pg8::EpiBf16PT<(kind == 1)> E{BIG, NQKV, (const LAS float*)(lds + RST_OFF), (float*)(ws + WS_KSS), MTOK}; fill_row_scales(S, SS, (LAS float*)(lds + RST_OFF), tid);
                   pg8::gemm_phase<pg8::EpiBf16PT<(kind == 1)>, pg8::StaticOrder, true, true>(lds, g, S, E);
 } PH_END
        if (kind == 0) {
            PH_BEGIN phase_shortconv(BIG, a.in[4] + (size_t)(L / 3) * 3 * DM, MIXO, vcu * NTHREADS + tid, G * NTHREADS);
            PH_END
        } else if (kind == 1) {
            PH_BEGIN
            phase_natten3(BIG, a.in[7], a.in[8], a.in[9], (const float*)(ws + WS_KSS), MIXO, lds, vcu, G, wave, lane, tid); PH_END
        } else {
            PH_BEGIN phase_hyena_pre(BIG, a.in[12], a.in[13], VT, MIXO, lds, gw, ngw, wave, lane);
            PH_END
            PH_BEGIN
            phase_hyena(VT, MIXO, (const bf16*)(ws + WS_KF), a.in[20], lds, vcu, G, wave, lane, tid); PH_END
            PH_BEGIN phase_hyena_post(BIG, a.in[12], a.in[13], VT, MIXO, lds, gw, ngw, wave, lane);
            PH_END
        }
        PH_BEGIN { pg8::Gemm g{MIXO, wl + W_OUT / 2, MTOK, DM, DM}; pg8::StaticOrder S; S.init(MTOK, DM, G, bx); pg8::EpiResNorm E{a.out, XN, SS, DM};
                   pg8::gemm_phase<pg8::EpiResNorm, pg8::StaticOrder, true, true>(lds, g, S, E); } PH_END
        PH_BEGIN { pg8::Gemm g{XN, wl + W_13 / 2, MTOK, NW13, DM}; pg8::StaticOrder S; S.init(MTOK, NW13, G, bx); pg8::EpiSwiGLU E{BIG, FFH, (const LAS float*)(lds + RST_OFF)}; fill_row_scales(S, SS, (LAS float*)(lds + RST_OFF), tid);
                   pg8::gemm_phase<pg8::EpiSwiGLU, pg8::StaticOrder, true, true>(lds, g, S, E);
 } PH_END
        PH_BEGIN { pg8::Gemm g{BIG, wl + W_2 / 2, MTOK, DM, FFH}; pg8::StaticOrder S; S.init(MTOK, DM, G, bx); pg8::EpiResNormT<(L == NLAYER - 1)> E{a.out, XN, SS, DM};
                   pg8::gemm_phase<pg8::EpiResNormT<(L == NLAYER - 1)>, pg8::StaticOrder, true, true>(lds, g, S, E); } PH_END
        }
    { constexpr int L = 1;

        constexpr int kind = L % 3;
        const bf16* wl = (const bf16*)(ws + WS_W + (size_t)L * W_LAYER);
        PH_BEGIN { pg8::Gemm g{XN, wl + W_IN / 2, MTOK, NQKV, DM}; pg8::StaticOrder S; S.init(MTOK, NQKV, G, bx); pg8::EpiBf16PT<(kind == 1)> E{BIG, NQKV, (const LAS float*)(lds + RST_OFF), (float*)(ws + WS_KSS), MTOK}; fill_row_scales(S, SS, (LAS float*)(lds + RST_OFF), tid);
                   pg8::gemm_phase<pg8::EpiBf16PT<(kind == 1)>, pg8::StaticOrder, true, true>(lds, g, S, E);
 } PH_END
        if (kind == 0) {
            PH_BEGIN phase_shortconv(BIG, a.in[4] + (size_t)(L / 3) * 3 * DM, MIXO, vcu * NTHREADS + tid, G * NTHREADS);
            PH_END
        } else if (kind == 1) {
            PH_BEGIN
            phase_natten3(BIG, a.in[7], a.in[8], a.in[9], (const float*)(ws + WS_KSS), MIXO, lds, vcu, G, wave, lane, tid); PH_END
        } else {
            PH_BEGIN phase_hyena_pre(BIG, a.in[12], a.in[13], VT, MIXO, lds, gw, ngw, wave, lane);
            PH_END
            PH_BEGIN
            phase_hyena(VT, MIXO, (const bf16*)(ws + WS_KF), a.in[20], lds, vcu, G, wave, lane, tid); PH_END
            PH_BEGIN phase_hyena_post(BIG, a.in[12], a.in[13], VT, MIXO, lds, gw, ngw, wave, lane);
            PH_END
        }
        PH_BEGIN { pg8::Gemm g{MIXO, wl + W_OUT / 2, MTOK, DM, DM}; pg8::StaticOrder S; S.init(MTOK, DM, G, bx); pg8::EpiResNorm E{a.out, XN, SS, DM};
                   pg8::gemm_phase<pg8::EpiResNorm, pg8::StaticOrder, true, true>(lds, g, S, E); } PH_END
        PH_BEGIN { pg8::Gemm g{XN, wl + W_13 / 2, MTOK, NW13, DM}; pg8::StaticOrder S; S.init(MTOK, NW13, G, bx); pg8::EpiSwiGLU E{BIG, FFH, (const LAS float*)(lds + RST_OFF)}; fill_row_scales(S, SS, (LAS float*)(lds + RST_OFF), tid);
                   pg8::gemm_phase<pg8::EpiSwiGLU, pg8::StaticOrder, true, true>(lds, g, S, E);
 } PH_END
        PH_BEGIN { pg8::Gemm g{BIG, wl + W_2 / 2, MTOK, DM, FFH}; pg8::StaticOrder S; S.init(MTOK, DM, G, bx); pg8::EpiResNormT<(L == NLAYER - 1)> E{a.out, XN, SS, DM};
                   pg8::gemm_phase<pg8::EpiResNormT<(L == NLAYER - 1)>, pg8::StaticOrder, true, true>(lds, g, S, E); } PH_END
        }
    { constexpr int L = 2;

        constexpr int kind = L % 3;
        const bf16* wl = (const bf16*)(ws + WS_W + (size_t)L * W_LAYER);
        PH_BEGIN { pg8::Gemm g{XN, wl + W_IN / 2, MTOK, NQKV, DM}; pg8::StaticOrder S; S.init(MTOK, NQKV, G, bx); pg8::EpiBf16PT<(kind == 1)> E{BIG, NQKV, (const LAS float*)(lds + RST_OFF), (float*)(ws + WS_KSS), MTOK}; fill_row_scales(S, SS, (LAS float*)(lds + RST_OFF), tid);
                   pg8::gemm_phase<pg8::EpiBf16PT<(kind == 1)>, pg8::StaticOrder, true, true>(lds, g, S, E);
 } PH_END
        if (kind == 0) {
            PH_BEGIN phase_shortconv(BIG, a.in[4] + (size_t)(L / 3) * 3 * DM, MIXO, vcu * NTHREADS + tid, G * NTHREADS);
            PH_END
        } else if (kind == 1) {
            PH_BEGIN
            phase_natten3(BIG, a.in[7], a.in[8], a.in[9], (const float*)(ws + WS_KSS), MIXO, lds, vcu, G, wave, lane, tid); PH_END
        } else {
            PH_BEGIN phase_hyena_pre(BIG, a.in[12], a.in[13], VT, MIXO, lds, gw, ngw, wave, lane);
            PH_END
            PH_BEGIN
            phase_hyena(VT, MIXO, (const bf16*)(ws + WS_KF), a.in[20], lds, vcu, G, wave, lane, tid); PH_END
            PH_BEGIN phase_hyena_post(BIG, a.in[12], a.in[13], VT, MIXO, lds, gw, ngw, wave, lane);
            PH_END
        }
        PH_BEGIN { pg8::Gemm g{MIXO, wl + W_OUT / 2, MTOK, DM, DM}; pg8::StaticOrder S; S.init(MTOK, DM, G, bx); pg8::EpiResNorm E{a.out, XN, SS, DM};
                   pg8::gemm_phase<pg8::EpiResNorm, pg8::StaticOrder, true, true>(lds, g, S, E); } PH_END
        PH_BEGIN { pg8::Gemm g{XN, wl + W_13 / 2, MTOK, NW13, DM}; pg8::StaticOrder S; S.init(MTOK, NW13, G, bx); pg8::EpiSwiGLU E{BIG, FFH, (const LAS float*)(lds + RST_OFF)}; fill_row_scales(S, SS, (LAS float*)(lds + RST_OFF), tid);
                   pg8::gemm_phase<pg8::EpiSwiGLU, pg8::StaticOrder, true, true>(lds, g, S, E);
 } PH_END
        PH_BEGIN { pg8::Gemm g{BIG, wl + W_2 / 2, MTOK, DM, FFH}; pg8::StaticOrder S; S.init(MTOK, DM, G, bx); pg8::EpiResNormT<(L == NLAYER - 1)> E{a.out, XN, SS, DM};
                   pg8::gemm_phase<pg8::EpiResNormT<(L == NLAYER - 1)>, pg8::StaticOrder, true, true>(lds, g, S, E); } PH_END
        }
    { constexpr int L = 3;

        constexpr int kind = L % 3;
        const bf16* wl = (const bf16*)(ws + WS_W + (size_t)L * W_LAYER);
        PH_BEGIN { pg8::Gemm g{XN, wl + W_IN / 2, MTOK, NQKV, DM}; pg8::StaticOrder S; S.init(MTOK, NQKV, G, bx); pg8::EpiBf16PT<(kind == 1)> E{BIG, NQKV, (const LAS float*)(lds + RST_OFF), (float*)(ws + WS_KSS), MTOK}; fill_row_scales(S, SS, (LAS float*)(lds + RST_OFF), tid);
                   pg8::gemm_phase<pg8::EpiBf16PT<(kind == 1)>, pg8::StaticOrder, true, true>(lds, g, S, E);
 } PH_END
        if (kind == 0) {
            PH_BEGIN phase_shortconv(BIG, a.in[4] + (size_t)(L / 3) * 3 * DM, MIXO, vcu * NTHREADS + tid, G * NTHREADS);
            PH_END
        } else if (kind == 1) {
            PH_BEGIN
            phase_natten3(BIG, a.in[7], a.in[8], a.in[9], (const float*)(ws + WS_KSS), MIXO, lds, vcu, G, wave, lane, tid); PH_END
        } else {
            PH_BEGIN phase_hyena_pre(BIG, a.in[12], a.in[13], VT, MIXO, lds, gw, ngw, wave, lane);
            PH_END
            PH_BEGIN
            phase_hyena(VT, MIXO, (const bf16*)(ws + WS_KF), a.in[20], lds, vcu, G, wave, lane, tid); PH_END
            PH_BEGIN phase_hyena_post(BIG, a.in[12], a.in[13], VT, MIXO, lds, gw, ngw, wave, lane);
            PH_END
        }
        PH_BEGIN { pg8::Gemm g{MIXO, wl + W_OUT / 2, MTOK, DM, DM}; pg8::StaticOrder S; S.init(MTOK, DM, G, bx); pg8::EpiResNorm E{a.out, XN, SS, DM};
                   pg8::gemm_phase<pg8::EpiResNorm, pg8::StaticOrder, true, true>(lds, g, S, E); } PH_END
        PH_BEGIN { pg8::Gemm g{XN, wl + W_13 / 2, MTOK, NW13, DM}; pg8::StaticOrder S; S.init(MTOK, NW13, G, bx); pg8::EpiSwiGLU E{BIG, FFH, (const LAS float*)(lds + RST_OFF)}; fill_row_scales(S, SS, (LAS float*)(lds + RST_OFF), tid);
                   pg8::gemm_phase<pg8::EpiSwiGLU, pg8::StaticOrder, true, true>(lds, g, S, E);
 } PH_END
        PH_BEGIN { pg8::Gemm g{BIG, wl + W_2 / 2, MTOK, DM, FFH}; pg8::StaticOrder S; S.init(MTOK, DM, G, bx); pg8::EpiResNormT<(L == NLAYER - 1)> E{a.out, XN, SS, DM};
                   pg8::gemm_phase<pg8::EpiResNormT<(L == NLAYER - 1)>, pg8::StaticOrder, true, true>(lds, g, S, E); } PH_END
        }
#undef PH_BEGIN
#undef PH_END
}
#ifndef MK_NPH
#define MK_NPH (2 + 5 + 5 + 7 + 5)
#endif
constexpr int N_PHASES = MK_NPH;

extern "C" void kernel_launch(void* const* d_in, const int* in_sizes, int n_in, void* d_out, int out_size, void* d_ws, size_t ws_size, hipStream_t stream) {
    static int grid = 0;
    if (grid == 0) {
        if (n_in != 24 || out_size != MTOK * DM || ws_size < WS_END) { fprintf(stderr, "kernel_launch: unexpected shapes (n_in %d, out %d, ws %zu); nothing launched\n", n_in, out_size, ws_size); grid = -1; return; }
        int dev = 0, cus = 0, per_cu = 0;
        if (hipGetDevice(&dev) != hipSuccess || hipDeviceGetAttribute(&cus, hipDeviceAttributeMultiprocessorCount, dev) != hipSuccess) { grid = -1; return; }
        if (hipFuncSetAttribute((const void*)mk_fwd, hipFuncAttributeMaxDynamicSharedMemorySize, LDS_BYTES) != hipSuccess) { fprintf(stderr, "kernel_launch: hipFuncSetAttribute failed\n"); grid = -1; return; }
        if (hipOccupancyMaxActiveBlocksPerMultiprocessor(&per_cu, (const void*)mk_fwd, NTHREADS, LDS_BYTES) != hipSuccess || per_cu < 1) { fprintf(stderr, "kernel_launch: occupancy query gives %d\n", per_cu); per_cu = 1; }
        (void)hipGetLastError();
        grid = cus;
    }
    if (grid < 0) return;
    Args a{};
    for (int i = 0; i < 24; ++i) a.in[i] = (const float*)d_in[i];
    a.out = (float*)d_out; a.ws = (unsigned char*)d_ws;
    if (hipMemsetAsync(d_ws, 0, CTL_ZERO_BYTES, stream) != hipSuccess) { fprintf(stderr, "kernel_launch: memset of the control words failed\n"); return; }
#if MK_N_LAUNCHES == 1
    a.ph_lo = 0; a.ph_hi = N_PHASES;
    { void* args[] = {&a}; hipError_t e = hipLaunchCooperativeKernel((const void*)mk_fwd, dim3(grid), dim3(NTHREADS), args, LDS_BYTES, stream);
      if (e != hipSuccess) fprintf(stderr, "kernel_launch: cooperative launch failed: %s (grid %d)\n", hipGetErrorString(e), grid); }
#else
    for (int p = 0; p < N_PHASES; ++p) { a.ph_lo = p; a.ph_hi = p + 1; void* args[] = {&a};
        hipError_t e = hipLaunchCooperativeKernel((const void*)mk_fwd, dim3(grid), dim3(NTHREADS), args, LDS_BYTES, stream);
        if (e != hipSuccess) { fprintf(stderr, "kernel_launch: launch %d failed: %s\n", p, hipGetErrorString(e)); break; } }
#endif
}
```

```cpp
#include <hip/hip_runtime.h>
#include <hip/hip_cooperative_groups.h>
#include <cstdio>
#include <cstdint>
namespace cg = cooperative_groups;
namespace pg8 {
#define PG8_LAS __attribute__((address_space(3)))
typedef unsigned short bf16_t;
typedef short bf16x8 __attribute__((ext_vector_type(8)));
typedef float f32x4 __attribute__((ext_vector_type(4)));
typedef unsigned u32x4 __attribute__((ext_vector_type(4)));
constexpr int BM = 256, BK = 64, HALF = 128, HTB = HALF * BK * 2  , STAGE_BYTES = 8 * HTB, NXCD = 8, WGM = 8;

__host__ __device__ __forceinline__ int lds_byte(int r, int c) { const int st = (r >> 4) * 2 + (c >> 5), rr = r & 15, cc = c & 31, ob = rr * 64 + cc * 2; return st * 1024 + (ob ^ (((ob >> 9) & 1) << 5)); }
__host__ __device__ __forceinline__ void stage_rc(int b, int& R, int& C) { const int st = b / 1024, sb = b % 1024, swz = sb ^ (((sb >> 9) & 1) << 5); R = (st >> 1) * 16 + swz / 64; C = (st & 1) * 32 + (swz % 64) / 2; }
__host__ __device__ __forceinline__ int perm32(int rho) { const int n = rho >> 4, i = rho & 15; return 8 * (i >> 2) + 4 * n + (i & 3); }

struct Unit { int pm, pn, idx; };
struct Gemm { const bf16_t* A; const bf16_t* Bt; int M, N, K; };

struct StaticOrder {
    int nM, nN, nwg, G, c;
    __host__ __device__ void init(int M, int N, int G_, int c_) { nM = M / BM; nN = N / BM; nwg = nM * nN; G = G_; c = c_; }
    __host__ __device__ bool next(int i, Unit& u) const {
        const long L = (long)i * G + c; if (L >= nwg) return false;
        int wgid = (int)L; { const int q = nwg / NXCD, r = nwg % NXCD, xcd = wgid % NXCD, off = wgid / NXCD; wgid = (xcd < r ? xcd * (q + 1) : r * (q + 1) + (xcd - r) * q) + off; }
        const int nig = WGM * nN, gid = wgid / nig, fm = gid * WGM, gsz = (nM - fm) < WGM ? (nM - fm) : WGM;
        u.pm = fm + ((wgid % nig) % gsz); u.pn = (wgid % nig) / gsz; u.idx = i; return true;
    }
    __device__ __forceinline__ void a_ready(const Unit&) const {}
    __device__ __forceinline__ void done(const Unit&) const {}
};
__device__ __forceinline__ unsigned cvt_pk_bf16(float lo, float hi) { unsigned r; asm volatile("v_cvt_pk_bf16_f32 %0, %1, %2" : "=v"(r) : "v"(lo), "v"(hi)); return r; }
__device__ __forceinline__ float row_rscale(const float* ss, int row) { const f32x4* p = (const f32x4*)(ss + (size_t)row * 16); const f32x4 a = (p[0] + p[1]) + (p[2] + p[3]);
    return __builtin_amdgcn_rsqf(((a[0] + a[1]) + (a[2] + a[3])) * (1.0f / 1024.0f) + 1e-6f); }
template <bool KSS = false> struct EpiBf16PT {
    static constexpr bool PERM = true, AFTER_DRAIN = false;
    bf16_t* O; int ldc; const PG8_LAS float* rst; float* kss; int mrows;
    __device__ __forceinline__ void operator()(const f32x4 (&acc)[2][2][4][2], const Unit& u, int wr, int wc, int fr, int fq) const {
        const int row0 = u.pm * BM + wr * 64 + fr, col0 = u.pn * BM + wc * 32 + 8 * fq;
        const bool kt = KSS && u.pn >= 4 && u.pn < 8;
#pragma unroll
        for (int ai = 0; ai < 2; ++ai)
#pragma unroll
            for (int m = 0; m < 4; ++m) { const int row = row0 + ai * HALF + m * 16; bf16_t* rowp = O + (size_t)row * ldc + col0; const float rs = rst[u.idx * 256 + wr * 64 + fr + ai * HALF + m * 16];
#pragma unroll
                for (int bj = 0; bj < 2; ++bj) { const f32x4 v0 = acc[ai][bj][m][0] * rs, v1 = acc[ai][bj][m][1] * rs;
                    u32x4 w; w.x = cvt_pk_bf16(v0[0], v0[1]); w.y = cvt_pk_bf16(v0[2], v0[3]); w.z = cvt_pk_bf16(v1[0], v1[1]); w.w = cvt_pk_bf16(v1[2], v1[3]);
                    *(u32x4*)(rowp + bj * HALF) = w;
                    if (kt) { float q = ((v0[0] * v0[0] + v0[1] * v0[1]) + (v0[2] * v0[2] + v0[3] * v0[3])) + ((v1[0] * v1[0] + v1[1] * v1[1]) + (v1[2] * v1[2] + v1[3] * v1[3]));
                        q += __shfl_xor(q, 16); q += __shfl_xor(q, 32);
                        if (fq == 0) kss[(size_t)((u.pn - 4) * 8 + bj * 4 + wc) * mrows + row] = q; } }
                if (KSS) asm volatile("" ::: "memory"); }
    }
};
typedef EpiBf16PT<false> EpiBf16P;
__device__ __forceinline__ float silu_mul(float g, float u) { return g * __builtin_amdgcn_rcpf(1.0f + __expf(-g)) * u; }
struct EpiSwiGLU {
    static constexpr bool PERM = true, AFTER_DRAIN = false;
    bf16_t* H; int ldh; const PG8_LAS float* rst;
    __device__ __forceinline__ void operator()(const f32x4 (&acc)[2][2][4][2], const Unit& u, int wr, int wc, int fr, int fq) const {
        const int row0 = u.pm * BM + wr * 64 + fr, col0 = u.pn * HALF + wc * 32 + 8 * fq;
#pragma unroll
        for (int ai = 0; ai < 2; ++ai)
#pragma unroll
            for (int m = 0; m < 4; ++m) { bf16_t* rowp = H + (size_t)(row0 + ai * HALF + m * 16) * ldh + col0; const float rs = rst[u.idx * 256 + wr * 64 + fr + ai * HALF + m * 16];
                const f32x4 g0 = acc[ai][0][m][0] * rs, g1 = acc[ai][0][m][1] * rs, u0 = acc[ai][1][m][0] * rs, u1 = acc[ai][1][m][1] * rs;
                u32x4 w; w.x = cvt_pk_bf16(silu_mul(g0[0], u0[0]), silu_mul(g0[1], u0[1])); w.y = cvt_pk_bf16(silu_mul(g0[2], u0[2]), silu_mul(g0[3], u0[3]));
                w.z = cvt_pk_bf16(silu_mul(g1[0], u1[0]), silu_mul(g1[1], u1[1])); w.w = cvt_pk_bf16(silu_mul(g1[2], u1[2]), silu_mul(g1[3], u1[3]));
                *(u32x4*)rowp = w; }
    }
};
typedef unsigned u32x2 __attribute__((ext_vector_type(2)));
struct EpiShortIn {
    static constexpr bool PERM = true, AFTER_DRAIN = false;
    bf16_t* CU; bf16_t* BG; const PG8_LAS float* rst;
    __device__ __forceinline__ void operator()(const f32x4 (&acc)[2][2][4][2], const Unit& u, int wr, int wc, int fr, int fq) const {
        const int row0 = u.pm * BM + wr * 64 + fr;
#pragma unroll
        for (int ai = 0; ai < 2; ++ai)
#pragma unroll
            for (int m = 0; m < 4; ++m) { const int row = row0 + ai * HALF + m * 16; const float rs = rst[u.idx * 256 + wr * 64 + fr + ai * HALF + m * 16];
                if (u.pn < 8) { const float r2 = rs * rs; const f32x4 c0 = acc[ai][0][m][0], c1 = acc[ai][0][m][1], u0 = acc[ai][1][m][0], u1 = acc[ai][1][m][1];
                    u32x4 w; w.x = cvt_pk_bf16(c0[0] * u0[0] * r2, c0[1] * u0[1] * r2); w.y = cvt_pk_bf16(c0[2] * u0[2] * r2, c0[3] * u0[3] * r2);
                    w.z = cvt_pk_bf16(c1[0] * u1[0] * r2, c1[1] * u1[1] * r2); w.w = cvt_pk_bf16(c1[2] * u1[2] * r2, c1[3] * u1[3] * r2);
                    *(u32x4*)(CU + (size_t)row * 1024 + u.pn * HALF + wc * 32 + 8 * fq) = w; }
                else { bf16_t* rowp = BG + (size_t)row * 1024 + (u.pn - 8) * BM + wc * 32 + 8 * fq;
#pragma unroll
                    for (int bj = 0; bj < 2; ++bj) { const f32x4 v0 = acc[ai][bj][m][0] * rs, v1 = acc[ai][bj][m][1] * rs;
                        u32x4 w; w.x = cvt_pk_bf16(v0[0], v0[1]); w.y = cvt_pk_bf16(v0[2], v0[3]); w.z = cvt_pk_bf16(v1[0], v1[1]); w.w = cvt_pk_bf16(v1[2], v1[3]);
                        *(u32x4*)(rowp + bj * HALF) = w; } } }
    }
};
template <bool LAST = false> struct EpiResNormT {
    static constexpr bool PERM = true, AFTER_DRAIN = false;
    float* out; bf16_t* xb; float* ss; int ldc;
    __device__ __forceinline__ void operator()(const f32x4 (&acc)[2][2][4][2], const Unit& u, int wr, int wc, int fr, int fq) const {
        const int row0 = u.pm * BM + wr * 64 + fr, col0 = u.pn * BM + wc * 32 + 8 * fq;
#pragma unroll
        for (int ai = 0; ai < 2; ++ai)
#pragma unroll
            for (int m = 0; m < 4; ++m) { const int row = row0 + ai * HALF + m * 16; const size_t off = (size_t)row * ldc + col0; float s = 0.f;
#pragma unroll
                for (int bj = 0; bj < 2; ++bj) { const size_t o = off + bj * HALF; const u32x4 b = *(const u32x4*)(xb + o);
                    f32x4 r0, r1;
                    r0[0] = __uint_as_float(b.x << 16) + acc[ai][bj][m][0][0]; r0[1] = __uint_as_float(b.x & 0xffff0000u) + acc[ai][bj][m][0][1];
                    r0[2] = __uint_as_float(b.y << 16) + acc[ai][bj][m][0][2]; r0[3] = __uint_as_float(b.y & 0xffff0000u) + acc[ai][bj][m][0][3];
                    r1[0] = __uint_as_float(b.z << 16) + acc[ai][bj][m][1][0]; r1[1] = __uint_as_float(b.z & 0xffff0000u) + acc[ai][bj][m][1][1];
                    r1[2] = __uint_as_float(b.w << 16) + acc[ai][bj][m][1][2]; r1[3] = __uint_as_float(b.w & 0xffff0000u) + acc[ai][bj][m][1][3];
                    if (LAST) { *(f32x4*)(out + o) = r0; *(f32x4*)(out + o + 4) = r1; }
                    else { s += ((r0[0] * r0[0] + r0[1] * r0[1]) + (r0[2] * r0[2] + r0[3] * r0[3])) + ((r1[0] * r1[0] + r1[1] * r1[1]) + (r1[2] * r1[2] + r1[3] * r1[3]));
                        u32x4 w; w.x = cvt_pk_bf16(r0[0], r0[1]); w.y = cvt_pk_bf16(r0[2], r0[3]); w.z = cvt_pk_bf16(r1[0], r1[1]); w.w = cvt_pk_bf16(r1[2], r1[3]); *(u32x4*)(xb + o) = w; } }
                if (!LAST) { s += __shfl_xor(s, 16); s += __shfl_xor(s, 32); if (fq == 0) ss[(size_t)row * 16 + u.pn * 4 + wc] = s; }
                asm volatile("" ::: "memory"); }
    }
};
typedef EpiResNormT<false> EpiResNorm;
template <class Epi, class Sched, bool ALIGN_EPI = false, bool SP2 = false>
__device__ __forceinline__ void gemm_phase(PG8_LAS unsigned char* lds, const Gemm g, const Sched& S, const Epi& E) {
    const int tid = threadIdx.x, wid = __builtin_amdgcn_readfirstlane(tid >> 6), lane = tid & 63, wr = wid >> 2, wc = wid & 3, fr = lane & 15, fq = lane >> 4;
    const int K = g.K, nt = K / BK;
    unsigned voffA[2], voffB[2];
#pragma unroll
    for (int i = 0; i < 2; ++i) { int R, C; stage_rc(tid * 16 + i * 8192, R, C); const int Rb = Epi::PERM ? ((R & ~31) + perm32(R & 31)) : R;
        voffA[i] = (unsigned)(R * K + C) * 2u; voffB[i] = (unsigned)(Rb * K + C) * 2u; }
    const size_t kstep = (size_t)(BK * 2);
    const size_t hstep = (size_t)HALF * K * 2;
    const size_t tstep = 2 * hstep;
    const unsigned ldsw = (unsigned)wid * 1024u;
    const int aoff = lds_byte(wr * 64 + fr, fq * 8), boff = lds_byte(wc * 32 + fr, fq * 8);
#define PG8_SA(b, h) (((b) * 2 + (h)) * HTB)
#define PG8_SB(b, h) ((4 + (b) * 2 + (h)) * HTB)
#define PG8_STAGE(bufoff, gbase, voff) do { _Pragma("unroll") for (int _i = 0; _i < 2; ++_i) \
        __builtin_amdgcn_global_load_lds((const unsigned*)((const char*)(gbase) + (voff)[_i]), (PG8_LAS unsigned*)(lds + (bufoff) + ldsw + _i * 8192), 16, 0, 0); } while (0)
#define PG8_LDA(dst, b, h) do { _Pragma("unroll") for (int m = 0; m < 4; ++m) _Pragma("unroll") for (int k = 0; k < 2; ++k) dst[m][k] = *(const PG8_LAS bf16x8*)(lds + PG8_SA(b, h) + aoff + m * 2048 + k * 1024); } while (0)
#define PG8_LDB(dst, b, h) do { _Pragma("unroll") for (int n = 0; n < 2; ++n) _Pragma("unroll") for (int k = 0; k < 2; ++k) dst[n][k] = *(const PG8_LAS bf16x8*)(lds + PG8_SB(b, h) + boff + n * 2048 + k * 1024); } while (0)
#define PG8_MMA(ai, bj, At, Bt) do { __builtin_amdgcn_s_setprio(1); _Pragma("unroll") for (int m = 0; m < 4; ++m) _Pragma("unroll") for (int n = 0; n < 2; ++n) _Pragma("unroll") for (int k = 0; k < 2; ++k) \
        acc[ai][bj][m][n] = __builtin_amdgcn_mfma_f32_16x16x32_bf16(Bt[n][k], At[m][k], acc[ai][bj][m][n], 0, 0, 0); __builtin_amdgcn_s_setprio(0); } while (0)
#define PG8_WAIT_V(n) asm volatile("s_waitcnt vmcnt(" #n ")" ::: "memory")
#define PG8_WAIT_L(n) asm volatile("s_waitcnt lgkmcnt(" #n ")" ::: "memory")
#define PG8_BAR __builtin_amdgcn_s_barrier()
#define PG8_SCHED __builtin_amdgcn_sched_barrier(0)
    Unit cur, nxt; int ui = 0;
    if (!S.next(0, cur)) return;
    f32x4 acc[2][2][4][2];
#pragma unroll
    for (int a = 0; a < 2; ++a)
#pragma unroll
        for (int b = 0; b < 2; ++b)
#pragma unroll
            for (int m = 0; m < 4; ++m)
#pragma unroll
                for (int n = 0; n < 2; ++n) acc[a][b][m][n] = (f32x4){0.f, 0.f, 0.f, 0.f};
    bf16x8 At[4][2], B0[2][2], B1[2][2];
    const char* cA = (const char*)g.A + (size_t)cur.pm * tstep; const char* cB = (const char*)g.Bt + (size_t)cur.pn * tstep;
    S.a_ready(cur);
    if constexpr (SP2) {
        PG8_STAGE(PG8_SB(0, 0), cB, voffB); PG8_STAGE(PG8_SB(0, 1), cB + hstep, voffB); PG8_STAGE(PG8_SA(0, 0), cA, voffA); PG8_STAGE(PG8_SA(0, 1), cA + hstep, voffA);
        if (wr == 1) PG8_BAR;
        PG8_WAIT_V(2); PG8_BAR;
        PG8_STAGE(PG8_SB(1, 0), cB + kstep, voffB); PG8_STAGE(PG8_SA(1, 0), cA + kstep, voffA); PG8_STAGE(PG8_SB(1, 1), cB + hstep + kstep, voffB);
        PG8_WAIT_V(6); PG8_BAR;
    } else {
        PG8_STAGE(PG8_SB(0, 0), cB, voffB); PG8_STAGE(PG8_SA(0, 0), cA, voffA); PG8_STAGE(PG8_SB(0, 1), cB + hstep, voffB); PG8_STAGE(PG8_SA(0, 1), cA + hstep, voffA);
        if (wr == 1) PG8_BAR;
        PG8_WAIT_V(4); PG8_BAR;
        PG8_STAGE(PG8_SB(1, 0), cB + kstep, voffB); PG8_STAGE(PG8_SA(1, 0), cA + kstep, voffA); PG8_STAGE(PG8_SB(1, 1), cB + hstep + kstep, voffB);
        PG8_WAIT_V(6); PG8_BAR;
    }
    for (;;) {
        const bool has_next = S.next(ui + 1, nxt);
        const char* nA = has_next ? (const char*)g.A + (size_t)nxt.pm * tstep : cA; const char* nB = has_next ? (const char*)g.Bt + (size_t)nxt.pn * tstep : cB;
        for (int t = 0; t < nt; t += 2) {
            const bool last = (t == nt - 2);
            const char* a1 = cA + (size_t)(t + 1) * kstep;
            const char* a2 = last ? nA : cA + (size_t)(t + 2) * kstep; const char* b2 = last ? nB : cB + (size_t)(t + 2) * kstep;
            const char* a3 = a2 + kstep; const char* b3 = b2 + kstep;
            if (last && has_next) S.a_ready(nxt);
            if constexpr (SP2) {
            PG8_LDB(B0, 0, 0); PG8_LDB(B1, 0, 1); PG8_SCHED; PG8_LDA(At, 0, 0); PG8_STAGE(PG8_SA(1, 1), a1 + hstep, voffA);
            PG8_WAIT_V(8); PG8_WAIT_L(0); PG8_BAR; PG8_MMA(0, 0, At, B0); PG8_MMA(0, 1, At, B1); PG8_BAR; PG8_SCHED;
            PG8_LDA(At, 0, 1); PG8_STAGE(PG8_SB(0, 0), b2, voffB); PG8_STAGE(PG8_SB(0, 1), b2 + hstep, voffB); PG8_STAGE(PG8_SA(0, 0), a2, voffA);
            PG8_WAIT_V(8); PG8_WAIT_L(0); PG8_BAR; PG8_MMA(1, 0, At, B0); PG8_MMA(1, 1, At, B1); PG8_BAR; PG8_SCHED;
            PG8_LDB(B0, 1, 0); PG8_LDB(B1, 1, 1); PG8_SCHED; PG8_LDA(At, 1, 0); PG8_STAGE(PG8_SA(0, 1), a2 + hstep, voffA);
            PG8_WAIT_V(8); PG8_WAIT_L(0); PG8_BAR; PG8_MMA(0, 0, At, B0); PG8_MMA(0, 1, At, B1); PG8_BAR; PG8_SCHED;
            PG8_LDA(At, 1, 1); PG8_STAGE(PG8_SB(1, 0), b3, voffB); PG8_STAGE(PG8_SB(1, 1), b3 + hstep, voffB); PG8_STAGE(PG8_SA(1, 0), a3, voffA);
            PG8_WAIT_V(8); PG8_WAIT_L(0); PG8_BAR; PG8_MMA(1, 0, At, B0); PG8_MMA(1, 1, At, B1); PG8_BAR; PG8_SCHED;
            } else {
            PG8_LDB(B0, 0, 0); PG8_SCHED; PG8_LDA(At, 0, 0); PG8_STAGE(PG8_SA(1, 1), a1 + hstep, voffA);
            PG8_WAIT_L(8); PG8_BAR; PG8_WAIT_L(0); PG8_MMA(0, 0, At, B0); PG8_BAR; PG8_SCHED;
            PG8_LDB(B1, 0, 1); PG8_STAGE(PG8_SB(0, 0), b2, voffB);
            PG8_BAR; PG8_WAIT_L(0); PG8_MMA(0, 1, At, B1); PG8_BAR;
            PG8_LDA(At, 0, 1); PG8_STAGE(PG8_SA(0, 0), a2, voffA);
            PG8_BAR; PG8_WAIT_L(0); PG8_MMA(1, 0, At, B0); PG8_BAR; PG8_SCHED;
            PG8_STAGE(PG8_SB(0, 1), b2 + hstep, voffB);
            PG8_WAIT_V(6); PG8_BAR; PG8_MMA(1, 1, At, B1); PG8_BAR;
            PG8_LDB(B0, 1, 0); PG8_SCHED; PG8_LDA(At, 1, 0); PG8_STAGE(PG8_SA(0, 1), a2 + hstep, voffA);
            PG8_WAIT_L(8); PG8_BAR; PG8_WAIT_L(0); PG8_MMA(0, 0, At, B0); PG8_BAR; PG8_SCHED;
            PG8_LDB(B1, 1, 1); PG8_STAGE(PG8_SB(1, 0), b3, voffB);
            PG8_BAR; PG8_WAIT_L(0); PG8_MMA(0, 1, At, B1); PG8_BAR;
            PG8_LDA(At, 1, 1); PG8_STAGE(PG8_SA(1, 0), a3, voffA);
            PG8_BAR; PG8_WAIT_L(0); PG8_MMA(1, 0, At, B0); PG8_BAR; PG8_SCHED;
            PG8_STAGE(PG8_SB(1, 1), b3 + hstep, voffB);
            PG8_WAIT_V(6); PG8_BAR; PG8_MMA(1, 1, At, B1); PG8_BAR;
            }
        }
        if constexpr (ALIGN_EPI) { if (wr == 0) PG8_BAR; }
        if constexpr (!Epi::AFTER_DRAIN) { E(acc, cur, wr, wc, fr, fq); S.done(cur); }
        if (!has_next) break;
#pragma unroll
        for (int a = 0; a < 2; ++a)
#pragma unroll
            for (int b = 0; b < 2; ++b)
#pragma unroll
                for (int m = 0; m < 4; ++m)
#pragma unroll
                    for (int n = 0; n < 2; ++n) acc[a][b][m][n] = (f32x4){0.f, 0.f, 0.f, 0.f};
        cur = nxt; cA = nA; cB = nB; ++ui;
        if constexpr (ALIGN_EPI) { if (wr == 1) PG8_BAR; }
    }
    PG8_WAIT_V(0);
    if constexpr (!ALIGN_EPI) { if (wr == 0) PG8_BAR; }
    PG8_BAR;
    if constexpr (Epi::AFTER_DRAIN) { E.fused(acc, cur, wr, wc, fr, fq, lds, wid, lane); S.done(cur); }
#undef PG8_SA
#undef PG8_SB
#undef PG8_STAGE
#undef PG8_LDA
#undef PG8_LDB
#undef PG8_MMA
#undef PG8_WAIT_V
#undef PG8_WAIT_L
#undef PG8_BAR
#undef PG8_SCHED
}
}

#ifndef MK_N_LAUNCHES
#define MK_N_LAUNCHES 1
#endif
constexpr int NB = 16, SEQ = 2048, DM = 1024, MTOK = NB * SEQ, NQKV = 3072, FFH = 2816, NW13 = 2 * FFH, NLAYER = 4;
constexpr float RMS_EPS = 1e-6f;
constexpr int NWAVES = 8, NTHREADS = 512;
constexpr size_t MiB = 1u << 20;
constexpr size_t WS_W = 1 * MiB, W_LAYER = 49 * MiB / 2;
constexpr size_t W_IN = 0, W_OUT = 6 * MiB, W_13 = 8 * MiB, W_2 = 19 * MiB;
constexpr size_t WS_SS = 439 * MiB;
constexpr size_t WS_HID = 100 * MiB;
constexpr size_t WS_KF = 102 * MiB;
constexpr int KF_LEN = 4112;
constexpr size_t WS_XN = 119 * MiB;
constexpr size_t WS_MIXO = 183 * MiB;
constexpr size_t WS_BIG = 247 * MiB;
constexpr size_t WS_VT = 441 * MiB;
constexpr size_t WS_KSS = 505 * MiB;
constexpr size_t WS_END = 509 * MiB;
constexpr int MISC_OFF = 163776, RST_OFF = 131072;
constexpr size_t WS_BAR = 16384, CTL_ZERO_BYTES = 65536;
constexpr int LDS_BYTES = 163840;
#define LAS __attribute__((address_space(3)))
typedef unsigned short bf16;
typedef unsigned v4u __attribute__((ext_vector_type(4)));
typedef unsigned v2u __attribute__((ext_vector_type(2)));
typedef float f32x4 __attribute__((ext_vector_type(4)));
typedef short bf16x8 __attribute__((ext_vector_type(8)));
typedef short v4i16_t __attribute__((ext_vector_type(4)));
#define LDS_WAIT() asm volatile("s_waitcnt lgkmcnt(0)" ::: "memory")
typedef float f32x2_cv __attribute__((ext_vector_type(2))); typedef __bf16 bf16x2_cv __attribute__((ext_vector_type(2)));
__device__ __forceinline__ unsigned pk2c(float lo, float hi) { const f32x2_cv v = {lo, hi}; const bf16x2_cv b = __builtin_convertvector(v, bf16x2_cv); return __builtin_bit_cast(unsigned, b); }
__device__ __forceinline__ unsigned pk2(float lo, float hi) { return pg8::cvt_pk_bf16(lo, hi); }
__device__ __forceinline__ float bflo(unsigned w) { return __uint_as_float(w << 16); }
__device__ __forceinline__ float bfhi(unsigned w) { return __uint_as_float(w & 0xffff0000u); }
__device__ __forceinline__ float bf2f(unsigned short b) { return __uint_as_float(((unsigned)b) << 16); }
__device__ __forceinline__ unsigned short f2bf(float f) { return (unsigned short)(pk2(f, 0.f) & 0xffffu); }
__device__ __forceinline__ float wave_sum(float v) {
#pragma unroll
    for (int o = 1; o < 64; o <<= 1) v += __shfl_xor(v, o);
    return v;
}

#define RLX_AGENT __ATOMIC_RELAXED, __HIP_MEMORY_SCOPE_AGENT
#define XB_TMO      128
#define XB_XCNT(j)  (256  + 64 * (j))
#define XB_XSUB(j)  (1280 + 64 * (j))
#define XB_XGEN(j)  (2304 + 64 * (j))
#define XB_TOP      3328
#define XB_TOPGEN   3392
#define XCD_BAR_WORDS 3456
#define XB_SPIN_CAP (1u << 18)

__device__ __forceinline__ unsigned xb_ld(unsigned* p)              { return __hip_atomic_load(p, __ATOMIC_RELAXED, __HIP_MEMORY_SCOPE_AGENT); }
__device__ __forceinline__ unsigned xb_add(unsigned* p, unsigned v) { return __hip_atomic_fetch_add(p, v, __ATOMIC_RELAXED, __HIP_MEMORY_SCOPE_AGENT); }
__device__ __forceinline__ unsigned xb_xcc_id() { return (unsigned)__builtin_amdgcn_s_getreg((3 << 11) | 20) & 0xFu; }
#define XB_SPIN(cond, bar) do { unsigned _sp = 0; while (cond) { __builtin_amdgcn_s_sleep(1); \
    if ((++_sp & 255u) == 0u) { if (xb_ld(&(bar)[XB_TMO])) break; if (_sp > XB_SPIN_CAP) { atomicAdd(&(bar)[XB_TMO], 1u); break; } } } } while (0)

struct XcdBarrier {
    unsigned* bar; unsigned x;
    volatile LAS unsigned* st;
};

__device__ __forceinline__ XcdBarrier xcd_barrier_post(unsigned* bar, volatile LAS unsigned* st) {
    XcdBarrier b; b.bar = bar; b.x = xb_xcc_id(); b.st = st;
    if (threadIdx.x == 0) (void)xb_add(&bar[XB_XCNT(b.x)], 1u);
    return b;
}
__device__ __forceinline__ void xcd_barrier_complete(unsigned* bar, unsigned x, unsigned& nloc, unsigned& nx) {
    const unsigned G = gridDim.x * gridDim.y * gridDim.z;
    unsigned sum, cnt, mine, sp = 0u;
    for (;;) {
        sum = 0u; cnt = 0u; mine = 0u;
#pragma unroll
        for (unsigned j = 0; j < 16; ++j) { const unsigned c = xb_ld(&bar[XB_XCNT(j)]); sum += c; cnt += (c > 0u) ? 1u : 0u; mine = (j == x) ? c : mine; }
        if (sum == G) break;
        __builtin_amdgcn_s_sleep(1);
        if ((++sp & 255u) == 0u) { if (xb_ld(&bar[XB_TMO])) break; if (sp > XB_SPIN_CAP) { atomicAdd(&bar[XB_TMO], 1u); break; } }
    }
    nloc = mine > 0u ? mine : 1u; nx = cnt > 0u ? cnt : 1u;
}

__device__ __forceinline__ void xcd_barrier(const XcdBarrier& b) {
    asm volatile("s_waitcnt vmcnt(0)" ::: "memory");
    __syncthreads();
    if (threadIdx.x == 0) {
        unsigned* bar = b.bar;
        __builtin_amdgcn_s_waitcnt(0);
        unsigned nloc = b.st[0], nx = b.st[1];
        if (nloc == 0u) { xcd_barrier_complete(bar, b.x, nloc, nx); b.st[0] = nloc; b.st[1] = nx; }
        const unsigned old = xb_add(&bar[XB_XSUB(b.x)], 1u);
        const unsigned gen = old / nloc;
        if (old + 1u == (gen + 1u) * nloc) {
            __builtin_amdgcn_fence(__ATOMIC_RELEASE, "agent");
            asm volatile("s_waitcnt vmcnt(0)" ::: "memory");
            const unsigned og = xb_add(&bar[XB_TOP], 1u);
            const unsigned tg = og / nx;
            if (og + 1u == (tg + 1u) * nx) xb_add(&bar[XB_TOPGEN], 1u);
            else XB_SPIN(xb_ld(&bar[XB_TOPGEN]) == tg, bar);
            __builtin_amdgcn_fence(__ATOMIC_ACQUIRE, "agent");
            xb_add(&bar[XB_XGEN(b.x)], 1u);
            asm volatile("s_waitcnt vmcnt(0)" ::: "memory");
        } else {
            XB_SPIN(xb_ld(&bar[XB_XGEN(b.x)]) == gen, bar);
            __builtin_amdgcn_fence(__ATOMIC_ACQUIRE, "agent");
            asm volatile("s_waitcnt vmcnt(0)" ::: "memory");
        }
    }
    __syncthreads();
}

__device__ __forceinline__ void transpose_item(const float* __restrict__ W, int K, int N, const float* __restrict__ gain, bf16* WT, int dst_row0, LAS float* scr, int k0, int n0, int lane) {
    float tv[32];
#pragma unroll
    for (int i = 0; i < 32; ++i) { const int kk = 2 * i + (lane >> 5); tv[i] = W[(size_t)(k0 + kk) * N + n0 + (lane & 31)]; }
#pragma unroll
    for (int i = 0; i < 32; ++i) { const int kk = 2 * i + (lane >> 5); float v = tv[i]; if (gain) v *= gain[k0 + kk]; scr[kk * 33 + (lane & 31)] = v; }
    LDS_WAIT();
    const int c = lane & 7;
#pragma unroll
    for (int j = 0; j < 4; ++j) { const int n = (lane >> 3) + 8 * j; const LAS float* s = scr + (8 * c) * 33 + n;
        v4u o; o.x = pk2(s[0 * 33], s[1 * 33]); o.y = pk2(s[2 * 33], s[3 * 33]); o.z = pk2(s[4 * 33], s[5 * 33]); o.w = pk2(s[6 * 33], s[7 * 33]);
        *(v4u*)(WT + (size_t)(dst_row0 + n) * K + k0 + 8 * c) = o; }
    LDS_WAIT();
}

struct Args { const float* in[24]; float* out; unsigned char* ws; int ph_lo, ph_hi; };

__device__ __forceinline__ void phase_prologue(const Args& a, LAS unsigned char* lds, int gw, int ngw, int wave, int lane) {
    LAS float* scr = (LAS float*)(lds + wave * 16384);
    constexpr int I_IN = 16 * 96, I_OUT = 16 * 32, I_13 = 16 * 176, I_2 = 44 * 32, I_L = I_IN + I_OUT + I_13 + I_2;
    for (int it = gw; it < NLAYER * I_L; it += ngw) {
        const int L = it / I_L; int r = it - L * I_L;
        const float* win = (L == 1) ? a.in[6] : (L == 2) ? a.in[11] : (L == 0 ? a.in[3] : a.in[3] + (size_t)DM * NQKV);
        const float* wout = (L == 1) ? a.in[10] : (L == 2) ? a.in[21] : (L == 0 ? a.in[5] : a.in[5] + (size_t)DM * DM);
        bf16* wl = (bf16*)(a.ws + WS_W + (size_t)L * W_LAYER);
        if (r < I_IN) { const int kb = r / 96, nb = r % 96, n0 = 32 * nb; int dst = n0;
            if (L % 3 == 0) { const int j = n0 & 1023; dst = (n0 < DM) ? 2 * DM + n0 : 256 * (j / 128) + (n0 < 2 * DM ? 0 : 128) + (j % 128); }
            transpose_item(win, DM, NQKV, a.in[1] + L * DM, wl + W_IN / 2, dst, scr, 64 * kb, n0, lane); continue; }
        r -= I_IN;
        if (r < I_OUT) { const int kb = r / 32, nb = r % 32; transpose_item(wout, DM, DM, nullptr, wl + W_OUT / 2, 32 * nb, scr, 64 * kb, 32 * nb, lane); continue; }
        r -= I_OUT;
        if (r < I_13) { const int kb = r / 176, nb = r % 176, n0 = 32 * nb, half = n0 / FFH, j = n0 % FFH, dst = 256 * (j / 128) + 128 * half + (j % 128);
            transpose_item(a.in[22] + (size_t)L * DM * NW13, DM, NW13, a.in[2] + L * DM, wl + W_13 / 2, dst, scr, 64 * kb, n0, lane); continue; }
        r -= I_13;
        { const int kb = r / 32, nb = r % 32; transpose_item(a.in[23] + (size_t)L * FFH * DM, FFH, DM, nullptr, wl + W_2 / 2, 32 * nb, scr, 64 * kb, 32 * nb, lane); }
    }
    const float* w1 = a.in[14]; const float* b1 = a.in[15]; const float* w2 = a.in[16]; const float* b2 = a.in[17]; const float* fr = a.in[19];
    float* hid = (float*)(a.ws + WS_HID);
    for (int t = gw; t < SEQ; t += ngw) {
        float zv = 0.f;
        if (lane == 0) zv = (float)t / (float)(SEQ - 1);
        else if (lane <= 32) { const int k = (lane - 1) & 15; const float band = 1e-4f + (float)k * ((15.0f - 1e-4f) / 15.0f);
            const float ang = ((6.283185307179586f * (float)t) / (float)SEQ) * band; zv = (lane <= 16) ? cosf(ang) : -sinf(ang); }
        float a1 = b1[lane];
        for (int e = 0; e < 33; ++e) a1 += __shfl(zv, e) * w1[e * 64 + lane];
        const float f = fr[lane];
        const float h1 = sinf(f * a1);
        float a2 = b2[lane];
        for (int i = 0; i < 64; ++i) a2 += __shfl(h1, i) * w2[i * 64 + lane];
        hid[t * 64 + lane] = sinf(f * a2);
    }
}

__device__ __forceinline__ void phase_filters(const Args& a, LAS unsigned char* lds, int vcu, int G, int wave, int lane, int tid) {
    const float* hid = (const float*)(a.ws + WS_HID); const float* w3 = a.in[18]; bf16* KF = (bf16*)(a.ws + WS_KF);
    constexpr int HS = 272;
    for (int p0 = vcu * NWAVES; p0 < 2 * DM; p0 += G * NWAVES) {
        const int p = p0 + wave, o = p >> 10, d = p & 1023, cf = o * 2048 + d, cr = cf + 1024;
        const float delta = 4.605170185988091f * (1.0f / 1.5f + (float)d * ((1.0f / 0.3f - 1.0f / 1.5f) / 1023.0f));
        bf16* kf = KF + (size_t)p * KF_LEN;
        LAS float* wcol = (LAS float*)(lds + 17408 + NWAVES * 16384 + wave * 512);
        wcol[lane] = w3[(size_t)lane * 4096 + cf]; wcol[64 + lane] = w3[(size_t)lane * 4096 + cr];
        float asum = 0.f;
        LAS float* vals = (LAS float*)(lds + 17408 + wave * 16384);
        v4u hreg[2];
#pragma unroll
        for (int i = 0; i < 2; ++i) { const int idx = tid + 512 * i; hreg[i] = *(const v4u*)(hid + (size_t)(idx >> 4) * 64 + (idx & 15) * 4); }
#pragma unroll 1
        for (int tb = 0; tb < 32; ++tb) {
            __syncthreads();
#pragma unroll
            for (int i = 0; i < 2; ++i) { const int idx = tid + 512 * i; *(LAS v4u*)(lds + (idx >> 4) * HS + (idx & 15) * 16) = hreg[i]; }
            if (tb < 31) {
#pragma unroll
                for (int i = 0; i < 2; ++i) { const int idx = tid + 512 * i; hreg[i] = *(const v4u*)(hid + (size_t)((tb + 1) * 64 + (idx >> 4)) * 64 + (idx & 15) * 4); } }
            __syncthreads();
            const int t = tb * 64 + lane; const LAS f32x4* hr = (const LAS f32x4*)(lds + lane * HS);
            float af = 0.f, ar = 0.f;
#pragma unroll
            for (int j4 = 0; j4 < 16; ++j4) { const f32x4 h = hr[j4]; const f32x4 a4 = ((const LAS f32x4*)wcol)[j4], b4 = ((const LAS f32x4*)wcol)[16 + j4];
                af += h[0] * a4[0] + h[1] * a4[1] + h[2] * a4[2] + h[3] * a4[3];
                ar += h[0] * b4[0] + h[1] * b4[1] + h[2] * b4[2] + h[3] * b4[3]; }
            const float dec = __expf(-((float)t / (float)(SEQ - 1)) * delta);
            af *= dec; ar *= dec; vals[(2 * tb) * 64 + lane] = af; vals[(2 * tb + 1) * 64 + lane] = ar;
            asum += (t == 0) ? fabsf(af + ar) : (fabsf(af) + fabsf(ar));
        }
        const float inv = 1.0f / wave_sum(asum);
#pragma unroll 4
        for (int tb = 0; tb < 32; ++tb) { const int t = tb * 64 + lane; const float vf = vals[(2 * tb) * 64 + lane], vr = vals[(2 * tb + 1) * 64 + lane];
            if (t == 0) kf[2048] = f2bf((vf + vr) * inv); else { kf[2048 - t] = f2bf(vf * inv); kf[2048 + t] = f2bf(vr * inv); } }
        if (lane < 17) kf[lane == 0 ? 0 : 4095 + lane] = 0;
    }
    __syncthreads();
}

__device__ __forceinline__ void phase_norm0(const float* __restrict__ x, bf16* __restrict__ xn, float* __restrict__ ss, int gw, int ngw, int lane) {
    for (int m = gw; m < MTOK; m += ngw) {
        const f32x4* xr = (const f32x4*)(x + (size_t)m * DM) + lane;
        f32x4 v[4]; float s = 0.f;
#pragma unroll
        for (int j = 0; j < 4; ++j) { v[j] = xr[64 * j]; s += (v[j].x * v[j].x + v[j].y * v[j].y) + (v[j].z * v[j].z + v[j].w * v[j].w); }
        s = wave_sum(s);
        if (lane < 16) ss[(size_t)m * 16 + lane] = (lane == 0) ? s : 0.f;
        unsigned long long* o8 = (unsigned long long*)(xn + (size_t)m * DM) + lane;
#pragma unroll
        for (int j = 0; j < 4; ++j) o8[64 * j] = (unsigned long long)pk2(v[j].x, v[j].y) | ((unsigned long long)pk2(v[j].z, v[j].w) << 32);
    }
}

__device__ __forceinline__ void fill_row_scales(const pg8::StaticOrder& S, const float* ss, LAS float* rst, int tid) {
    for (int idx = tid; idx < 11 * 256; idx += NTHREADS) { pg8::Unit u; if (!S.next(idx >> 8, u)) break; rst[idx] = pg8::row_rscale(ss, u.pm * 256 + (idx & 255)); }
    __syncthreads();
}

__device__ __forceinline__ void phase_shortconv(const bf16* __restrict__ cu, const bf16* __restrict__ bg, const float* __restrict__ cw, bf16* __restrict__ outp, int gtid, int ngt) {
    for (int idx = gtid; idx < MTOK * 128; idx += ngt) {
        const int m = idx >> 7, d0 = (idx & 127) * 8, t = m & (SEQ - 1);
        const size_t o = (size_t)m * DM + d0;
        const v4u bv = *(const v4u*)(bg + o), c1 = *(const v4u*)(cu + o);
        v4u c0 = {0u, 0u, 0u, 0u}, c2 = c0;
        if (t > 0) c0 = *(const v4u*)(cu + o - DM);
        if (t < SEQ - 1) c2 = *(const v4u*)(cu + o + DM);
        const f32x4 wa0 = *(const f32x4*)(cw + d0), wa1 = *(const f32x4*)(cw + d0 + 4), wb0 = *(const f32x4*)(cw + DM + d0), wb1 = *(const f32x4*)(cw + DM + d0 + 4),
                    wc0 = *(const f32x4*)(cw + 2 * DM + d0), wc1 = *(const f32x4*)(cw + 2 * DM + d0 + 4);
        v4u ov;
#pragma unroll
        for (int k = 0; k < 4; ++k) {
            const float w0l = (k < 2) ? wa0[2 * k] : wa1[2 * k - 4], w0h = (k < 2) ? wa0[2 * k + 1] : wa1[2 * k - 3];
            const float w1l = (k < 2) ? wb0[2 * k] : wb1[2 * k - 4], w1h = (k < 2) ? wb0[2 * k + 1] : wb1[2 * k - 3];
            const float w2l = (k < 2) ? wc0[2 * k] : wc1[2 * k - 4], w2h = (k < 2) ? wc0[2 * k + 1] : wc1[2 * k - 3];
            const float lo = bflo(bv[k]) * (w0l * bflo(c0[k]) + w1l * bflo(c1[k]) + w2l * bflo(c2[k]));
            const float hi = bfhi(bv[k]) * (w0h * bfhi(c0[k]) + w1h * bfhi(c1[k]) + w2h * bfhi(c2[k]));
            ov[k] = pk2(lo, hi);
        }
        *(v4u*)(outp + o) = ov;
    }
}

__device__ __forceinline__ void norm_frag(const v4u r0, const v4u r1, const LAS float* g, int quad, float extra, bf16x8& f0, bf16x8& f1) {
    float x[16];
#pragma unroll
    for (int k = 0; k < 4; ++k) { x[2 * k] = bflo(r0[k]); x[2 * k + 1] = bfhi(r0[k]); x[8 + 2 * k] = bflo(r1[k]); x[9 + 2 * k] = bfhi(r1[k]); }
    float ss = 0.f;
#pragma unroll
    for (int k = 0; k < 16; ++k) ss += x[k] * x[k];
    ss += __shfl_xor(ss, 16); ss += __shfl_xor(ss, 32);
    const float r = rsqrtf(ss * (1.0f / 64.0f) + RMS_EPS) * extra;
    v4u o0, o1;
#pragma unroll
    for (int k = 0; k < 4; ++k) { o0[k] = pk2c(x[2 * k] * r * g[8 * quad + 2 * k], x[2 * k + 1] * r * g[8 * quad + 2 * k + 1]);
        o1[k] = pk2c(x[8 + 2 * k] * r * g[32 + 8 * quad + 2 * k], x[9 + 2 * k] * r * g[32 + 8 * quad + 2 * k + 1]); }
    f0 = __builtin_bit_cast(bf16x8, o0); f1 = __builtin_bit_cast(bf16x8, o1);
}

constexpr int AR_SLOT = 16640, AR_V = 8192, AR_RK = 16384, AR_NSLOT = 9, AR_RPB = AR_NSLOT * AR_SLOT, AR_G = AR_RPB + 1920;
__device__ __forceinline__ int ar_off(int k, int c) { return k * 128 + ((c ^ (k & 7)) << 4); }

constexpr int A3_NSLOT = 8, A3_RPB = A3_NSLOT * AR_SLOT, A3_G = A3_RPB + 1920, A3_CMB = A3_G + 256, A3_CMB_BYTES = 4608;
static_assert(A3_CMB + 4 * A3_CMB_BYTES <= MISC_OFF, "attention LDS map");
__device__ __forceinline__ void phase_natten3(const bf16* qkv, const float* qg, const float* kg, const float* rpb, const float* kss, bf16* outp, LAS unsigned char* lds, int vcu, int G, int wave, int lane, int tid) {
    LAS float* rpb_l = (LAS float*)(lds + A3_RPB); LAS float* g_l = (LAS float*)(lds + A3_G);
    const int n = lane & 15, quad = lane >> 4, qq = (lane >> 2) & 3, p = lane & 3;
    const int cb = wave & 3, kh = wave >> 2;
    LAS unsigned char* cmb = lds + A3_CMB + cb * A3_CMB_BYTES;
    const int lk = (tid >> 3) & 63, lc = tid & 7;
    for (int unit = vcu; unit < NB * 16; unit += G) {
        const int b = unit >> 4, h = unit & 15;
        const bf16* kvbase = qkv + (size_t)b * SEQ * NQKV + DM + h * 64 + lc * 8 + (size_t)lk * NQKV;
        const float* ksbase = kss + (size_t)(2 * h) * MTOK + (size_t)b * SEQ + tid;
        __syncthreads();
        for (int i = tid; i < 15 * 31; i += NTHREADS) rpb_l[i] = rpb[h * (15 * 31) + i];
        if (tid < 64) g_l[tid] = qg[tid] * kg[tid];
        {   v4u rk_[8], rv_[8]; float rs_[8];
#pragma unroll
            for (int rho = 0; rho < 8; ++rho) { const bf16* pp = kvbase + (size_t)rho * 64 * NQKV; rk_[rho] = *(const v4u*)pp; rv_[rho] = *(const v4u*)(pp + DM);
                rs_[rho] = (tid < 64) ? ksbase[rho * 64] + ksbase[MTOK + rho * 64] : 0.f; }
#pragma unroll
            for (int rho = 0; rho < 8; ++rho) { LAS unsigned char* slot = lds + rho * AR_SLOT; *(LAS v4u*)(slot + ar_off(lk, lc)) = rk_[rho]; *(LAS v4u*)(slot + AR_V + ar_off(lk, lc)) = rv_[rho];
                if (tid < 64) *(LAS float*)(slot + AR_RK + 4 * tid) = __builtin_amdgcn_rsqf(rs_[rho] * (1.0f / 64.0f) + RMS_EPS); } }
        int start = cb * 16 - 8; start = start < 0 ? 0 : (start > 32 ? 32 : start);
        const int qc = cb * 16 + n; int cs = qc - 8; cs = cs < 0 ? 0 : (cs > 48 ? 48 : cs);
        const bf16* qbase = qkv + (size_t)(b * SEQ + cb * 16 + n) * NQKV + h * 64 + 8 * quad;
        v4u qr0 = *(const v4u*)qbase, qr1 = *(const v4u*)(qbase + 32);
        __syncthreads();
#pragma unroll 1
        for (int r = 0; r < 32; ++r) {
            int rs = r - 4; rs = rs < 0 ? 0 : (rs > 24 ? 24 : rs);
            int rsn = r - 3; rsn = rsn < 0 ? 0 : (rsn > 24 ? 24 : rsn);
            const bool slide = (r < 31) && (rsn != rs);
            v4u nk = {0u, 0u, 0u, 0u}, nv = nk; float nss = 0.f;
            if (slide) { const bf16* pp = kvbase + (size_t)(rs + 8) * 64 * NQKV; nk = *(const v4u*)pp; nv = *(const v4u*)(pp + DM); if (tid < 64) nss = ksbase[(rs + 8) * 64] + ksbase[MTOK + (rs + 8) * 64]; }
            bf16x8 qf0, qf1;
            norm_frag(qr0, qr1, g_l, quad, 0.125f, qf0, qf1);
            if (r < 31) { const bf16* qp = qbase + (size_t)(r + 1) * 64 * NQKV; qr0 = *(const v4u*)qp; qr1 = *(const v4u*)(qp + 32); }
            f32x4 st[4][2];
#pragma unroll
            for (int jj = 0; jj < 4; ++jj) { const LAS unsigned char* slot = lds + ((rs + 4 * kh + jj) & 7) * AR_SLOT;
#pragma unroll
                for (int kt = 0; kt < 2; ++kt) { const int k = start + 16 * kt + n;
                    const bf16x8 kf0 = *(const LAS bf16x8*)(slot + ar_off(k, quad)), kf1 = *(const LAS bf16x8*)(slot + ar_off(k, quad + 4));
                    f32x4 sacc = {0.f, 0.f, 0.f, 0.f};
                    sacc = __builtin_amdgcn_mfma_f32_16x16x32_bf16(kf0, qf0, sacc, 0, 0, 0);
                    sacc = __builtin_amdgcn_mfma_f32_16x16x32_bf16(kf1, qf1, sacc, 0, 0, 0);
                    st[jj][kt] = sacc; } }
            float mx = -3.0e38f;
#pragma unroll
            for (int jj = 0; jj < 4; ++jj) { const int dr = rs + 4 * kh + jj - r + 7; const LAS unsigned char* slot = lds + ((rs + 4 * kh + jj) & 7) * AR_SLOT;
#pragma unroll
                for (int kt = 0; kt < 2; ++kt) { const f32x4 rk = *(const LAS f32x4*)(slot + AR_RK + 4 * (start + 16 * kt + 4 * quad));
#pragma unroll
                    for (int i = 0; i < 4; ++i) { const int kc = start + 16 * kt + 4 * quad + i; int dc = kc - qc + 15; dc = dc < 0 ? 0 : (dc > 30 ? 30 : dc);
                        const bool valid = (kc >= cs) && (kc < cs + 16);
                        const float v = valid ? st[jj][kt][i] * rk[i] + rpb_l[dr * 31 + dc] : -3.0e38f;
                        st[jj][kt][i] = v; mx = fmaxf(mx, v); } } }
            mx = fmaxf(mx, __shfl_xor(mx, 16)); mx = fmaxf(mx, __shfl_xor(mx, 32));
            float sum = 0.f;
#pragma unroll
            for (int jj = 0; jj < 4; ++jj)
#pragma unroll
                for (int kt = 0; kt < 2; ++kt)
#pragma unroll
                    for (int i = 0; i < 4; ++i) { const float e = __expf(st[jj][kt][i] - mx); st[jj][kt][i] = e; sum += e; }
            sum += __shfl_xor(sum, 16); sum += __shfl_xor(sum, 32);
            f32x4 oacc[4];
#pragma unroll
            for (int dt = 0; dt < 4; ++dt) oacc[dt] = (f32x4){0.f, 0.f, 0.f, 0.f};
            const int kl = start + 4 * quad + qq;
            v4i16_t lo[4][4], hi[4][4];
#pragma unroll
            for (int jj = 0; jj < 4; ++jj) {
                const unsigned vs = (unsigned)(unsigned long long)(lds + ((rs + 4 * kh + jj) & 7) * AR_SLOT + AR_V) + 8 * (p & 1);
#pragma unroll
                for (int dt = 0; dt < 4; ++dt) { const unsigned a_lo = vs + ar_off(kl, 2 * dt + (p >> 1)), a_hi = vs + ar_off(kl + 16, 2 * dt + (p >> 1));
                    asm volatile("ds_read_b64_tr_b16 %0, %1" : "=v"(lo[jj][dt]) : "v"(a_lo) : "memory");
                    asm volatile("ds_read_b64_tr_b16 %0, %1" : "=v"(hi[jj][dt]) : "v"(a_hi) : "memory"); } }
            bf16x8 pf[4];
#pragma unroll
            for (int jj = 0; jj < 4; ++jj) { const f32x4 s0 = st[jj][0], s1 = st[jj][1];
                v4u pw; pw.x = pk2c(s0[0], s0[1]); pw.y = pk2c(s0[2], s0[3]); pw.z = pk2c(s1[0], s1[1]); pw.w = pk2c(s1[2], s1[3]); pf[jj] = __builtin_bit_cast(bf16x8, pw); }
            asm volatile("s_waitcnt lgkmcnt(0)" ::: "memory"); __builtin_amdgcn_sched_barrier(0);
#pragma unroll
            for (int jj = 0; jj < 4; ++jj)
#pragma unroll
                for (int dt = 0; dt < 4; ++dt) {
                    const bf16x8 vf = (bf16x8){lo[jj][dt][0], lo[jj][dt][1], lo[jj][dt][2], lo[jj][dt][3], hi[jj][dt][0], hi[jj][dt][1], hi[jj][dt][2], hi[jj][dt][3]};
                    oacc[dt] = __builtin_amdgcn_mfma_f32_16x16x32_bf16(vf, pf[jj], oacc[dt], 0, 0, 0);
                }
            if (kh == 1) {
#pragma unroll
                for (int dt = 0; dt < 4; ++dt) *(LAS f32x4*)(cmb + (dt * 64 + lane) * 16) = oacc[dt];
                *(LAS float*)(cmb + 4096 + lane * 8) = mx; *(LAS float*)(cmb + 4096 + lane * 8 + 4) = sum;
            }
            __syncthreads();
            if (kh == 0) {
                const float mb = *(const LAS float*)(cmb + 4096 + lane * 8), lb = *(const LAS float*)(cmb + 4096 + lane * 8 + 4);
                const float M = fmaxf(mx, mb), fa = __expf(mx - M), fb = __expf(mb - M), inv = 1.0f / (sum * fa + lb * fb), wa = fa * inv, wb = fb * inv;
                bf16* op = outp + (size_t)(b * SEQ + r * 64 + cb * 16 + n) * DM + h * 64 + 4 * quad;
#pragma unroll
                for (int dt = 0; dt < 4; ++dt) { const f32x4 ob = *(const LAS f32x4*)(cmb + (dt * 64 + lane) * 16); const f32x4 o = oacc[dt] * wa + ob * wb;
                    v2u w; w.x = pk2c(o[0], o[1]); w.y = pk2c(o[2], o[3]); *(v2u*)(op + 16 * dt) = w; }
            }
            if (slide) { LAS unsigned char* slot = lds + ((rs + 8) & 7) * AR_SLOT; *(LAS v4u*)(slot + ar_off(lk, lc)) = nk; *(LAS v4u*)(slot + AR_V + ar_off(lk, lc)) = nv;
                if (tid < 64) *(LAS float*)(slot + AR_RK + 4 * tid) = __builtin_amdgcn_rsqf(nss * (1.0f / 64.0f) + RMS_EPS); }
            __syncthreads();
        }
    }
}

constexpr int CT_STRIDE = 144, CT_BYTES = 66 * CT_STRIDE;
__device__ __forceinline__ void hyena_pre_fetch(const bf16* big, int id, int lane, v4u (&v)[9]) {
    const int ct = id & 31, tt = id >> 5, b = tt >> 5, t0 = (tt & 31) * 64, c0 = ct * 64;
#pragma unroll
    for (int ps = 0; ps < 9; ++ps) { const int rr = ps * 8 + (lane >> 3), part = lane & 7, t = t0 - 1 + rr;
        v[ps] = (v4u){0u, 0u, 0u, 0u};
        if (rr < 66 && t >= 0 && t < SEQ) v[ps] = *(const v4u*)(big + (size_t)(b * SEQ + t) * NQKV + c0 + part * 8); }
}
__device__ __forceinline__ void phase_hyena_pre(const bf16* big, const float* sw, const float* sb, bf16* VTp, bf16* X1Tp, LAS unsigned char* lds, int gw, int ngw, int wave, int lane) {
    LAS unsigned char* scr = lds + wave * 16384;
    v4u vin[9];
    if (gw < 512 * 32) hyena_pre_fetch(big, gw, lane, vin);
    for (int id = gw; id < 512 * 32; id += ngw) {
        const int ct = id & 31, tt = id >> 5, b = tt >> 5, t0 = (tt & 31) * 64, c0 = ct * 64;
#pragma unroll
        for (int ps = 0; ps < 9; ++ps) { const int rr = ps * 8 + (lane >> 3), part = lane & 7; if (rr < 66) *(LAS v4u*)(scr + rr * CT_STRIDE + part * 16) = vin[ps]; }
        if (id + ngw < 512 * 32) hyena_pre_fetch(big, id + ngw, lane, vin);
        LDS_WAIT();
        const int cg = c0 + lane; const float w0 = sw[cg], w1 = sw[NQKV + cg], w2 = sw[2 * NQKV + cg], bias = sb[cg];
        const LAS unsigned short* col = (const LAS unsigned short*)(scr + 2 * lane);
        float pa = bf2f(col[0]), pb = bf2f(col[CT_STRIDE / 2]);
        v4u o[8];
#pragma unroll
        for (int g8 = 0; g8 < 8; ++g8) { float y[8];
#pragma unroll
            for (int k = 0; k < 8; ++k) { const float pc = bf2f(col[(g8 * 8 + k + 2) * (CT_STRIDE / 2)]); y[k] = w0 * pa + w1 * pb + w2 * pc + bias; pa = pb; pb = pc; }
            o[g8].x = pk2(y[0], y[1]); o[g8].y = pk2(y[2], y[3]); o[g8].z = pk2(y[4], y[5]); o[g8].w = pk2(y[6], y[7]); }
        LDS_WAIT();
#pragma unroll
        for (int g8 = 0; g8 < 8; ++g8) *(LAS v4u*)(scr + lane * CT_STRIDE + g8 * 16) = o[g8];
        LDS_WAIT();
#pragma unroll
        for (int ps = 0; ps < 8; ++ps) { const int cl = ps * 8 + (lane >> 3), part = lane & 7, cc = c0 + cl;
            const v4u v = *(const LAS v4u*)(scr + cl * CT_STRIDE + part * 16);
            bf16* op = (cc < DM ? VTp + (size_t)cc * NB * SEQ : X1Tp + (size_t)(cc - DM) * NB * SEQ) + (size_t)b * SEQ + t0 + part * 8;
            *(v4u*)op = v; }
        LDS_WAIT();
    }
}
constexpr int U_STRIDE = 4112, U_BYTES = 16 * U_STRIDE, CP_OFF = U_BYTES, CP_STRIDE = 8224;
struct HyFilt { v4u a, b; };
__device__ __forceinline__ HyFilt hyena_fetch_filter(const bf16* kf, int tid) { HyFilt f; const v4u* src = (const v4u*)kf; f.a = src[tid]; f.b = (tid < 2) ? src[512 + tid] : (v4u){0u, 0u, 0u, 0u}; return f; }
__device__ __forceinline__ void hyena_put_filter(LAS unsigned char* lds, const HyFilt& f, int tid) {
    *(LAS v4u*)(lds + CP_OFF + 16 * tid) = f.a;
    if (tid < 2) *(LAS v4u*)(lds + CP_OFF + 16 * (512 + tid)) = f.b;
    __syncthreads();
    const v4u lo = *(LAS v4u*)(lds + CP_OFF + 16 * tid), hi = *(LAS v4u*)(lds + CP_OFF + 16 * tid + 16);
    const unsigned s[8] = {lo.x, lo.y, lo.z, lo.w, hi.x, hi.y, hi.z, hi.w};
#pragma unroll
    for (int r = 1; r < 8; ++r) { v4u o;
#pragma unroll
        for (int w = 0; w < 4; ++w) { const int q = w + r / 2; o[w] = (r & 1) ? ((s[q] >> 16) | (s[q + 1] << 16)) : s[q]; }
        *(LAS v4u*)(lds + CP_OFF + r * CP_STRIDE + 16 * tid) = o; }
    __syncthreads();
}
__device__ __forceinline__ void hyena_conv(LAS unsigned char* lds, f32x4 (&acc)[16], unsigned toep0, unsigned uaddr0) {
#pragma unroll
    for (int ti = 0; ti < 16; ++ti) acc[ti] = (f32x4){0.f, 0.f, 0.f, 0.f};
#pragma unroll 1
    for (int k4 = 0; k4 < 16; ++k4) {
        bf16x8 uf[4];
#pragma unroll
        for (int s = 0; s < 4; ++s) uf[s] = *(const LAS bf16x8*)(lds + uaddr0 + 256 * k4 + 64 * s);
#pragma unroll
        for (int x = 0; x < 22; ++x) {
            const bf16x8 tf = *(const LAS bf16x8*)(lds + toep0 + 256 * k4 + 32 * x);
#pragma unroll
            for (int s = 0; s < 4; ++s) { const int ti = 15 + 2 * s - x; if (ti >= 0 && ti < 16) acc[ti] = __builtin_amdgcn_mfma_f32_16x16x32_bf16(tf, uf[s], acc[ti], 0, 0, 0); }
        }
    }
}
__device__ __forceinline__ void phase_hyena(bf16* VT, const bf16* X1T, const bf16* KF, const float* skip, LAS unsigned char* lds, int vcu, int G, int wave, int lane, int tid) {
    const int n = lane & 15, quad = lane >> 4, rho = (-n) & 7;
    const int base = 2048 - 256 * wave - n + 8 * quad;
    const unsigned toep0 = CP_OFF + rho * CP_STRIDE + 16 * ((base >> 3) - 30);
    const unsigned uaddr0 = n * U_STRIDE + 16 * quad;
    v4u ur[8]; HyFilt f0;
    if (vcu < DM) { const v4u* src = (const v4u*)(VT + (size_t)vcu * NB * SEQ);
#pragma unroll
        for (int k = 0; k < 8; ++k) ur[k] = src[tid + 512 * k];
        f0 = hyena_fetch_filter(KF + (size_t)vcu * KF_LEN, tid); }
    for (int d = vcu; d < DM; d += G) {
        bf16* vrow = VT + (size_t)d * NB * SEQ;
#pragma unroll
        for (int k = 0; k < 8; ++k) { const int c = tid + 512 * k; *(LAS v4u*)(lds + (c >> 8) * U_STRIDE + 16 * (c & 255)) = ur[k]; }
        hyena_put_filter(lds, f0, tid);
        const HyFilt f1 = hyena_fetch_filter(KF + (size_t)(DM + d) * KF_LEN, tid);
        v2u xx[16];
#pragma unroll
        for (int ti = 0; ti < 16; ++ti) xx[ti] = *(const v2u*)(X1T + ((size_t)d * NB + n) * SEQ + 256 * wave + 16 * ti + 4 * quad);
        f32x4 acc[16];
        hyena_conv(lds, acc, toep0, uaddr0);
        const float sk0 = skip[d], sk1 = skip[DM + d];
        v2u z[16];
#pragma unroll
        for (int ti = 0; ti < 16; ++ti) { const int t = 256 * wave + 16 * ti + 4 * quad;
            const v2u vv = *(const LAS v2u*)(lds + n * U_STRIDE + 2 * t);
            const float z0 = bflo(xx[ti].x) * (acc[ti][0] + sk0 * bflo(vv.x)), z1 = bfhi(xx[ti].x) * (acc[ti][1] + sk0 * bfhi(vv.x));
            const float z2 = bflo(xx[ti].y) * (acc[ti][2] + sk0 * bflo(vv.y)), z3 = bfhi(xx[ti].y) * (acc[ti][3] + sk0 * bfhi(vv.y));
            z[ti].x = pk2(z0, z1); z[ti].y = pk2(z2, z3); }
        __syncthreads();
#pragma unroll
        for (int ti = 0; ti < 16; ++ti) { const int t = 256 * wave + 16 * ti + 4 * quad; *(LAS v2u*)(lds + n * U_STRIDE + 2 * t) = z[ti]; }
        hyena_put_filter(lds, f1, tid);
        if (d + G < DM) { const v4u* src = (const v4u*)(VT + (size_t)(d + G) * NB * SEQ);
#pragma unroll
            for (int k = 0; k < 8; ++k) ur[k] = src[tid + 512 * k];
            f0 = hyena_fetch_filter(KF + (size_t)(d + G) * KF_LEN, tid); }
        hyena_conv(lds, acc, toep0, uaddr0);
        __syncthreads();
#pragma unroll
        for (int ti = 0; ti < 16; ++ti) { const int t = 256 * wave + 16 * ti + 4 * quad;
            const float o0 = acc[ti][0] + sk1 * bflo(z[ti].x), o1 = acc[ti][1] + sk1 * bfhi(z[ti].x), o2 = acc[ti][2] + sk1 * bflo(z[ti].y), o3 = acc[ti][3] + sk1 * bfhi(z[ti].y);
            v2u w; w.x = pk2(o0, o1); w.y = pk2(o2, o3); *(LAS v2u*)(lds + n * U_STRIDE + 2 * t) = w; }
        __syncthreads();
        {   v4u* dst = (v4u*)vrow;
#pragma unroll
            for (int k = 0; k < 8; ++k) { const int c = tid + 512 * k; dst[c] = *(const LAS v4u*)(lds + (c >> 8) * U_STRIDE + 16 * (c & 255)); } }
        __syncthreads();
    }
}
constexpr int C5_STRIDE = 132;
__device__ __forceinline__ void phase_hyena_post(const bf16* big, const float* sw, const float* sb, const bf16* ZT, bf16* outp, LAS unsigned char* lds, int gw, int ngw, int wave, int lane) {
    LAS unsigned char* scr = lds + wave * 16384;
    for (int id = gw; id < 512 * 16; id += ngw) {
        const int dtile = id & 15, tt = id >> 4, b = tt >> 5, t0 = (tt & 31) * 64, d0 = dtile * 64;
        const int cg = 2 * DM + d0 + lane; const float w0 = sw[cg], w1 = sw[NQKV + cg], w2 = sw[2 * NQKV + cg], bias = sb[cg];
        const bf16* pp = big + (size_t)(b * SEQ + t0) * NQKV + cg;
        unsigned short pr[66];
#pragma unroll
        for (int k = 0; k < 66; ++k) { const int t = t0 - 1 + k; pr[k] = (t >= 0 && t < SEQ) ? pp[(long)(k - 1) * NQKV] : (unsigned short)0; }
        v4u zv[8];
#pragma unroll
        for (int ps = 0; ps < 8; ++ps) { const int dd = ps * 8 + (lane >> 3), part = lane & 7; zv[ps] = *(const v4u*)(ZT + ((size_t)(d0 + dd) * NB + b) * SEQ + t0 + part * 8); }
#pragma unroll
        for (int ps = 0; ps < 8; ++ps) { const int dd = ps * 8 + (lane >> 3), part = lane & 7;
            LAS unsigned* w = (LAS unsigned*)(scr + dd * C5_STRIDE + part * 16); w[0] = zv[ps].x; w[1] = zv[ps].y; w[2] = zv[ps].z; w[3] = zv[ps].w; }
        LDS_WAIT();
        const LAS unsigned short* zr = (const LAS unsigned short*)(scr + lane * C5_STRIDE);
        bf16* op = outp + (size_t)(b * SEQ + t0) * DM + d0 + lane;
#pragma unroll
        for (int k = 0; k < 64; ++k) { const float y = (w0 * bf2f(pr[k]) + w1 * bf2f(pr[k + 1]) + w2 * bf2f(pr[k + 2]) + bias) * bf2f(zr[k]); op[(size_t)k * DM] = f2bf(y); }
        LDS_WAIT();
    }
}

__global__ void __launch_bounds__(NTHREADS, 2) mk_fwd(Args a) {
    extern __shared__ __attribute__((aligned(16))) unsigned char lds_raw[];
    LAS unsigned char* lds = (LAS unsigned char*)lds_raw;
    cg::grid_group grid = cg::this_grid();
    const int tid = threadIdx.x, lane = tid & 63, wave = __builtin_amdgcn_readfirstlane(tid >> 6);
    const int G = gridDim.x, bx = blockIdx.x;
    const int vcu = (G % 8 == 0) ? (bx % 8) * (G / 8) + bx / 8 : bx;
    const int gw = vcu * NWAVES + wave, ngw = G * NWAVES;
    unsigned char* ws = a.ws;
    float* SS = (float*)(ws + WS_SS); bf16* XN = (bf16*)(ws + WS_XN); bf16* VT = (bf16*)(ws + WS_VT); bf16* MIXO = (bf16*)(ws + WS_MIXO); bf16* BIG = (bf16*)(ws + WS_BIG);
    const int lo = a.ph_lo, hi = a.ph_hi; int ph = 0;
    volatile LAS unsigned* MISC = (volatile LAS unsigned*)(lds + MISC_OFF);
    if (tid < 16) MISC[tid] = 0u;
    __syncthreads();
    XcdBarrier xbar = xcd_barrier_post((unsigned*)(ws + WS_BAR), MISC);
#define PH_BEGIN if (ph >= lo && ph < hi) {
#define PH_END   if (ph + 1 < hi) { if (ph == 0) grid.sync(); else xcd_barrier(xbar); } } ++ph;

    PH_BEGIN phase_prologue(a, lds, gw, ngw, wave, lane);
    PH_END
    PH_BEGIN phase_filters(a, lds, vcu, G, wave, lane, tid); phase_norm0(a.in[0], XN, SS, gw, ngw, lane); PH_END

    { constexpr int L = 0;

        constexpr int kind = L % 3;
        const bf16* wl = (const bf16*)(ws + WS_W + (size_t)L * W_LAYER);
        PH_BEGIN { pg8::Gemm g{XN, wl + W_IN / 2, MTOK, NQKV, DM}; pg8::StaticOrder S; S.init(MTOK, NQKV, G, bx); fill_row_scales(S, SS, (LAS float*)(lds + RST_OFF), tid);
                   if constexpr (kind == 0) { pg8::EpiShortIn E{BIG, BIG + (size_t)MTOK * DM, (const LAS float*)(lds + RST_OFF)}; pg8::gemm_phase<pg8::EpiShortIn, pg8::StaticOrder, true, true>(lds, g, S, E); }
                   else { pg8::EpiBf16PT<(kind == 1)> E{BIG, NQKV, (const LAS float*)(lds + RST_OFF), (float*)(ws + WS_KSS), MTOK};
                   pg8::gemm_phase<pg8::EpiBf16PT<(kind == 1)>, pg8::StaticOrder, true, true>(lds, g, S, E); }
 } PH_END
        if (kind == 0) {
            PH_BEGIN phase_shortconv(BIG, BIG + (size_t)MTOK * DM, a.in[4] + (size_t)(L / 3) * 3 * DM, MIXO, vcu * NTHREADS + tid, G * NTHREADS);
            PH_END
        } else if (kind == 1) {
            PH_BEGIN
            phase_natten3(BIG, a.in[7], a.in[8], a.in[9], (const float*)(ws + WS_KSS), MIXO, lds, vcu, G, wave, lane, tid); PH_END
        } else {
            PH_BEGIN phase_hyena_pre(BIG, a.in[12], a.in[13], VT, MIXO, lds, gw, ngw, wave, lane);
            PH_END
            PH_BEGIN
            phase_hyena(VT, MIXO, (const bf16*)(ws + WS_KF), a.in[20], lds, vcu, G, wave, lane, tid); PH_END
            PH_BEGIN phase_hyena_post(BIG, a.in[12], a.in[13], VT, MIXO, lds, gw, ngw, wave, lane);
            PH_END
        }
        PH_BEGIN { pg8::Gemm g{MIXO, wl + W_OUT / 2, MTOK, DM, DM}; pg8::StaticOrder S; S.init(MTOK, DM, G, bx); pg8::EpiResNorm E{a.out, XN, SS, DM};
                   pg8::gemm_phase<pg8::EpiResNorm, pg8::StaticOrder, true, true>(lds, g, S, E); } PH_END
        PH_BEGIN { pg8::Gemm g{XN, wl + W_13 / 2, MTOK, NW13, DM}; pg8::StaticOrder S; S.init(MTOK, NW13, G, bx); pg8::EpiSwiGLU E{BIG, FFH, (const LAS float*)(lds + RST_OFF)}; fill_row_scales(S, SS, (LAS float*)(lds + RST_OFF), tid);
                   pg8::gemm_phase<pg8::EpiSwiGLU, pg8::StaticOrder, true, true>(lds, g, S, E);
 } PH_END
        PH_BEGIN { pg8::Gemm g{BIG, wl + W_2 / 2, MTOK, DM, FFH}; pg8::StaticOrder S; S.init(MTOK, DM, G, bx); pg8::EpiResNormT<(L == NLAYER - 1)> E{a.out, XN, SS, DM};
                   pg8::gemm_phase<pg8::EpiResNormT<(L == NLAYER - 1)>, pg8::StaticOrder, true, true>(lds, g, S, E); } PH_END
        }
    { constexpr int L = 1;

        constexpr int kind = L % 3;
        const bf16* wl = (const bf16*)(ws + WS_W + (size_t)L * W_LAYER);
        PH_BEGIN { pg8::Gemm g{XN, wl + W_IN / 2, MTOK, NQKV, DM}; pg8::StaticOrder S; S.init(MTOK, NQKV, G, bx); fill_row_scales(S, SS, (LAS float*)(lds + RST_OFF), tid);
                   if constexpr (kind == 0) { pg8::EpiShortIn E{BIG, BIG + (size_t)MTOK * DM, (const LAS float*)(lds + RST_OFF)}; pg8::gemm_phase<pg8::EpiShortIn, pg8::StaticOrder, true, true>(lds, g, S, E); }
                   else { pg8::EpiBf16PT<(kind == 1)> E{BIG, NQKV, (const LAS float*)(lds + RST_OFF), (float*)(ws + WS_KSS), MTOK};
                   pg8::gemm_phase<pg8::EpiBf16PT<(kind == 1)>, pg8::StaticOrder, true, true>(lds, g, S, E); }
 } PH_END
        if (kind == 0) {
            PH_BEGIN phase_shortconv(BIG, BIG + (size_t)MTOK * DM, a.in[4] + (size_t)(L / 3) * 3 * DM, MIXO, vcu * NTHREADS + tid, G * NTHREADS);
            PH_END
        } else if (kind == 1) {
            PH_BEGIN
            phase_natten3(BIG, a.in[7], a.in[8], a.in[9], (const float*)(ws + WS_KSS), MIXO, lds, vcu, G, wave, lane, tid); PH_END
        } else {
            PH_BEGIN phase_hyena_pre(BIG, a.in[12], a.in[13], VT, MIXO, lds, gw, ngw, wave, lane);
            PH_END
            PH_BEGIN
            phase_hyena(VT, MIXO, (const bf16*)(ws + WS_KF), a.in[20], lds, vcu, G, wave, lane, tid); PH_END
            PH_BEGIN phase_hyena_post(BIG, a.in[12], a.in[13], VT, MIXO, lds, gw, ngw, wave, lane);
            PH_END
        }
        PH_BEGIN { pg8::Gemm g{MIXO, wl + W_OUT / 2, MTOK, DM, DM}; pg8::StaticOrder S; S.init(MTOK, DM, G, bx); pg8::EpiResNorm E{a.out, XN, SS, DM};
                   pg8::gemm_phase<pg8::EpiResNorm, pg8::StaticOrder, true, true>(lds, g, S, E); } PH_END
        PH_BEGIN { pg8::Gemm g{XN, wl + W_13 / 2, MTOK, NW13, DM}; pg8::StaticOrder S; S.init(MTOK, NW13, G, bx); pg8::EpiSwiGLU E{BIG, FFH, (const LAS float*)(lds + RST_OFF)}; fill_row_scales(S, SS, (LAS float*)(lds + RST_OFF), tid);
                   pg8::gemm_phase<pg8::EpiSwiGLU, pg8::StaticOrder, true, true>(lds, g, S, E);
 } PH_END
        PH_BEGIN { pg8::Gemm g{BIG, wl + W_2 / 2, MTOK, DM, FFH}; pg8::StaticOrder S; S.init(MTOK, DM, G, bx); pg8::EpiResNormT<(L == NLAYER - 1)> E{a.out, XN, SS, DM};
                   pg8::gemm_phase<pg8::EpiResNormT<(L == NLAYER - 1)>, pg8::StaticOrder, true, true>(lds, g, S, E); } PH_END
        }
    { constexpr int L = 2;

        constexpr int kind = L % 3;
        const bf16* wl = (const bf16*)(ws + WS_W + (size_t)L * W_LAYER);
        PH_BEGIN { pg8::Gemm g{XN, wl + W_IN / 2, MTOK, NQKV, DM}; pg8::StaticOrder S; S.init(MTOK, NQKV, G, bx); fill_row_scales(S, SS, (LAS float*)(lds + RST_OFF), tid);
                   if constexpr (kind == 0) { pg8::EpiShortIn E{BIG, BIG + (size_t)MTOK * DM, (const LAS float*)(lds + RST_OFF)}; pg8::gemm_phase<pg8::EpiShortIn, pg8::StaticOrder, true, true>(lds, g, S, E); }
                   else { pg8::EpiBf16PT<(kind == 1)> E{BIG, NQKV, (const LAS float*)(lds + RST_OFF), (float*)(ws + WS_KSS), MTOK};
                   pg8::gemm_phase<pg8::EpiBf16PT<(kind == 1)>, pg8::StaticOrder, true, true>(lds, g, S, E); }
 } PH_END
        if (kind == 0) {
            PH_BEGIN phase_shortconv(BIG, BIG + (size_t)MTOK * DM, a.in[4] + (size_t)(L / 3) * 3 * DM, MIXO, vcu * NTHREADS + tid, G * NTHREADS);
            PH_END
        } else if (kind == 1) {
            PH_BEGIN
            phase_natten3(BIG, a.in[7], a.in[8], a.in[9], (const float*)(ws + WS_KSS), MIXO, lds, vcu, G, wave, lane, tid); PH_END
        } else {
            PH_BEGIN phase_hyena_pre(BIG, a.in[12], a.in[13], VT, MIXO, lds, gw, ngw, wave, lane);
            PH_END
            PH_BEGIN
            phase_hyena(VT, MIXO, (const bf16*)(ws + WS_KF), a.in[20], lds, vcu, G, wave, lane, tid); PH_END
            PH_BEGIN phase_hyena_post(BIG, a.in[12], a.in[13], VT, MIXO, lds, gw, ngw, wave, lane);
            PH_END
        }
        PH_BEGIN { pg8::Gemm g{MIXO, wl + W_OUT / 2, MTOK, DM, DM}; pg8::StaticOrder S; S.init(MTOK, DM, G, bx); pg8::EpiResNorm E{a.out, XN, SS, DM};
                   pg8::gemm_phase<pg8::EpiResNorm, pg8::StaticOrder, true, true>(lds, g, S, E); } PH_END
        PH_BEGIN { pg8::Gemm g{XN, wl + W_13 / 2, MTOK, NW13, DM}; pg8::StaticOrder S; S.init(MTOK, NW13, G, bx); pg8::EpiSwiGLU E{BIG, FFH, (const LAS float*)(lds + RST_OFF)}; fill_row_scales(S, SS, (LAS float*)(lds + RST_OFF), tid);
                   pg8::gemm_phase<pg8::EpiSwiGLU, pg8::StaticOrder, true, true>(lds, g, S, E);
 } PH_END
        PH_BEGIN { pg8::Gemm g{BIG, wl + W_2 / 2, MTOK, DM, FFH}; pg8::StaticOrder S; S.init(MTOK, DM, G, bx); pg8::EpiResNormT<(L == NLAYER - 1)> E{a.out, XN, SS, DM};
                   pg8::gemm_phase<pg8::EpiResNormT<(L == NLAYER - 1)>, pg8::StaticOrder, true, true>(lds, g, S, E); } PH_END
        }
    { constexpr int L = 3;

        constexpr int kind = L % 3;
        const bf16* wl = (const bf16*)(ws + WS_W + (size_t)L * W_LAYER);
        PH_BEGIN { pg8::Gemm g{XN, wl + W_IN / 2, MTOK, NQKV, DM}; pg8::StaticOrder S; S.init(MTOK, NQKV, G, bx); fill_row_scales(S, SS, (LAS float*)(lds + RST_OFF), tid);
                   if constexpr (kind == 0) { pg8::EpiShortIn E{BIG, BIG + (size_t)MTOK * DM, (const LAS float*)(lds + RST_OFF)}; pg8::gemm_phase<pg8::EpiShortIn, pg8::StaticOrder, true, true>(lds, g, S, E); }
                   else { pg8::EpiBf16PT<(kind == 1)> E{BIG, NQKV, (const LAS float*)(lds + RST_OFF), (float*)(ws + WS_KSS), MTOK};
                   pg8::gemm_phase<pg8::EpiBf16PT<(kind == 1)>, pg8::StaticOrder, true, true>(lds, g, S, E); }
 } PH_END
        if (kind == 0) {
            PH_BEGIN phase_shortconv(BIG, BIG + (size_t)MTOK * DM, a.in[4] + (size_t)(L / 3) * 3 * DM, MIXO, vcu * NTHREADS + tid, G * NTHREADS);
            PH_END
        } else if (kind == 1) {
            PH_BEGIN
            phase_natten3(BIG, a.in[7], a.in[8], a.in[9], (const float*)(ws + WS_KSS), MIXO, lds, vcu, G, wave, lane, tid); PH_END
        } else {
            PH_BEGIN phase_hyena_pre(BIG, a.in[12], a.in[13], VT, MIXO, lds, gw, ngw, wave, lane);
            PH_END
            PH_BEGIN
            phase_hyena(VT, MIXO, (const bf16*)(ws + WS_KF), a.in[20], lds, vcu, G, wave, lane, tid); PH_END
            PH_BEGIN phase_hyena_post(BIG, a.in[12], a.in[13], VT, MIXO, lds, gw, ngw, wave, lane);
            PH_END
        }
        PH_BEGIN { pg8::Gemm g{MIXO, wl + W_OUT / 2, MTOK, DM, DM}; pg8::StaticOrder S; S.init(MTOK, DM, G, bx); pg8::EpiResNorm E{a.out, XN, SS, DM};
                   pg8::gemm_phase<pg8::EpiResNorm, pg8::StaticOrder, true, true>(lds, g, S, E); } PH_END
        PH_BEGIN { pg8::Gemm g{XN, wl + W_13 / 2, MTOK, NW13, DM}; pg8::StaticOrder S; S.init(MTOK, NW13, G, bx); pg8::EpiSwiGLU E{BIG, FFH, (const LAS float*)(lds + RST_OFF)}; fill_row_scales(S, SS, (LAS float*)(lds + RST_OFF), tid);
                   pg8::gemm_phase<pg8::EpiSwiGLU, pg8::StaticOrder, true, true>(lds, g, S, E);
 } PH_END
        PH_BEGIN { pg8::Gemm g{BIG, wl + W_2 / 2, MTOK, DM, FFH}; pg8::StaticOrder S; S.init(MTOK, DM, G, bx); pg8::EpiResNormT<(L == NLAYER - 1)> E{a.out, XN, SS, DM};
                   pg8::gemm_phase<pg8::EpiResNormT<(L == NLAYER - 1)>, pg8::StaticOrder, true, true>(lds, g, S, E); } PH_END
        }
#undef PH_BEGIN
#undef PH_END
}
#ifndef MK_NPH
#define MK_NPH (2 + 5 + 5 + 7 + 5)
#endif
constexpr int N_PHASES = MK_NPH;

extern "C" void kernel_launch(void* const* d_in, const int* in_sizes, int n_in, void* d_out, int out_size, void* d_ws, size_t ws_size, hipStream_t stream) {
    static int grid = 0;
    if (grid == 0) {
        if (n_in != 24 || out_size != MTOK * DM || ws_size < WS_END) { fprintf(stderr, "kernel_launch: unexpected shapes (n_in %d, out %d, ws %zu); nothing launched\n", n_in, out_size, ws_size); grid = -1; return; }
        int dev = 0, cus = 0, per_cu = 0;
        if (hipGetDevice(&dev) != hipSuccess || hipDeviceGetAttribute(&cus, hipDeviceAttributeMultiprocessorCount, dev) != hipSuccess) { grid = -1; return; }
        if (hipFuncSetAttribute((const void*)mk_fwd, hipFuncAttributeMaxDynamicSharedMemorySize, LDS_BYTES) != hipSuccess) { fprintf(stderr, "kernel_launch: hipFuncSetAttribute failed\n"); grid = -1; return; }
        if (hipOccupancyMaxActiveBlocksPerMultiprocessor(&per_cu, (const void*)mk_fwd, NTHREADS, LDS_BYTES) != hipSuccess || per_cu < 1) { fprintf(stderr, "kernel_launch: occupancy query gives %d\n", per_cu); per_cu = 1; }
        (void)hipGetLastError();
        grid = cus;
    }
    if (grid < 0) return;
    Args a{};
    for (int i = 0; i < 24; ++i) a.in[i] = (const float*)d_in[i];
    a.out = (float*)d_out; a.ws = (unsigned char*)d_ws;
    if (hipMemsetAsync(d_ws, 0, CTL_ZERO_BYTES, stream) != hipSuccess) { fprintf(stderr, "kernel_launch: memset of the control words failed\n"); return; }
#if MK_N_LAUNCHES == 1
    a.ph_lo = 0; a.ph_hi = N_PHASES;
    { void* args[] = {&a}; hipError_t e = hipLaunchCooperativeKernel((const void*)mk_fwd, dim3(grid), dim3(NTHREADS), args, LDS_BYTES, stream);
      if (e != hipSuccess) fprintf(stderr, "kernel_launch: cooperative launch failed: %s (grid %d)\n", hipGetErrorString(e), grid); }
#else
    for (int p = 0; p < N_PHASES; ++p) { a.ph_lo = p; a.ph_hi = p + 1; void* args[] = {&a};
        hipError_t e = hipLaunchCooperativeKernel((const void*)mk_fwd, dim3(grid), dim3(NTHREADS), args, LDS_BYTES, stream);
        if (e != hipSuccess) { fprintf(stderr, "kernel_launch: launch %d failed: %s\n", p, hipGetErrorString(e)); break; } }
#endif
}
```

```cpp
#include <hip/hip_runtime.h>
#include <hip/hip_cooperative_groups.h>
#include <cstdio>
#include <cstdint>
namespace cg = cooperative_groups;
namespace pg8 {
#define PG8_LAS __attribute__((address_space(3)))
typedef unsigned short bf16_t;
typedef short bf16x8 __attribute__((ext_vector_type(8)));
typedef float f32x4 __attribute__((ext_vector_type(4)));
typedef unsigned u32x4 __attribute__((ext_vector_type(4)));
constexpr int BM = 256, BK = 64, HALF = 128, HTB = HALF * BK * 2  , STAGE_BYTES = 8 * HTB, NXCD = 8, WGM = 8;

__host__ __device__ __forceinline__ int lds_byte(int r, int c) { const int st = (r >> 4) * 2 + (c >> 5), rr = r & 15, cc = c & 31, ob = rr * 64 + cc * 2; return st * 1024 + (ob ^ (((ob >> 9) & 1) << 5)); }
__host__ __device__ __forceinline__ void stage_rc(int b, int& R, int& C) { const int st = b / 1024, sb = b % 1024, swz = sb ^ (((sb >> 9) & 1) << 5); R = (st >> 1) * 16 + swz / 64; C = (st & 1) * 32 + (swz % 64) / 2; }
__host__ __device__ __forceinline__ int perm32(int rho) { const int n = rho >> 4, i = rho & 15; return 8 * (i >> 2) + 4 * n + (i & 3); }

struct Unit { int pm, pn, idx; };
struct Gemm { const bf16_t* A; const bf16_t* Bt; int M, N, K; };

struct StaticOrder {
    int nM, nN, nwg, G, c;
    __host__ __device__ void init(int M, int N, int G_, int c_) { nM = M / BM; nN = N / BM; nwg = nM * nN; G = G_; c = c_; }
    __host__ __device__ bool next(int i, Unit& u) const {
        const long L = (long)i * G + c; if (L >= nwg) return false;
        int wgid = (int)L; { const int q = nwg / NXCD, r = nwg % NXCD, xcd = wgid % NXCD, off = wgid / NXCD; wgid = (xcd < r ? xcd * (q + 1) : r * (q + 1) + (xcd - r) * q) + off; }
        const int nig = WGM * nN, gid = wgid / nig, fm = gid * WGM, gsz = (nM - fm) < WGM ? (nM - fm) : WGM;
        u.pm = fm + ((wgid % nig) % gsz); u.pn = (wgid % nig) / gsz; u.idx = i; return true;
    }
    __device__ __forceinline__ void a_ready(const Unit&) const {}
    __device__ __forceinline__ void done(const Unit&) const {}
};
__device__ __forceinline__ unsigned cvt_pk_bf16(float lo, float hi) { unsigned r; asm volatile("v_cvt_pk_bf16_f32 %0, %1, %2" : "=v"(r) : "v"(lo), "v"(hi)); return r; }
__device__ __forceinline__ float row_rscale(const float* ss, int row) { const f32x4* p = (const f32x4*)(ss + (size_t)row * 16); const f32x4 a = (p[0] + p[1]) + (p[2] + p[3]);
    return __builtin_amdgcn_rsqf(((a[0] + a[1]) + (a[2] + a[3])) * (1.0f / 1024.0f) + 1e-6f); }
template <bool KSS = false> struct EpiBf16PT {
    static constexpr bool PERM = true, AFTER_DRAIN = false;
    bf16_t* O; int ldc; const PG8_LAS float* rst; float* kss; int mrows;
    __device__ __forceinline__ void operator()(const f32x4 (&acc)[2][2][4][2], const Unit& u, int wr, int wc, int fr, int fq) const {
        const int row0 = u.pm * BM + wr * 64 + fr, col0 = u.pn * BM + wc * 32 + 8 * fq;
        const bool kt = KSS && u.pn >= 4 && u.pn < 8;
#pragma unroll
        for (int ai = 0; ai < 2; ++ai)
#pragma unroll
            for (int m = 0; m < 4; ++m) { const int row = row0 + ai * HALF + m * 16; bf16_t* rowp = O + (size_t)row * ldc + col0; const float rs = rst[u.idx * 256 + wr * 64 + fr + ai * HALF + m * 16];
#pragma unroll
                for (int bj = 0; bj < 2; ++bj) { const f32x4 v0 = acc[ai][bj][m][0] * rs, v1 = acc[ai][bj][m][1] * rs;
                    u32x4 w; w.x = cvt_pk_bf16(v0[0], v0[1]); w.y = cvt_pk_bf16(v0[2], v0[3]); w.z = cvt_pk_bf16(v1[0], v1[1]); w.w = cvt_pk_bf16(v1[2], v1[3]);
                    *(u32x4*)(rowp + bj * HALF) = w;
                    if (kt) { float q = ((v0[0] * v0[0] + v0[1] * v0[1]) + (v0[2] * v0[2] + v0[3] * v0[3])) + ((v1[0] * v1[0] + v1[1] * v1[1]) + (v1[2] * v1[2] + v1[3] * v1[3]));
                        q += __shfl_xor(q, 16); q += __shfl_xor(q, 32);
                        if (fq == 0) kss[(size_t)((u.pn - 4) * 8 + bj * 4 + wc) * mrows + row] = q; } }
                if (KSS) asm volatile("" ::: "memory"); }
    }
};
typedef EpiBf16PT<false> EpiBf16P;
__device__ __forceinline__ float silu_mul(float g, float u) { return g * __builtin_amdgcn_rcpf(1.0f + __expf(-g)) * u; }
struct EpiSwiGLU {
    static constexpr bool PERM = true, AFTER_DRAIN = false;
    bf16_t* H; int ldh; const PG8_LAS float* rst;
    __device__ __forceinline__ void operator()(const f32x4 (&acc)[2][2][4][2], const Unit& u, int wr, int wc, int fr, int fq) const {
        const int row0 = u.pm * BM + wr * 64 + fr, col0 = u.pn * HALF + wc * 32 + 8 * fq;
#pragma unroll
        for (int ai = 0; ai < 2; ++ai)
#pragma unroll
            for (int m = 0; m < 4; ++m) { bf16_t* rowp = H + (size_t)(row0 + ai * HALF + m * 16) * ldh + col0; const float rs = rst[u.idx * 256 + wr * 64 + fr + ai * HALF + m * 16];
                const f32x4 g0 = acc[ai][0][m][0] * rs, g1 = acc[ai][0][m][1] * rs, u0 = acc[ai][1][m][0] * rs, u1 = acc[ai][1][m][1] * rs;
                u32x4 w; w.x = cvt_pk_bf16(silu_mul(g0[0], u0[0]), silu_mul(g0[1], u0[1])); w.y = cvt_pk_bf16(silu_mul(g0[2], u0[2]), silu_mul(g0[3], u0[3]));
                w.z = cvt_pk_bf16(silu_mul(g1[0], u1[0]), silu_mul(g1[1], u1[1])); w.w = cvt_pk_bf16(silu_mul(g1[2], u1[2]), silu_mul(g1[3], u1[3]));
                *(u32x4*)rowp = w; }
    }
};
typedef unsigned u32x2 __attribute__((ext_vector_type(2)));
struct EpiShortIn {
    static constexpr bool PERM = true, AFTER_DRAIN = false;
    bf16_t* CU; bf16_t* BG; const PG8_LAS float* rst;
    __device__ __forceinline__ void operator()(const f32x4 (&acc)[2][2][4][2], const Unit& u, int wr, int wc, int fr, int fq) const {
        const int row0 = u.pm * BM + wr * 64 + fr;
#pragma unroll
        for (int ai = 0; ai < 2; ++ai)
#pragma unroll
            for (int m = 0; m < 4; ++m) { const int row = row0 + ai * HALF + m * 16; const float rs = rst[u.idx * 256 + wr * 64 + fr + ai * HALF + m * 16];
                if (u.pn < 8) { const float r2 = rs * rs; const f32x4 c0 = acc[ai][0][m][0], c1 = acc[ai][0][m][1], u0 = acc[ai][1][m][0], u1 = acc[ai][1][m][1];
                    u32x4 w; w.x = cvt_pk_bf16(c0[0] * u0[0] * r2, c0[1] * u0[1] * r2); w.y = cvt_pk_bf16(c0[2] * u0[2] * r2, c0[3] * u0[3] * r2);
                    w.z = cvt_pk_bf16(c1[0] * u1[0] * r2, c1[1] * u1[1] * r2); w.w = cvt_pk_bf16(c1[2] * u1[2] * r2, c1[3] * u1[3] * r2);
                    *(u32x4*)(CU + (size_t)row * 1024 + u.pn * HALF + wc * 32 + 8 * fq) = w; }
                else { bf16_t* rowp = BG + (size_t)row * 1024 + (u.pn - 8) * BM + wc * 32 + 8 * fq;
#pragma unroll
                    for (int bj = 0; bj < 2; ++bj) { const f32x4 v0 = acc[ai][bj][m][0] * rs, v1 = acc[ai][bj][m][1] * rs;
                        u32x4 w; w.x = cvt_pk_bf16(v0[0], v0[1]); w.y = cvt_pk_bf16(v0[2], v0[3]); w.z = cvt_pk_bf16(v1[0], v1[1]); w.w = cvt_pk_bf16(v1[2], v1[3]);
                        *(u32x4*)(rowp + bj * HALF) = w; } } }
    }
};
template <bool LAST = false> struct EpiResNormT {
    static constexpr bool PERM = true, AFTER_DRAIN = false;
    float* out; bf16_t* xb; float* ss; int ldc;
    __device__ __forceinline__ void operator()(const f32x4 (&acc)[2][2][4][2], const Unit& u, int wr, int wc, int fr, int fq) const {
        const int row0 = u.pm * BM + wr * 64 + fr, col0 = u.pn * BM + wc * 32 + 8 * fq;
#pragma unroll
        for (int ai = 0; ai < 2; ++ai)
#pragma unroll
            for (int m = 0; m < 4; ++m) { const int row = row0 + ai * HALF + m * 16; const size_t off = (size_t)row * ldc + col0; float s = 0.f;
#pragma unroll
                for (int bj = 0; bj < 2; ++bj) { const size_t o = off + bj * HALF; const u32x4 b = *(const u32x4*)(xb + o);
                    f32x4 r0, r1;
                    r0[0] = __uint_as_float(b.x << 16) + acc[ai][bj][m][0][0]; r0[1] = __uint_as_float(b.x & 0xffff0000u) + acc[ai][bj][m][0][1];
                    r0[2] = __uint_as_float(b.y << 16) + acc[ai][bj][m][0][2]; r0[3] = __uint_as_float(b.y & 0xffff0000u) + acc[ai][bj][m][0][3];
                    r1[0] = __uint_as_float(b.z << 16) + acc[ai][bj][m][1][0]; r1[1] = __uint_as_float(b.z & 0xffff0000u) + acc[ai][bj][m][1][1];
                    r1[2] = __uint_as_float(b.w << 16) + acc[ai][bj][m][1][2]; r1[3] = __uint_as_float(b.w & 0xffff0000u) + acc[ai][bj][m][1][3];
                    if (LAST) { *(f32x4*)(out + o) = r0; *(f32x4*)(out + o + 4) = r1; }
                    else { s += ((r0[0] * r0[0] + r0[1] * r0[1]) + (r0[2] * r0[2] + r0[3] * r0[3])) + ((r1[0] * r1[0] + r1[1] * r1[1]) + (r1[2] * r1[2] + r1[3] * r1[3]));
                        u32x4 w; w.x = cvt_pk_bf16(r0[0], r0[1]); w.y = cvt_pk_bf16(r0[2], r0[3]); w.z = cvt_pk_bf16(r1[0], r1[1]); w.w = cvt_pk_bf16(r1[2], r1[3]); *(u32x4*)(xb + o) = w; } }
                if (!LAST) { s += __shfl_xor(s, 16); s += __shfl_xor(s, 32); if (fq == 0) ss[(size_t)row * 16 + u.pn * 4 + wc] = s; }
                asm volatile("" ::: "memory"); }
    }
};
typedef EpiResNormT<false> EpiResNorm;
template <class Epi, class Sched, bool ALIGN_EPI = false, bool SP2 = false>
__device__ __forceinline__ void gemm_phase(PG8_LAS unsigned char* lds, const Gemm g, const Sched& S, const Epi& E) {
    const int tid = threadIdx.x, wid = __builtin_amdgcn_readfirstlane(tid >> 6), lane = tid & 63, wr = wid >> 2, wc = wid & 3, fr = lane & 15, fq = lane >> 4;
    const int K = g.K, nt = K / BK;
    unsigned voffA[2], voffB[2];
#pragma unroll
    for (int i = 0; i < 2; ++i) { int R, C; stage_rc(tid * 16 + i * 8192, R, C); const int Rb = Epi::PERM ? ((R & ~31) + perm32(R & 31)) : R;
        voffA[i] = (unsigned)(R * K + C) * 2u; voffB[i] = (unsigned)(Rb * K + C) * 2u; }
    const size_t kstep = (size_t)(BK * 2);
    const size_t hstep = (size_t)HALF * K * 2;
    const size_t tstep = 2 * hstep;
    const unsigned ldsw = (unsigned)wid * 1024u;
    const int aoff = lds_byte(wr * 64 + fr, fq * 8), boff = lds_byte(wc * 32 + fr, fq * 8);
#define PG8_SA(b, h) (((b) * 2 + (h)) * HTB)
#define PG8_SB(b, h) ((4 + (b) * 2 + (h)) * HTB)
#define PG8_STAGE(bufoff, gbase, voff) do { _Pragma("unroll") for (int _i = 0; _i < 2; ++_i) \
        __builtin_amdgcn_global_load_lds((const unsigned*)((const char*)(gbase) + (voff)[_i]), (PG8_LAS unsigned*)(lds + (bufoff) + ldsw + _i * 8192), 16, 0, 0); } while (0)
#define PG8_LDA(dst, b, h) do { _Pragma("unroll") for (int m = 0; m < 4; ++m) _Pragma("unroll") for (int k = 0; k < 2; ++k) dst[m][k] = *(const PG8_LAS bf16x8*)(lds + PG8_SA(b, h) + aoff + m * 2048 + k * 1024); } while (0)
#define PG8_LDB(dst, b, h) do { _Pragma("unroll") for (int n = 0; n < 2; ++n) _Pragma("unroll") for (int k = 0; k < 2; ++k) dst[n][k] = *(const PG8_LAS bf16x8*)(lds + PG8_SB(b, h) + boff + n * 2048 + k * 1024); } while (0)
#define PG8_MMA(ai, bj, At, Bt) do { __builtin_amdgcn_s_setprio(1); _Pragma("unroll") for (int m = 0; m < 4; ++m) _Pragma("unroll") for (int n = 0; n < 2; ++n) _Pragma("unroll") for (int k = 0; k < 2; ++k) \
        acc[ai][bj][m][n] = __builtin_amdgcn_mfma_f32_16x16x32_bf16(Bt[n][k], At[m][k], acc[ai][bj][m][n], 0, 0, 0); __builtin_amdgcn_s_setprio(0); } while (0)
#define PG8_WAIT_V(n) asm volatile("s_waitcnt vmcnt(" #n ")" ::: "memory")
#define PG8_WAIT_L(n) asm volatile("s_waitcnt lgkmcnt(" #n ")" ::: "memory")
#define PG8_BAR __builtin_amdgcn_s_barrier()
#define PG8_SCHED __builtin_amdgcn_sched_barrier(0)
    Unit cur, nxt; int ui = 0;
    if (!S.next(0, cur)) return;
    f32x4 acc[2][2][4][2];
#pragma unroll
    for (int a = 0; a < 2; ++a)
#pragma unroll
        for (int b = 0; b < 2; ++b)
#pragma unroll
            for (int m = 0; m < 4; ++m)
#pragma unroll
                for (int n = 0; n < 2; ++n) acc[a][b][m][n] = (f32x4){0.f, 0.f, 0.f, 0.f};
    bf16x8 At[4][2], B0[2][2], B1[2][2];
    const char* cA = (const char*)g.A + (size_t)cur.pm * tstep; const char* cB = (const char*)g.Bt + (size_t)cur.pn * tstep;
    S.a_ready(cur);
    if constexpr (SP2) {
        PG8_STAGE(PG8_SB(0, 0), cB, voffB); PG8_STAGE(PG8_SB(0, 1), cB + hstep, voffB); PG8_STAGE(PG8_SA(0, 0), cA, voffA); PG8_STAGE(PG8_SA(0, 1), cA + hstep, voffA);
        if (wr == 1) PG8_BAR;
        PG8_WAIT_V(2); PG8_BAR;
        PG8_STAGE(PG8_SB(1, 0), cB + kstep, voffB); PG8_STAGE(PG8_SA(1, 0), cA + kstep, voffA); PG8_STAGE(PG8_SB(1, 1), cB + hstep + kstep, voffB);
        PG8_WAIT_V(6); PG8_BAR;
    } else {
        PG8_STAGE(PG8_SB(0, 0), cB, voffB); PG8_STAGE(PG8_SA(0, 0), cA, voffA); PG8_STAGE(PG8_SB(0, 1), cB + hstep, voffB); PG8_STAGE(PG8_SA(0, 1), cA + hstep, voffA);
        if (wr == 1) PG8_BAR;
        PG8_WAIT_V(4); PG8_BAR;
        PG8_STAGE(PG8_SB(1, 0), cB + kstep, voffB); PG8_STAGE(PG8_SA(1, 0), cA + kstep, voffA); PG8_STAGE(PG8_SB(1, 1), cB + hstep + kstep, voffB);
        PG8_WAIT_V(6); PG8_BAR;
    }
    for (;;) {
        const bool has_next = S.next(ui + 1, nxt);
        const char* nA = has_next ? (const char*)g.A + (size_t)nxt.pm * tstep : cA; const char* nB = has_next ? (const char*)g.Bt + (size_t)nxt.pn * tstep : cB;
        for (int t = 0; t < nt; t += 2) {
            const bool last = (t == nt - 2);
            const char* a1 = cA + (size_t)(t + 1) * kstep;
            const char* a2 = last ? nA : cA + (size_t)(t + 2) * kstep; const char* b2 = last ? nB : cB + (size_t)(t + 2) * kstep;
            const char* a3 = a2 + kstep; const char* b3 = b2 + kstep;
            if (last && has_next) S.a_ready(nxt);
            if constexpr (SP2) {
            PG8_LDB(B0, 0, 0); PG8_LDB(B1, 0, 1); PG8_SCHED; PG8_LDA(At, 0, 0); PG8_STAGE(PG8_SA(1, 1), a1 + hstep, voffA);
            PG8_WAIT_V(8); PG8_WAIT_L(0); PG8_BAR; PG8_MMA(0, 0, At, B0); PG8_MMA(0, 1, At, B1); PG8_BAR; PG8_SCHED;
            PG8_LDA(At, 0, 1); PG8_STAGE(PG8_SB(0, 0), b2, voffB); PG8_STAGE(PG8_SB(0, 1), b2 + hstep, voffB); PG8_STAGE(PG8_SA(0, 0), a2, voffA);
            PG8_WAIT_V(8); PG8_WAIT_L(0); PG8_BAR; PG8_MMA(1, 0, At, B0); PG8_MMA(1, 1, At, B1); PG8_BAR; PG8_SCHED;
            PG8_LDB(B0, 1, 0); PG8_LDB(B1, 1, 1); PG8_SCHED; PG8_LDA(At, 1, 0); PG8_STAGE(PG8_SA(0, 1), a2 + hstep, voffA);
            PG8_WAIT_V(8); PG8_WAIT_L(0); PG8_BAR; PG8_MMA(0, 0, At, B0); PG8_MMA(0, 1, At, B1); PG8_BAR; PG8_SCHED;
            PG8_LDA(At, 1, 1); PG8_STAGE(PG8_SB(1, 0), b3, voffB); PG8_STAGE(PG8_SB(1, 1), b3 + hstep, voffB); PG8_STAGE(PG8_SA(1, 0), a3, voffA);
            PG8_WAIT_V(8); PG8_WAIT_L(0); PG8_BAR; PG8_MMA(1, 0, At, B0); PG8_MMA(1, 1, At, B1); PG8_BAR; PG8_SCHED;
            } else {
            PG8_LDB(B0, 0, 0); PG8_SCHED; PG8_LDA(At, 0, 0); PG8_STAGE(PG8_SA(1, 1), a1 + hstep, voffA);
            PG8_WAIT_L(8); PG8_BAR; PG8_WAIT_L(0); PG8_MMA(0, 0, At, B0); PG8_BAR; PG8_SCHED;
            PG8_LDB(B1, 0, 1); PG8_STAGE(PG8_SB(0, 0), b2, voffB);
            PG8_BAR; PG8_WAIT_L(0); PG8_MMA(0, 1, At, B1); PG8_BAR;
            PG8_LDA(At, 0, 1); PG8_STAGE(PG8_SA(0, 0), a2, voffA);
            PG8_BAR; PG8_WAIT_L(0); PG8_MMA(1, 0, At, B0); PG8_BAR; PG8_SCHED;
            PG8_STAGE(PG8_SB(0, 1), b2 + hstep, voffB);
            PG8_WAIT_V(6); PG8_BAR; PG8_MMA(1, 1, At, B1); PG8_BAR;
            PG8_LDB(B0, 1, 0); PG8_SCHED; PG8_LDA(At, 1, 0); PG8_STAGE(PG8_SA(0, 1), a2 + hstep, voffA);
            PG8_WAIT_L(8); PG8_BAR; PG8_WAIT_L(0); PG8_MMA(0, 0, At, B0); PG8_BAR; PG8_SCHED;
            PG8_LDB(B1, 1, 1); PG8_STAGE(PG8_SB(1, 0), b3, voffB);
            PG8_BAR; PG8_WAIT_L(0); PG8_MMA(0, 1, At, B1); PG8_BAR;
            PG8_LDA(At, 1, 1); PG8_STAGE(PG8_SA(1, 0), a3, voffA);
            PG8_BAR; PG8_WAIT_L(0); PG8_MMA(1, 0, At, B0); PG8_BAR; PG8_SCHED;
            PG8_STAGE(PG8_SB(1, 1), b3 + hstep, voffB);
            PG8_WAIT_V(6); PG8_BAR; PG8_MMA(1, 1, At, B1); PG8_BAR;
            }
        }
        if constexpr (ALIGN_EPI) { if (wr == 0) PG8_BAR; }
        if constexpr (!Epi::AFTER_DRAIN) { E(acc, cur, wr, wc, fr, fq); S.done(cur); }
        if (!has_next) break;
#pragma unroll
        for (int a = 0; a < 2; ++a)
#pragma unroll
            for (int b = 0; b < 2; ++b)
#pragma unroll
                for (int m = 0; m < 4; ++m)
#pragma unroll
                    for (int n = 0; n < 2; ++n) acc[a][b][m][n] = (f32x4){0.f, 0.f, 0.f, 0.f};
        cur = nxt; cA = nA; cB = nB; ++ui;
        if constexpr (ALIGN_EPI) { if (wr == 1) PG8_BAR; }
    }
    PG8_WAIT_V(0);
    if constexpr (!ALIGN_EPI) { if (wr == 0) PG8_BAR; }
    PG8_BAR;
    if constexpr (Epi::AFTER_DRAIN) { E.fused(acc, cur, wr, wc, fr, fq, lds, wid, lane); S.done(cur); }
#undef PG8_SA
#undef PG8_SB
#undef PG8_STAGE
#undef PG8_LDA
#undef PG8_LDB
#undef PG8_MMA
#undef PG8_WAIT_V
#undef PG8_WAIT_L
#undef PG8_BAR
#undef PG8_SCHED
}
}

#ifndef MK_N_LAUNCHES
#define MK_N_LAUNCHES 1
#endif
constexpr int NB = 16, SEQ = 2048, DM = 1024, MTOK = NB * SEQ, NQKV = 3072, FFH = 2816, NW13 = 2 * FFH, NLAYER = 4;
constexpr float RMS_EPS = 1e-6f;
constexpr int NWAVES = 8, NTHREADS = 512;
constexpr size_t MiB = 1u << 20;
constexpr size_t WS_W = 1 * MiB, W_LAYER = 49 * MiB / 2;
constexpr size_t W_IN = 0, W_OUT = 6 * MiB, W_13 = 8 * MiB, W_2 = 19 * MiB;
constexpr size_t WS_SS = 439 * MiB;
constexpr size_t WS_HID = 100 * MiB;
constexpr size_t WS_KF = 102 * MiB;
constexpr int KF_LEN = 4112;
constexpr size_t WS_XN = 119 * MiB;
constexpr size_t WS_MIXO = 183 * MiB;
constexpr size_t WS_BIG = 247 * MiB;
constexpr size_t WS_VT = 441 * MiB;
constexpr size_t WS_KSS = 505 * MiB;
constexpr size_t WS_END = 509 * MiB;
constexpr int MISC_OFF = 163776, RST_OFF = 131072;
constexpr size_t WS_BAR = 16384, CTL_ZERO_BYTES = 65536;
constexpr int LDS_BYTES = 163840;
#define LAS __attribute__((address_space(3)))
typedef unsigned short bf16;
typedef unsigned v4u __attribute__((ext_vector_type(4)));
typedef unsigned v2u __attribute__((ext_vector_type(2)));
typedef float f32x4 __attribute__((ext_vector_type(4)));
typedef short bf16x8 __attribute__((ext_vector_type(8)));
typedef short v4i16_t __attribute__((ext_vector_type(4)));
#define LDS_WAIT() asm volatile("s_waitcnt lgkmcnt(0)" ::: "memory")
typedef float f32x2_cv __attribute__((ext_vector_type(2))); typedef __bf16 bf16x2_cv __attribute__((ext_vector_type(2)));
__device__ __forceinline__ unsigned pk2c(float lo, float hi) { const f32x2_cv v = {lo, hi}; const bf16x2_cv b = __builtin_convertvector(v, bf16x2_cv); return __builtin_bit_cast(unsigned, b); }
__device__ __forceinline__ unsigned pk2(float lo, float hi) { return pg8::cvt_pk_bf16(lo, hi); }
__device__ __forceinline__ float bflo(unsigned w) { return __uint_as_float(w << 16); }
__device__ __forceinline__ float bfhi(unsigned w) { return __uint_as_float(w & 0xffff0000u); }
__device__ __forceinline__ float bf2f(unsigned short b) { return __uint_as_float(((unsigned)b) << 16); }
__device__ __forceinline__ unsigned short f2bf(float f) { return (unsigned short)(pk2(f, 0.f) & 0xffffu); }
__device__ __forceinline__ float wave_sum(float v) {
#pragma unroll
    for (int o = 1; o < 64; o <<= 1) v += __shfl_xor(v, o);
    return v;
}

#define RLX_AGENT __ATOMIC_RELAXED, __HIP_MEMORY_SCOPE_AGENT
#define XB_TMO      128
#define XB_XCNT(j)  (256  + 64 * (j))
#define XB_XSUB(j)  (1280 + 64 * (j))
#define XB_XGEN(j)  (2304 + 64 * (j))
#define XB_TOP      3328
#define XB_TOPGEN   3392
#define XCD_BAR_WORDS 3456
#define XB_SPIN_CAP (1u << 18)

__device__ __forceinline__ unsigned xb_ld(unsigned* p)              { return __hip_atomic_load(p, __ATOMIC_RELAXED, __HIP_MEMORY_SCOPE_AGENT); }
__device__ __forceinline__ unsigned xb_add(unsigned* p, unsigned v) { return __hip_atomic_fetch_add(p, v, __ATOMIC_RELAXED, __HIP_MEMORY_SCOPE_AGENT); }
__device__ __forceinline__ unsigned xb_xcc_id() { return (unsigned)__builtin_amdgcn_s_getreg((3 << 11) | 20) & 0xFu; }
#define XB_SPIN(cond, bar) do { unsigned _sp = 0; while (cond) { __builtin_amdgcn_s_sleep(1); \
    if ((++_sp & 255u) == 0u) { if (xb_ld(&(bar)[XB_TMO])) break; if (_sp > XB_SPIN_CAP) { atomicAdd(&(bar)[XB_TMO], 1u); break; } } } } while (0)

struct XcdBarrier {
    unsigned* bar; unsigned x;
    volatile LAS unsigned* st;
};

__device__ __forceinline__ XcdBarrier xcd_barrier_post(unsigned* bar, volatile LAS unsigned* st) {
    XcdBarrier b; b.bar = bar; b.x = xb_xcc_id(); b.st = st;
    if (threadIdx.x == 0) (void)xb_add(&bar[XB_XCNT(b.x)], 1u);
    return b;
}
__device__ __forceinline__ void xcd_barrier_complete(unsigned* bar, unsigned x, unsigned& nloc, unsigned& nx) {
    const unsigned G = gridDim.x * gridDim.y * gridDim.z;
    unsigned sum, cnt, mine, sp = 0u;
    for (;;) {
        sum = 0u; cnt = 0u; mine = 0u;
#pragma unroll
        for (unsigned j = 0; j < 16; ++j) { const unsigned c = xb_ld(&bar[XB_XCNT(j)]); sum += c; cnt += (c > 0u) ? 1u : 0u; mine = (j == x) ? c : mine; }
        if (sum == G) break;
        __builtin_amdgcn_s_sleep(1);
        if ((++sp & 255u) == 0u) { if (xb_ld(&bar[XB_TMO])) break; if (sp > XB_SPIN_CAP) { atomicAdd(&bar[XB_TMO], 1u); break; } }
    }
    nloc = mine > 0u ? mine : 1u; nx = cnt > 0u ? cnt : 1u;
}

__device__ __forceinline__ void xcd_barrier(const XcdBarrier& b) {
    asm volatile("s_waitcnt vmcnt(0)" ::: "memory");
    __syncthreads();
    if (threadIdx.x == 0) {
        unsigned* bar = b.bar;
        __builtin_amdgcn_s_waitcnt(0);
        unsigned nloc = b.st[0], nx = b.st[1];
        if (nloc == 0u) { xcd_barrier_complete(bar, b.x, nloc, nx); b.st[0] = nloc; b.st[1] = nx; }
        const unsigned old = xb_add(&bar[XB_XSUB(b.x)], 1u);
        const unsigned gen = old / nloc;
        if (old + 1u == (gen + 1u) * nloc) {
            __builtin_amdgcn_fence(__ATOMIC_RELEASE, "agent");
            asm volatile("s_waitcnt vmcnt(0)" ::: "memory");
            const unsigned og = xb_add(&bar[XB_TOP], 1u);
            const unsigned tg = og / nx;
            if (og + 1u == (tg + 1u) * nx) xb_add(&bar[XB_TOPGEN], 1u);
            else XB_SPIN(xb_ld(&bar[XB_TOPGEN]) == tg, bar);
            __builtin_amdgcn_fence(__ATOMIC_ACQUIRE, "agent");
            xb_add(&bar[XB_XGEN(b.x)], 1u);
            asm volatile("s_waitcnt vmcnt(0)" ::: "memory");
        } else {
            XB_SPIN(xb_ld(&bar[XB_XGEN(b.x)]) == gen, bar);
            __builtin_amdgcn_fence(__ATOMIC_ACQUIRE, "agent");
            asm volatile("s_waitcnt vmcnt(0)" ::: "memory");
        }
    }
    __syncthreads();
}

__device__ __forceinline__ void transpose_item(const float* __restrict__ W, int K, int N, const float* __restrict__ gain, bf16* WT, int dst_row0, LAS float* scr, int k0, int n0, int lane) {
    float tv[32];
#pragma unroll
    for (int i = 0; i < 32; ++i) { const int kk = 2 * i + (lane >> 5); tv[i] = W[(size_t)(k0 + kk) * N + n0 + (lane & 31)]; }
#pragma unroll
    for (int i = 0; i < 32; ++i) { const int kk = 2 * i + (lane >> 5); float v = tv[i]; if (gain) v *= gain[k0 + kk]; scr[kk * 33 + (lane & 31)] = v; }
    LDS_WAIT();
    const int c = lane & 7;
#pragma unroll
    for (int j = 0; j < 4; ++j) { const int n = (lane >> 3) + 8 * j; const LAS float* s = scr + (8 * c) * 33 + n;
        v4u o; o.x = pk2(s[0 * 33], s[1 * 33]); o.y = pk2(s[2 * 33], s[3 * 33]); o.z = pk2(s[4 * 33], s[5 * 33]); o.w = pk2(s[6 * 33], s[7 * 33]);
        *(v4u*)(WT + (size_t)(dst_row0 + n) * K + k0 + 8 * c) = o; }
    LDS_WAIT();
}

struct Args { const float* in[24]; float* out; unsigned char* ws; int ph_lo, ph_hi; };

__device__ __forceinline__ void phase_prologue(const Args& a, LAS unsigned char* lds, int gw, int ngw, int wave, int lane) {
    LAS float* scr = (LAS float*)(lds + wave * 16384);
    constexpr int I_IN = 16 * 96, I_OUT = 16 * 32, I_13 = 16 * 176, I_2 = 44 * 32, I_L = I_IN + I_OUT + I_13 + I_2;
    for (int it = gw; it < NLAYER * I_L; it += ngw) {
        const int L = it / I_L; int r = it - L * I_L;
        const float* win = (L == 1) ? a.in[6] : (L == 2) ? a.in[11] : (L == 0 ? a.in[3] : a.in[3] + (size_t)DM * NQKV);
        const float* wout = (L == 1) ? a.in[10] : (L == 2) ? a.in[21] : (L == 0 ? a.in[5] : a.in[5] + (size_t)DM * DM);
        bf16* wl = (bf16*)(a.ws + WS_W + (size_t)L * W_LAYER);
        if (r < I_IN) { const int kb = r / 96, nb = r % 96, n0 = 32 * nb; int dst = n0;
            if (L % 3 == 0) { const int j = n0 & 1023; dst = (n0 < DM) ? 2 * DM + n0 : 256 * (j / 128) + (n0 < 2 * DM ? 0 : 128) + (j % 128); }
            transpose_item(win, DM, NQKV, a.in[1] + L * DM, wl + W_IN / 2, dst, scr, 64 * kb, n0, lane); continue; }
        r -= I_IN;
        if (r < I_OUT) { const int kb = r / 32, nb = r % 32; transpose_item(wout, DM, DM, nullptr, wl + W_OUT / 2, 32 * nb, scr, 64 * kb, 32 * nb, lane); continue; }
        r -= I_OUT;
        if (r < I_13) { const int kb = r / 176, nb = r % 176, n0 = 32 * nb, half = n0 / FFH, j = n0 % FFH, dst = 256 * (j / 128) + 128 * half + (j % 128);
            transpose_item(a.in[22] + (size_t)L * DM * NW13, DM, NW13, a.in[2] + L * DM, wl + W_13 / 2, dst, scr, 64 * kb, n0, lane); continue; }
        r -= I_13;
        { const int kb = r / 32, nb = r % 32; transpose_item(a.in[23] + (size_t)L * FFH * DM, FFH, DM, nullptr, wl + W_2 / 2, 32 * nb, scr, 64 * kb, 32 * nb, lane); }
    }
    const float* w1 = a.in[14]; const float* b1 = a.in[15]; const float* w2 = a.in[16]; const float* b2 = a.in[17]; const float* fr = a.in[19];
    float* hid = (float*)(a.ws + WS_HID);
    for (int t = gw; t < SEQ; t += ngw) {
        float zv = 0.f;
        if (lane == 0) zv = (float)t / (float)(SEQ - 1);
        else if (lane <= 32) { const int k = (lane - 1) & 15; const float band = 1e-4f + (float)k * ((15.0f - 1e-4f) / 15.0f);
            const float ang = ((6.283185307179586f * (float)t) / (float)SEQ) * band; zv = (lane <= 16) ? cosf(ang) : -sinf(ang); }
        float a1 = b1[lane];
        for (int e = 0; e < 33; ++e) a1 += __shfl(zv, e) * w1[e * 64 + lane];
        const float f = fr[lane];
        const float h1 = sinf(f * a1);
        float a2 = b2[lane];
        for (int i = 0; i < 64; ++i) a2 += __shfl(h1, i) * w2[i * 64 + lane];
        hid[t * 64 + lane] = sinf(f * a2);
    }
}

__device__ __forceinline__ void phase_filters(const Args& a, LAS unsigned char* lds, int vcu, int G, int wave, int lane, int tid) {
    const float* hid = (const float*)(a.ws + WS_HID); const float* w3 = a.in[18]; bf16* KF = (bf16*)(a.ws + WS_KF);
    constexpr int HS = 272;
    for (int p0 = vcu * NWAVES; p0 < 2 * DM; p0 += G * NWAVES) {
        const int p = p0 + wave, o = p >> 10, d = p & 1023, cf = o * 2048 + d, cr = cf + 1024;
        const float delta = 4.605170185988091f * (1.0f / 1.5f + (float)d * ((1.0f / 0.3f - 1.0f / 1.5f) / 1023.0f));
        bf16* kf = KF + (size_t)p * KF_LEN;
        LAS float* wcol = (LAS float*)(lds + 17408 + NWAVES * 16384 + wave * 512);
        wcol[lane] = w3[(size_t)lane * 4096 + cf]; wcol[64 + lane] = w3[(size_t)lane * 4096 + cr];
        float asum = 0.f;
        LAS float* vals = (LAS float*)(lds + 17408 + wave * 16384);
        v4u hreg[2];
#pragma unroll
        for (int i = 0; i < 2; ++i) { const int idx = tid + 512 * i; hreg[i] = *(const v4u*)(hid + (size_t)(idx >> 4) * 64 + (idx & 15) * 4); }
#pragma unroll 1
        for (int tb = 0; tb < 32; ++tb) {
            __syncthreads();
#pragma unroll
            for (int i = 0; i < 2; ++i) { const int idx = tid + 512 * i; *(LAS v4u*)(lds + (idx >> 4) * HS + (idx & 15) * 16) = hreg[i]; }
            if (tb < 31) {
#pragma unroll
                for (int i = 0; i < 2; ++i) { const int idx = tid + 512 * i; hreg[i] = *(const v4u*)(hid + (size_t)((tb + 1) * 64 + (idx >> 4)) * 64 + (idx & 15) * 4); } }
            __syncthreads();
            const int t = tb * 64 + lane; const LAS f32x4* hr = (const LAS f32x4*)(lds + lane * HS);
            float af = 0.f, ar = 0.f;
#pragma unroll
            for (int j4 = 0; j4 < 16; ++j4) { const f32x4 h = hr[j4]; const f32x4 a4 = ((const LAS f32x4*)wcol)[j4], b4 = ((const LAS f32x4*)wcol)[16 + j4];
                af += h[0] * a4[0] + h[1] * a4[1] + h[2] * a4[2] + h[3] * a4[3];
                ar += h[0] * b4[0] + h[1] * b4[1] + h[2] * b4[2] + h[3] * b4[3]; }
            const float dec = __expf(-((float)t / (float)(SEQ - 1)) * delta);
            af *= dec; ar *= dec; vals[(2 * tb) * 64 + lane] = af; vals[(2 * tb + 1) * 64 + lane] = ar;
            asum += (t == 0) ? fabsf(af + ar) : (fabsf(af) + fabsf(ar));
        }
        const float inv = 1.0f / wave_sum(asum);
#pragma unroll 4
        for (int tb = 0; tb < 32; ++tb) { const int t = tb * 64 + lane; const float vf = vals[(2 * tb) * 64 + lane], vr = vals[(2 * tb + 1) * 64 + lane];
            if (t == 0) kf[2048] = f2bf((vf + vr) * inv); else { kf[2048 - t] = f2bf(vf * inv); kf[2048 + t] = f2bf(vr * inv); } }
        if (lane < 17) kf[lane == 0 ? 0 : 4095 + lane] = 0;
    }
    __syncthreads();
}

__device__ __forceinline__ void phase_norm0(const float* __restrict__ x, bf16* __restrict__ xn, float* __restrict__ ss, int gw, int ngw, int lane) {
    for (int m = gw; m < MTOK; m += ngw) {
        const f32x4* xr = (const f32x4*)(x + (size_t)m * DM) + lane;
        f32x4 v[4]; float s = 0.f;
#pragma unroll
        for (int j = 0; j < 4; ++j) { v[j] = xr[64 * j]; s += (v[j].x * v[j].x + v[j].y * v[j].y) + (v[j].z * v[j].z + v[j].w * v[j].w); }
        s = wave_sum(s);
        if (lane < 16) ss[(size_t)m * 16 + lane] = (lane == 0) ? s : 0.f;
        unsigned long long* o8 = (unsigned long long*)(xn + (size_t)m * DM) + lane;
#pragma unroll
        for (int j = 0; j < 4; ++j) o8[64 * j] = (unsigned long long)pk2(v[j].x, v[j].y) | ((unsigned long long)pk2(v[j].z, v[j].w) << 32);
    }
}

__device__ __forceinline__ void fill_row_scales(const pg8::StaticOrder& S, const float* ss, LAS float* rst, int tid) {
    for (int idx = tid; idx < 11 * 256; idx += NTHREADS) { pg8::Unit u; if (!S.next(idx >> 8, u)) break; rst[idx] = pg8::row_rscale(ss, u.pm * 256 + (idx & 255)); }
    __syncthreads();
}

__device__ __forceinline__ void phase_shortconv(const bf16* __restrict__ cu, const bf16* __restrict__ bg, const float* __restrict__ cw, bf16* __restrict__ outp, int gtid, int ngt) {
    for (int idx = gtid; idx < MTOK * 128; idx += ngt) {
        const int m = idx >> 7, d0 = (idx & 127) * 8, t = m & (SEQ - 1);
        const size_t o = (size_t)m * DM + d0;
        const v4u bv = *(const v4u*)(bg + o), c1 = *(const v4u*)(cu + o);
        v4u c0 = {0u, 0u, 0u, 0u}, c2 = c0;
        if (t > 0) c0 = *(const v4u*)(cu + o - DM);
        if (t < SEQ - 1) c2 = *(const v4u*)(cu + o + DM);
        const f32x4 wa0 = *(const f32x4*)(cw + d0), wa1 = *(const f32x4*)(cw + d0 + 4), wb0 = *(const f32x4*)(cw + DM + d0), wb1 = *(const f32x4*)(cw + DM + d0 + 4),
                    wc0 = *(const f32x4*)(cw + 2 * DM + d0), wc1 = *(const f32x4*)(cw + 2 * DM + d0 + 4);
        v4u ov;
#pragma unroll
        for (int k = 0; k < 4; ++k) {
            const float w0l = (k < 2) ? wa0[2 * k] : wa1[2 * k - 4], w0h = (k < 2) ? wa0[2 * k + 1] : wa1[2 * k - 3];
            const float w1l = (k < 2) ? wb0[2 * k] : wb1[2 * k - 4], w1h = (k < 2) ? wb0[2 * k + 1] : wb1[2 * k - 3];
            const float w2l = (k < 2) ? wc0[2 * k] : wc1[2 * k - 4], w2h = (k < 2) ? wc0[2 * k + 1] : wc1[2 * k - 3];
            const float lo = bflo(bv[k]) * (w0l * bflo(c0[k]) + w1l * bflo(c1[k]) + w2l * bflo(c2[k]));
            const float hi = bfhi(bv[k]) * (w0h * bfhi(c0[k]) + w1h * bfhi(c1[k]) + w2h * bfhi(c2[k]));
            ov[k] = pk2(lo, hi);
        }
        *(v4u*)(outp + o) = ov;
    }
}

__device__ __forceinline__ void norm_frag(const v4u r0, const v4u r1, const LAS float* g, int quad, float extra, bf16x8& f0, bf16x8& f1) {
    float x[16];
#pragma unroll
    for (int k = 0; k < 4; ++k) { x[2 * k] = bflo(r0[k]); x[2 * k + 1] = bfhi(r0[k]); x[8 + 2 * k] = bflo(r1[k]); x[9 + 2 * k] = bfhi(r1[k]); }
    float ss = 0.f;
#pragma unroll
    for (int k = 0; k < 16; ++k) ss += x[k] * x[k];
    ss += __shfl_xor(ss, 16); ss += __shfl_xor(ss, 32);
    const float r = rsqrtf(ss * (1.0f / 64.0f) + RMS_EPS) * extra;
    v4u o0, o1;
#pragma unroll
    for (int k = 0; k < 4; ++k) { o0[k] = pk2c(x[2 * k] * r * g[8 * quad + 2 * k], x[2 * k + 1] * r * g[8 * quad + 2 * k + 1]);
        o1[k] = pk2c(x[8 + 2 * k] * r * g[32 + 8 * quad + 2 * k], x[9 + 2 * k] * r * g[32 + 8 * quad + 2 * k + 1]); }
    f0 = __builtin_bit_cast(bf16x8, o0); f1 = __builtin_bit_cast(bf16x8, o1);
}

constexpr int AR_SLOT = 16640, AR_V = 8192, AR_RK = 16384, AR_NSLOT = 9, AR_RPB = AR_NSLOT * AR_SLOT, AR_G = AR_RPB + 1920;
__device__ __forceinline__ int ar_off(int k, int c) { return k * 128 + ((c ^ (k & 7)) << 4); }

constexpr int A3_NSLOT = 8, A3_RPB = A3_NSLOT * AR_SLOT, A3_G = A3_RPB + 1920, A3_CMB = A3_G + 256, A3_CMB_BYTES = 4608;
static_assert(A3_CMB + 4 * A3_CMB_BYTES <= MISC_OFF, "attention LDS map");
__device__ __forceinline__ void phase_natten3(const bf16* qkv, const float* qg, const float* kg, const float* rpb, const float* kss, bf16* outp, LAS unsigned char* lds, int vcu, int G, int wave, int lane, int tid) {
    LAS float* rpb_l = (LAS float*)(lds + A3_RPB); LAS float* g_l = (LAS float*)(lds + A3_G);
    const int n = lane & 15, quad = lane >> 4, qq = (lane >> 2) & 3, p = lane & 3;
    const int cb = wave & 3, kh = wave >> 2;
    LAS unsigned char* cmb = lds + A3_CMB + cb * A3_CMB_BYTES;
    const int lk = (tid >> 3) & 63, lc = tid & 7;
    for (int unit = vcu; unit < NB * 16; unit += G) {
        const int b = unit >> 4, h = unit & 15;
        const bf16* kvbase = qkv + (size_t)b * SEQ * NQKV + DM + h * 64 + lc * 8 + (size_t)lk * NQKV;
        const float* ksbase = kss + (size_t)(2 * h) * MTOK + (size_t)b * SEQ + tid;
        __syncthreads();
        for (int i = tid; i < 15 * 31; i += NTHREADS) rpb_l[i] = rpb[h * (15 * 31) + i];
        if (tid < 64) g_l[tid] = qg[tid] * kg[tid];
        {   v4u rk_[8], rv_[8]; float rs_[8];
#pragma unroll
            for (int rho = 0; rho < 8; ++rho) { const bf16* pp = kvbase + (size_t)rho * 64 * NQKV; rk_[rho] = *(const v4u*)pp; rv_[rho] = *(const v4u*)(pp + DM);
                rs_[rho] = (tid < 64) ? ksbase[rho * 64] + ksbase[MTOK + rho * 64] : 0.f; }
#pragma unroll
            for (int rho = 0; rho < 8; ++rho) { LAS unsigned char* slot = lds + rho * AR_SLOT; *(LAS v4u*)(slot + ar_off(lk, lc)) = rk_[rho]; *(LAS v4u*)(slot + AR_V + ar_off(lk, lc)) = rv_[rho];
                if (tid < 64) *(LAS float*)(slot + AR_RK + 4 * tid) = __builtin_amdgcn_rsqf(rs_[rho] * (1.0f / 64.0f) + RMS_EPS); } }
        int start = cb * 16 - 8; start = start < 0 ? 0 : (start > 32 ? 32 : start);
        const int qc = cb * 16 + n; int cs = qc - 8; cs = cs < 0 ? 0 : (cs > 48 ? 48 : cs);
        const bf16* qbase = qkv + (size_t)(b * SEQ + cb * 16 + n) * NQKV + h * 64 + 8 * quad;
        v4u qr0 = *(const v4u*)qbase, qr1 = *(const v4u*)(qbase + 32);
        __syncthreads();
#pragma unroll 1
        for (int r = 0; r < 32; ++r) {
            int rs = r - 4; rs = rs < 0 ? 0 : (rs > 24 ? 24 : rs);
            int rsn = r - 3; rsn = rsn < 0 ? 0 : (rsn > 24 ? 24 : rsn);
            const bool slide = (r < 31) && (rsn != rs);
            v4u nk = {0u, 0u, 0u, 0u}, nv = nk; float nss = 0.f;
            if (slide) { const bf16* pp = kvbase + (size_t)(rs + 8) * 64 * NQKV; nk = *(const v4u*)pp; nv = *(const v4u*)(pp + DM); if (tid < 64) nss = ksbase[(rs + 8) * 64] + ksbase[MTOK + (rs + 8) * 64]; }
            bf16x8 qf0, qf1;
            norm_frag(qr0, qr1, g_l, quad, 0.125f, qf0, qf1);
            if (r < 31) { const bf16* qp = qbase + (size_t)(r + 1) * 64 * NQKV; qr0 = *(const v4u*)qp; qr1 = *(const v4u*)(qp + 32); }
            f32x4 st[4][2];
#pragma unroll
            for (int jj = 0; jj < 4; ++jj) { const LAS unsigned char* slot = lds + ((rs + 4 * kh + jj) & 7) * AR_SLOT;
#pragma unroll
                for (int kt = 0; kt < 2; ++kt) { const int k = start + 16 * kt + n;
                    const bf16x8 kf0 = *(const LAS bf16x8*)(slot + ar_off(k, quad)), kf1 = *(const LAS bf16x8*)(slot + ar_off(k, quad + 4));
                    f32x4 sacc = {0.f, 0.f, 0.f, 0.f};
                    sacc = __builtin_amdgcn_mfma_f32_16x16x32_bf16(kf0, qf0, sacc, 0, 0, 0);
                    sacc = __builtin_amdgcn_mfma_f32_16x16x32_bf16(kf1, qf1, sacc, 0, 0, 0);
                    st[jj][kt] = sacc; } }
            float mx = -3.0e38f;
#pragma unroll
            for (int jj = 0; jj < 4; ++jj) { const int dr = rs + 4 * kh + jj - r + 7; const LAS unsigned char* slot = lds + ((rs + 4 * kh + jj) & 7) * AR_SLOT;
#pragma unroll
                for (int kt = 0; kt < 2; ++kt) { const f32x4 rk = *(const LAS f32x4*)(slot + AR_RK + 4 * (start + 16 * kt + 4 * quad));
#pragma unroll
                    for (int i = 0; i < 4; ++i) { const int kc = start + 16 * kt + 4 * quad + i; int dc = kc - qc + 15; dc = dc < 0 ? 0 : (dc > 30 ? 30 : dc);
                        const bool valid = (kc >= cs) && (kc < cs + 16);
                        const float v = valid ? st[jj][kt][i] * rk[i] + rpb_l[dr * 31 + dc] : -3.0e38f;
                        st[jj][kt][i] = v; mx = fmaxf(mx, v); } } }
            mx = fmaxf(mx, __shfl_xor(mx, 16)); mx = fmaxf(mx, __shfl_xor(mx, 32));
            float sum = 0.f;
#pragma unroll
            for (int jj = 0; jj < 4; ++jj)
#pragma unroll
                for (int kt = 0; kt < 2; ++kt)
#pragma unroll
                    for (int i = 0; i < 4; ++i) { const float e = __expf(st[jj][kt][i] - mx); st[jj][kt][i] = e; sum += e; }
            sum += __shfl_xor(sum, 16); sum += __shfl_xor(sum, 32);
            f32x4 oacc[4];
#pragma unroll
            for (int dt = 0; dt < 4; ++dt) oacc[dt] = (f32x4){0.f, 0.f, 0.f, 0.f};
            const int kl = start + 4 * quad + qq;
            v4i16_t lo[4][4], hi[4][4];
#pragma unroll
            for (int jj = 0; jj < 4; ++jj) {
                const unsigned vs = (unsigned)(unsigned long long)(lds + ((rs + 4 * kh + jj) & 7) * AR_SLOT + AR_V) + 8 * (p & 1);
#pragma unroll
                for (int dt = 0; dt < 4; ++dt) { const unsigned a_lo = vs + ar_off(kl, 2 * dt + (p >> 1)), a_hi = vs + ar_off(kl + 16, 2 * dt + (p >> 1));
                    asm volatile("ds_read_b64_tr_b16 %0, %1" : "=v"(lo[jj][dt]) : "v"(a_lo) : "memory");
                    asm volatile("ds_read_b64_tr_b16 %0, %1" : "=v"(hi[jj][dt]) : "v"(a_hi) : "memory"); } }
            bf16x8 pf[4];
#pragma unroll
            for (int jj = 0; jj < 4; ++jj) { const f32x4 s0 = st[jj][0], s1 = st[jj][1];
                v4u pw; pw.x = pk2c(s0[0], s0[1]); pw.y = pk2c(s0[2], s0[3]); pw.z = pk2c(s1[0], s1[1]); pw.w = pk2c(s1[2], s1[3]); pf[jj] = __builtin_bit_cast(bf16x8, pw); }
            asm volatile("s_waitcnt lgkmcnt(0)" ::: "memory"); __builtin_amdgcn_sched_barrier(0);
#pragma unroll
            for (int jj = 0; jj < 4; ++jj)
#pragma unroll
                for (int dt = 0; dt < 4; ++dt) {
                    const bf16x8 vf = (bf16x8){lo[jj][dt][0], lo[jj][dt][1], lo[jj][dt][2], lo[jj][dt][3], hi[jj][dt][0], hi[jj][dt][1], hi[jj][dt][2], hi[jj][dt][3]};
                    oacc[dt] = __builtin_amdgcn_mfma_f32_16x16x32_bf16(vf, pf[jj], oacc[dt], 0, 0, 0);
                }
            if (kh == 1) {
#pragma unroll
                for (int dt = 0; dt < 4; ++dt) *(LAS f32x4*)(cmb + (dt * 64 + lane) * 16) = oacc[dt];
                *(LAS float*)(cmb + 4096 + lane * 8) = mx; *(LAS float*)(cmb + 4096 + lane * 8 + 4) = sum;
            }
            __syncthreads();
            if (kh == 0) {
                const float mb = *(const LAS float*)(cmb + 4096 + lane * 8), lb = *(const LAS float*)(cmb + 4096 + lane * 8 + 4);
                const float M = fmaxf(mx, mb), fa = __expf(mx - M), fb = __expf(mb - M), inv = 1.0f / (sum * fa + lb * fb), wa = fa * inv, wb = fb * inv;
                bf16* op = outp + (size_t)(b * SEQ + r * 64 + cb * 16 + n) * DM + h * 64 + 4 * quad;
#pragma unroll
                for (int dt = 0; dt < 4; ++dt) { const f32x4 ob = *(const LAS f32x4*)(cmb + (dt * 64 + lane) * 16); const f32x4 o = oacc[dt] * wa + ob * wb;
                    v2u w; w.x = pk2c(o[0], o[1]); w.y = pk2c(o[2], o[3]); *(v2u*)(op + 16 * dt) = w; }
            }
            if (slide) { LAS unsigned char* slot = lds + ((rs + 8) & 7) * AR_SLOT; *(LAS v4u*)(slot + ar_off(lk, lc)) = nk; *(LAS v4u*)(slot + AR_V + ar_off(lk, lc)) = nv;
                if (tid < 64) *(LAS float*)(slot + AR_RK + 4 * tid) = __builtin_amdgcn_rsqf(nss * (1.0f / 64.0f) + RMS_EPS); }
            __syncthreads();
        }
    }
}

constexpr int CT_STRIDE = 144, CT_BYTES = 66 * CT_STRIDE;
__device__ __forceinline__ void hyena_pre_fetch(const bf16* big, int id, int lane, v4u (&v)[9]) {
    const int ct = id & 31, tt = id >> 5, b = tt >> 5, t0 = (tt & 31) * 64, c0 = ct * 64;
#pragma unroll
    for (int ps = 0; ps < 9; ++ps) { const int rr = ps * 8 + (lane >> 3), part = lane & 7, t = t0 - 1 + rr;
        v[ps] = (v4u){0u, 0u, 0u, 0u};
        if (rr < 66 && t >= 0 && t < SEQ) v[ps] = *(const v4u*)(big + (size_t)(b * SEQ + t) * NQKV + c0 + part * 8); }
}
__device__ __forceinline__ void phase_hyena_pre(const bf16* big, const float* sw, const float* sb, bf16* VTp, bf16* X1Tp, LAS unsigned char* lds, int gw, int ngw, int wave, int lane) {
    LAS unsigned char* scr = lds + wave * 16384;
    v4u vin[9];
    if (gw < 512 * 32) hyena_pre_fetch(big, gw, lane, vin);
    for (int id = gw; id < 512 * 32; id += ngw) {
        const int ct = id & 31, tt = id >> 5, b = tt >> 5, t0 = (tt & 31) * 64, c0 = ct * 64;
#pragma unroll
        for (int ps = 0; ps < 9; ++ps) { const int rr = ps * 8 + (lane >> 3), part = lane & 7; if (rr < 66) *(LAS v4u*)(scr + rr * CT_STRIDE + part * 16) = vin[ps]; }
        if (id + ngw < 512 * 32) hyena_pre_fetch(big, id + ngw, lane, vin);
        LDS_WAIT();
        const int cg = c0 + lane; const float w0 = sw[cg], w1 = sw[NQKV + cg], w2 = sw[2 * NQKV + cg], bias = sb[cg];
        const LAS unsigned short* col = (const LAS unsigned short*)(scr + 2 * lane);
        float pa = bf2f(col[0]), pb = bf2f(col[CT_STRIDE / 2]);
        v4u o[8];
#pragma unroll
        for (int g8 = 0; g8 < 8; ++g8) { float y[8];
#pragma unroll
            for (int k = 0; k < 8; ++k) { const float pc = bf2f(col[(g8 * 8 + k + 2) * (CT_STRIDE / 2)]); y[k] = w0 * pa + w1 * pb + w2 * pc + bias; pa = pb; pb = pc; }
            o[g8].x = pk2(y[0], y[1]); o[g8].y = pk2(y[2], y[3]); o[g8].z = pk2(y[4], y[5]); o[g8].w = pk2(y[6], y[7]); }
        LDS_WAIT();
#pragma unroll
        for (int g8 = 0; g8 < 8; ++g8) *(LAS v4u*)(scr + lane * CT_STRIDE + g8 * 16) = o[g8];
        LDS_WAIT();
#pragma unroll
        for (int ps = 0; ps < 8; ++ps) { const int cl = ps * 8 + (lane >> 3), part = lane & 7, cc = c0 + cl;
            const v4u v = *(const LAS v4u*)(scr + cl * CT_STRIDE + part * 16);
            bf16* op = (cc < DM ? VTp + (size_t)cc * NB * SEQ : X1Tp + (size_t)(cc - DM) * NB * SEQ) + (size_t)b * SEQ + t0 + part * 8;
            *(v4u*)op = v; }
        LDS_WAIT();
    }
}
constexpr int U_STRIDE = 4112, U_BYTES = 16 * U_STRIDE, CP_OFF = U_BYTES, CP_STRIDE = 8224;
struct HyFilt { v4u a, b; };
__device__ __forceinline__ HyFilt hyena_fetch_filter(const bf16* kf, int tid) { HyFilt f; const v4u* src = (const v4u*)kf; f.a = src[tid]; f.b = (tid < 2) ? src[512 + tid] : (v4u){0u, 0u, 0u, 0u}; return f; }
__device__ __forceinline__ void hyena_put_filter(LAS unsigned char* lds, const HyFilt& f, int tid) {
    *(LAS v4u*)(lds + CP_OFF + 16 * tid) = f.a;
    if (tid < 2) *(LAS v4u*)(lds + CP_OFF + 16 * (512 + tid)) = f.b;
    __syncthreads();
    const v4u lo = *(LAS v4u*)(lds + CP_OFF + 16 * tid), hi = *(LAS v4u*)(lds + CP_OFF + 16 * tid + 16);
    const unsigned s[8] = {lo.x, lo.y, lo.z, lo.w, hi.x, hi.y, hi.z, hi.w};
#pragma unroll
    for (int r = 1; r < 8; ++r) { v4u o;
#pragma unroll
        for (int w = 0; w < 4; ++w) { const int q = w + r / 2; o[w] = (r & 1) ? ((s[q] >> 16) | (s[q + 1] << 16)) : s[q]; }
        *(LAS v4u*)(lds + CP_OFF + r * CP_STRIDE + 16 * tid) = o; }
    __syncthreads();
}
__device__ __forceinline__ void hyena_conv(LAS unsigned char* lds, f32x4 (&acc)[16], unsigned toep0, unsigned uaddr0) {
#pragma unroll
    for (int ti = 0; ti < 16; ++ti) acc[ti] = (f32x4){0.f, 0.f, 0.f, 0.f};
#pragma unroll 1
    for (int k8 = 0; k8 < 8; ++k8) {
        bf16x8 uf[8];
#pragma unroll
        for (int s = 0; s < 8; ++s) uf[s] = *(const LAS bf16x8*)(lds + uaddr0 + 512 * k8 + 64 * s);
#pragma unroll
        for (int x = 0; x < 30; ++x) {
            const bf16x8 tf = *(const LAS bf16x8*)(lds + toep0 + 512 * k8 + 32 * x);
#pragma unroll
            for (int s = 0; s < 8; ++s) { const int ti = 15 + 2 * s - x; if (ti >= 0 && ti < 16) acc[ti] = __builtin_amdgcn_mfma_f32_16x16x32_bf16(tf, uf[s], acc[ti], 0, 0, 0); }
        }
    }
}
__device__ __forceinline__ void phase_hyena(bf16* VT, const bf16* X1T, const bf16* KF, const float* skip, LAS unsigned char* lds, int vcu, int G, int wave, int lane, int tid) {
    const int n = lane & 15, quad = lane >> 4, rho = (-n) & 7;
    const int base = 2048 - 256 * wave - n + 8 * quad;
    const unsigned toep0 = CP_OFF + rho * CP_STRIDE + 16 * ((base >> 3) - 30);
    const unsigned uaddr0 = n * U_STRIDE + 16 * quad;
    v4u ur[8]; HyFilt f0;
    if (vcu < DM) { const v4u* src = (const v4u*)(VT + (size_t)vcu * NB * SEQ);
#pragma unroll
        for (int k = 0; k < 8; ++k) ur[k] = src[tid + 512 * k];
        f0 = hyena_fetch_filter(KF + (size_t)vcu * KF_LEN, tid); }
    for (int d = vcu; d < DM; d += G) {
        bf16* vrow = VT + (size_t)d * NB * SEQ;
#pragma unroll
        for (int k = 0; k < 8; ++k) { const int c = tid + 512 * k; *(LAS v4u*)(lds + (c >> 8) * U_STRIDE + 16 * (c & 255)) = ur[k]; }
        hyena_put_filter(lds, f0, tid);
        const HyFilt f1 = hyena_fetch_filter(KF + (size_t)(DM + d) * KF_LEN, tid);
        v2u xx[16];
#pragma unroll
        for (int ti = 0; ti < 16; ++ti) xx[ti] = *(const v2u*)(X1T + ((size_t)d * NB + n) * SEQ + 256 * wave + 16 * ti + 4 * quad);
        f32x4 acc[16];
        hyena_conv(lds, acc, toep0, uaddr0);
        const float sk0 = skip[d], sk1 = skip[DM + d];
        v2u z[16];
#pragma unroll
        for (int ti = 0; ti < 16; ++ti) { const int t = 256 * wave + 16 * ti + 4 * quad;
            const v2u vv = *(const LAS v2u*)(lds + n * U_STRIDE + 2 * t);
            const float z0 = bflo(xx[ti].x) * (acc[ti][0] + sk0 * bflo(vv.x)), z1 = bfhi(xx[ti].x) * (acc[ti][1] + sk0 * bfhi(vv.x));
            const float z2 = bflo(xx[ti].y) * (acc[ti][2] + sk0 * bflo(vv.y)), z3 = bfhi(xx[ti].y) * (acc[ti][3] + sk0 * bfhi(vv.y));
            z[ti].x = pk2(z0, z1); z[ti].y = pk2(z2, z3); }
        __syncthreads();
#pragma unroll
        for (int ti = 0; ti < 16; ++ti) { const int t = 256 * wave + 16 * ti + 4 * quad; *(LAS v2u*)(lds + n * U_STRIDE + 2 * t) = z[ti]; }
        hyena_put_filter(lds, f1, tid);
        if (d + G < DM) { const v4u* src = (const v4u*)(VT + (size_t)(d + G) * NB * SEQ);
#pragma unroll
            for (int k = 0; k < 8; ++k) ur[k] = src[tid + 512 * k];
            f0 = hyena_fetch_filter(KF + (size_t)(d + G) * KF_LEN, tid); }
        hyena_conv(lds, acc, toep0, uaddr0);
        __syncthreads();
#pragma unroll
        for (int ti = 0; ti < 16; ++ti) { const int t = 256 * wave + 16 * ti + 4 * quad;
            const float o0 = acc[ti][0] + sk1 * bflo(z[ti].x), o1 = acc[ti][1] + sk1 * bfhi(z[ti].x), o2 = acc[ti][2] + sk1 * bflo(z[ti].y), o3 = acc[ti][3] + sk1 * bfhi(z[ti].y);
            v2u w; w.x = pk2(o0, o1); w.y = pk2(o2, o3); *(LAS v2u*)(lds + n * U_STRIDE + 2 * t) = w; }
        __syncthreads();
        {   v4u* dst = (v4u*)vrow;
#pragma unroll
            for (int k = 0; k < 8; ++k) { const int c = tid + 512 * k; dst[c] = *(const LAS v4u*)(lds + (c >> 8) * U_STRIDE + 16 * (c & 255)); } }
        __syncthreads();
    }
}
constexpr int C5_STRIDE = 132;
__device__ __forceinline__ void phase_hyena_post(const bf16* big, const float* sw, const float* sb, const bf16* ZT, bf16* outp, LAS unsigned char* lds, int gw, int ngw, int wave, int lane) {
    LAS unsigned char* scr = lds + wave * 16384;
    for (int id = gw; id < 512 * 16; id += ngw) {
        const int dtile = id & 15, tt = id >> 4, b = tt >> 5, t0 = (tt & 31) * 64, d0 = dtile * 64;
        const int cg = 2 * DM + d0 + lane; const float w0 = sw[cg], w1 = sw[NQKV + cg], w2 = sw[2 * NQKV + cg], bias = sb[cg];
        const bf16* pp = big + (size_t)(b * SEQ + t0) * NQKV + cg;
        unsigned short pr[66];
#pragma unroll
        for (int k = 0; k < 66; ++k) { const int t = t0 - 1 + k; pr[k] = (t >= 0 && t < SEQ) ? pp[(long)(k - 1) * NQKV] : (unsigned short)0; }
        v4u zv[8];
#pragma unroll
        for (int ps = 0; ps < 8; ++ps) { const int dd = ps * 8 + (lane >> 3), part = lane & 7; zv[ps] = *(const v4u*)(ZT + ((size_t)(d0 + dd) * NB + b) * SEQ + t0 + part * 8); }
#pragma unroll
        for (int ps = 0; ps < 8; ++ps) { const int dd = ps * 8 + (lane >> 3), part = lane & 7;
            LAS unsigned* w = (LAS unsigned*)(scr + dd * C5_STRIDE + part * 16); w[0] = zv[ps].x; w[1] = zv[ps].y; w[2] = zv[ps].z; w[3] = zv[ps].w; }
        LDS_WAIT();
        const LAS unsigned short* zr = (const LAS unsigned short*)(scr + lane * C5_STRIDE);
        bf16* op = outp + (size_t)(b * SEQ + t0) * DM + d0 + lane;
#pragma unroll
        for (int k = 0; k < 64; ++k) { const float y = (w0 * bf2f(pr[k]) + w1 * bf2f(pr[k + 1]) + w2 * bf2f(pr[k + 2]) + bias) * bf2f(zr[k]); op[(size_t)k * DM] = f2bf(y); }
        LDS_WAIT();
    }
}

__global__ void __launch_bounds__(NTHREADS, 2) mk_fwd(Args a) {
    extern __shared__ __attribute__((aligned(16))) unsigned char lds_raw[];
    LAS unsigned char* lds = (LAS unsigned char*)lds_raw;
    cg::grid_group grid = cg::this_grid();
    const int tid = threadIdx.x, lane = tid & 63, wave = __builtin_amdgcn_readfirstlane(tid >> 6);
    const int G = gridDim.x, bx = blockIdx.x;
    const int vcu = (G % 8 == 0) ? (bx % 8) * (G / 8) + bx / 8 : bx;
    const int gw = vcu * NWAVES + wave, ngw = G * NWAVES;
    unsigned char* ws = a.ws;
    float* SS = (float*)(ws + WS_SS); bf16* XN = (bf16*)(ws + WS_XN); bf16* VT = (bf16*)(ws + WS_VT); bf16* MIXO = (bf16*)(ws + WS_MIXO); bf16* BIG = (bf16*)(ws + WS_BIG);
    const int lo = a.ph_lo, hi = a.ph_hi; int ph = 0;
    volatile LAS unsigned* MISC = (volatile LAS unsigned*)(lds + MISC_OFF);
    if (tid < 16) MISC[tid] = 0u;
    __syncthreads();
    XcdBarrier xbar = xcd_barrier_post((unsigned*)(ws + WS_BAR), MISC);
#define PH_BEGIN if (ph >= lo && ph < hi) {
#define PH_END   if (ph + 1 < hi) { if (ph == 0) grid.sync(); else xcd_barrier(xbar); } } ++ph;

    PH_BEGIN phase_prologue(a, lds, gw, ngw, wave, lane);
    PH_END
    PH_BEGIN phase_filters(a, lds, vcu, G, wave, lane, tid); phase_norm0(a.in[0], XN, SS, gw, ngw, lane); PH_END

    { constexpr int L = 0;

        constexpr int kind = L % 3;
        const bf16* wl = (const bf16*)(ws + WS_W + (size_t)L * W_LAYER);
        PH_BEGIN { pg8::Gemm g{XN, wl + W_IN / 2, MTOK, NQKV, DM}; pg8::StaticOrder S; S.init(MTOK, NQKV, G, bx); fill_row_scales(S, SS, (LAS float*)(lds + RST_OFF), tid);
                   if constexpr (kind == 0) { pg8::EpiShortIn E{BIG, BIG + (size_t)MTOK * DM, (const LAS float*)(lds + RST_OFF)}; pg8::gemm_phase<pg8::EpiShortIn, pg8::StaticOrder, true, true>(lds, g, S, E); }
                   else { pg8::EpiBf16PT<(kind == 1)> E{BIG, NQKV, (const LAS float*)(lds + RST_OFF), (float*)(ws + WS_KSS), MTOK};
                   pg8::gemm_phase<pg8::EpiBf16PT<(kind == 1)>, pg8::StaticOrder, true, true>(lds, g, S, E); }
 } PH_END
        if (kind == 0) {
            PH_BEGIN phase_shortconv(BIG, BIG + (size_t)MTOK * DM, a.in[4] + (size_t)(L / 3) * 3 * DM, MIXO, vcu * NTHREADS + tid, G * NTHREADS);
            PH_END
        } else if (kind == 1) {
            PH_BEGIN
            phase_natten3(BIG, a.in[7], a.in[8], a.in[9], (const float*)(ws + WS_KSS), MIXO, lds, vcu, G, wave, lane, tid); PH_END
        } else {
            PH_BEGIN phase_hyena_pre(BIG, a.in[12], a.in[13], VT, MIXO, lds, gw, ngw, wave, lane);
            PH_END
            PH_BEGIN
            phase_hyena(VT, MIXO, (const bf16*)(ws + WS_KF), a.in[20], lds, vcu, G, wave, lane, tid); PH_END
            PH_BEGIN phase_hyena_post(BIG, a.in[12], a.in[13], VT, MIXO, lds, gw, ngw, wave, lane);
            PH_END
        }
        PH_BEGIN { pg8::Gemm g{MIXO, wl + W_OUT / 2, MTOK, DM, DM}; pg8::StaticOrder S; S.init(MTOK, DM, G, bx); pg8::EpiResNorm E{a.out, XN, SS, DM};
                   pg8::gemm_phase<pg8::EpiResNorm, pg8::StaticOrder, true, true>(lds, g, S, E); } PH_END
        PH_BEGIN { pg8::Gemm g{XN, wl + W_13 / 2, MTOK, NW13, DM}; pg8::StaticOrder S; S.init(MTOK, NW13, G, bx); pg8::EpiSwiGLU E{BIG, FFH, (const LAS float*)(lds + RST_OFF)}; fill_row_scales(S, SS, (LAS float*)(lds + RST_OFF), tid);
                   pg8::gemm_phase<pg8::EpiSwiGLU, pg8::StaticOrder, true, true>(lds, g, S, E);
 } PH_END
        PH_BEGIN { pg8::Gemm g{BIG, wl + W_2 / 2, MTOK, DM, FFH}; pg8::StaticOrder S; S.init(MTOK, DM, G, bx); pg8::EpiResNormT<(L == NLAYER - 1)> E{a.out, XN, SS, DM};
                   pg8::gemm_phase<pg8::EpiResNormT<(L == NLAYER - 1)>, pg8::StaticOrder, true, true>(lds, g, S, E); } PH_END
        }
    { constexpr int L = 1;

        constexpr int kind = L % 3;
        const bf16* wl = (const bf16*)(ws + WS_W + (size_t)L * W_LAYER);
        PH_BEGIN { pg8::Gemm g{XN, wl + W_IN / 2, MTOK, NQKV, DM}; pg8::StaticOrder S; S.init(MTOK, NQKV, G, bx); fill_row_scales(S, SS, (LAS float*)(lds + RST_OFF), tid);
                   if constexpr (kind == 0) { pg8::EpiShortIn E{BIG, BIG + (size_t)MTOK * DM, (const LAS float*)(lds + RST_OFF)}; pg8::gemm_phase<pg8::EpiShortIn, pg8::StaticOrder, true, true>(lds, g, S, E); }
                   else { pg8::EpiBf16PT<(kind == 1)> E{BIG, NQKV, (const LAS float*)(lds + RST_OFF), (float*)(ws + WS_KSS), MTOK};
                   pg8::gemm_phase<pg8::EpiBf16PT<(kind == 1)>, pg8::StaticOrder, true, true>(lds, g, S, E); }
 } PH_END
        if (kind == 0) {
            PH_BEGIN phase_shortconv(BIG, BIG + (size_t)MTOK * DM, a.in[4] + (size_t)(L / 3) * 3 * DM, MIXO, vcu * NTHREADS + tid, G * NTHREADS);
            PH_END
        } else if (kind == 1) {
            PH_BEGIN
            phase_natten3(BIG, a.in[7], a.in[8], a.in[9], (const float*)(ws + WS_KSS), MIXO, lds, vcu, G, wave, lane, tid); PH_END
        } else {
            PH_BEGIN phase_hyena_pre(BIG, a.in[12], a.in[13], VT, MIXO, lds, gw, ngw, wave, lane);
            PH_END
            PH_BEGIN
            phase_hyena(VT, MIXO, (const bf16*)(ws + WS_KF), a.in[20], lds, vcu, G, wave, lane, tid); PH_END
            PH_BEGIN phase_hyena_post(BIG, a.in[12], a.in[13], VT, MIXO, lds, gw, ngw, wave, lane);
            PH_END
        }
        PH_BEGIN { pg8::Gemm g{MIXO, wl + W_OUT / 2, MTOK, DM, DM}; pg8::StaticOrder S; S.init(MTOK, DM, G, bx); pg8::EpiResNorm E{a.out, XN, SS, DM};
                   pg8::gemm_phase<pg8::EpiResNorm, pg8::StaticOrder, true, true>(lds, g, S, E); } PH_END
        PH_BEGIN { pg8::Gemm g{XN, wl + W_13 / 2, MTOK, NW13, DM}; pg8::StaticOrder S; S.init(MTOK, NW13, G, bx); pg8::EpiSwiGLU E{BIG, FFH, (const LAS float*)(lds + RST_OFF)}; fill_row_scales(S, SS, (LAS float*)(lds + RST_OFF), tid);
                   pg8::gemm_phase<pg8::EpiSwiGLU, pg8::StaticOrder, true, true>(lds, g, S, E);
 } PH_END
        PH_BEGIN { pg8::Gemm g{BIG, wl + W_2 / 2, MTOK, DM, FFH}; pg8::StaticOrder S; S.init(MTOK, DM, G, bx); pg8::EpiResNormT<(L == NLAYER - 1)> E{a.out, XN, SS, DM};
                   pg8::gemm_phase<pg8::EpiResNormT<(L == NLAYER - 1)>, pg8::StaticOrder, true, true>(lds, g, S, E); } PH_END
        }
    { constexpr int L = 2;

        constexpr int kind = L % 3;
        const bf16* wl = (const bf16*)(ws + WS_W + (size_t)L * W_LAYER);
        PH_BEGIN { pg8::Gemm g{XN, wl + W_IN / 2, MTOK, NQKV, DM}; pg8::StaticOrder S; S.init(MTOK, NQKV, G, bx); fill_row_scales(S, SS, (LAS float*)(lds + RST_OFF), tid);
                   if constexpr (kind == 0) { pg8::EpiShortIn E{BIG, BIG + (size_t)MTOK * DM, (const LAS float*)(lds + RST_OFF)}; pg8::gemm_phase<pg8::EpiShortIn, pg8::StaticOrder, true, true>(lds, g, S, E); }
                   else { pg8::EpiBf16PT<(kind == 1)> E{BIG, NQKV, (const LAS float*)(lds + RST_OFF), (float*)(ws + WS_KSS), MTOK};
                   pg8::gemm_phase<pg8::EpiBf16PT<(kind == 1)>, pg8::StaticOrder, true, true>(lds, g, S, E); }
 } PH_END
        if (kind == 0) {
            PH_BEGIN phase_shortconv(BIG, BIG + (size_t)MTOK * DM, a.in[4] + (size_t)(L / 3) * 3 * DM, MIXO, vcu * NTHREADS + tid, G * NTHREADS);
            PH_END
        } else if (kind == 1) {
            PH_BEGIN
            phase_natten3(BIG, a.in[7], a.in[8], a.in[9], (const float*)(ws + WS_KSS), MIXO, lds, vcu, G, wave, lane, tid); PH_END
        } else {
            PH_BEGIN phase_hyena_pre(BIG, a.in[12], a.in[13], VT, MIXO, lds, gw, ngw, wave, lane);
            PH_END
            PH_BEGIN
            phase_hyena(VT, MIXO, (const bf16*)(ws + WS_KF), a.in[20], lds, vcu, G, wave, lane, tid); PH_END
            PH_BEGIN phase_hyena_post(BIG, a.in[12], a.in[13], VT, MIXO, lds, gw, ngw, wave, lane);
            PH_END
        }
        PH_BEGIN { pg8::Gemm g{MIXO, wl + W_OUT / 2, MTOK, DM, DM}; pg8::StaticOrder S; S.init(MTOK, DM, G, bx); pg8::EpiResNorm E{a.out, XN, SS, DM};
                   pg8::gemm_phase<pg8::EpiResNorm, pg8::StaticOrder, true, true>(lds, g, S, E); } PH_END
        PH_BEGIN { pg8::Gemm g{XN, wl + W_13 / 2, MTOK, NW13, DM}; pg8::StaticOrder S; S.init(MTOK, NW13, G, bx); pg8::EpiSwiGLU E{BIG, FFH, (const LAS float*)(lds + RST_OFF)}; fill_row_scales(S, SS, (LAS float*)(lds + RST_OFF), tid);
                   pg8::gemm_phase<pg8::EpiSwiGLU, pg8::StaticOrder, true, true>(lds, g, S, E);
 } PH_END
        PH_BEGIN { pg8::Gemm g{BIG, wl + W_2 / 2, MTOK, DM, FFH}; pg8::StaticOrder S; S.init(MTOK, DM, G, bx); pg8::EpiResNormT<(L == NLAYER - 1)> E{a.out, XN, SS, DM};
                   pg8::gemm_phase<pg8::EpiResNormT<(L == NLAYER - 1)>, pg8::StaticOrder, true, true>(lds, g, S, E); } PH_END
        }
    { constexpr int L = 3;

        constexpr int kind = L % 3;
        const bf16* wl = (const bf16*)(ws + WS_W + (size_t)L * W_LAYER);
        PH_BEGIN { pg8::Gemm g{XN, wl + W_IN / 2, MTOK, NQKV, DM}; pg8::StaticOrder S; S.init(MTOK, NQKV, G, bx); fill_row_scales(S, SS, (LAS float*)(lds + RST_OFF), tid);
                   if constexpr (kind == 0) { pg8::EpiShortIn E{BIG, BIG + (size_t)MTOK * DM, (const LAS float*)(lds + RST_OFF)}; pg8::gemm_phase<pg8::EpiShortIn, pg8::StaticOrder, true, true>(lds, g, S, E); }
                   else { pg8::EpiBf16PT<(kind == 1)> E{BIG, NQKV, (const LAS float*)(lds + RST_OFF), (float*)(ws + WS_KSS), MTOK};
                   pg8::gemm_phase<pg8::EpiBf16PT<(kind == 1)>, pg8::StaticOrder, true, true>(lds, g, S, E); }
 } PH_END
        if (kind == 0) {
            PH_BEGIN phase_shortconv(BIG, BIG + (size_t)MTOK * DM, a.in[4] + (size_t)(L / 3) * 3 * DM, MIXO, vcu * NTHREADS + tid, G * NTHREADS);
            PH_END
        } else if (kind == 1) {
            PH_BEGIN
            phase_natten3(BIG, a.in[7], a.in[8], a.in[9], (const float*)(ws + WS_KSS), MIXO, lds, vcu, G, wave, lane, tid); PH_END
        } else {
            PH_BEGIN phase_hyena_pre(BIG, a.in[12], a.in[13], VT, MIXO, lds, gw, ngw, wave, lane);
            PH_END
            PH_BEGIN
            phase_hyena(VT, MIXO, (const bf16*)(ws + WS_KF), a.in[20], lds, vcu, G, wave, lane, tid); PH_END
            PH_BEGIN phase_hyena_post(BIG, a.in[12], a.in[13], VT, MIXO, lds, gw, ngw, wave, lane);
            PH_END
        }
        PH_BEGIN { pg8::Gemm g{MIXO, wl + W_OUT / 2, MTOK, DM, DM}; pg8::StaticOrder S; S.init(MTOK, DM, G, bx); pg8::EpiResNorm E{a.out, XN, SS, DM};
                   pg8::gemm_phase<pg8::EpiResNorm, pg8::StaticOrder, true, true>(lds, g, S, E); } PH_END
        PH_BEGIN { pg8::Gemm g{XN, wl + W_13 / 2, MTOK, NW13, DM}; pg8::StaticOrder S; S.init(MTOK, NW13, G, bx); pg8::EpiSwiGLU E{BIG, FFH, (const LAS float*)(lds + RST_OFF)}; fill_row_scales(S, SS, (LAS float*)(lds + RST_OFF), tid);
                   pg8::gemm_phase<pg8::EpiSwiGLU, pg8::StaticOrder, true, true>(lds, g, S, E);
 } PH_END
        PH_BEGIN { pg8::Gemm g{BIG, wl + W_2 / 2, MTOK, DM, FFH}; pg8::StaticOrder S; S.init(MTOK, DM, G, bx); pg8::EpiResNormT<(L == NLAYER - 1)> E{a.out, XN, SS, DM};
                   pg8::gemm_phase<pg8::EpiResNormT<(L == NLAYER - 1)>, pg8::StaticOrder, true, true>(lds, g, S, E); } PH_END
        }
#undef PH_BEGIN
#undef PH_END
}
#ifndef MK_NPH
#define MK_NPH (2 + 5 + 5 + 7 + 5)
#endif
constexpr int N_PHASES = MK_NPH;

extern "C" void kernel_launch(void* const* d_in, const int* in_sizes, int n_in, void* d_out, int out_size, void* d_ws, size_t ws_size, hipStream_t stream) {
    static int grid = 0;
    if (grid == 0) {
        if (n_in != 24 || out_size != MTOK * DM || ws_size < WS_END) { fprintf(stderr, "kernel_launch: unexpected shapes (n_in %d, out %d, ws %zu); nothing launched\n", n_in, out_size, ws_size); grid = -1; return; }
        int dev = 0, cus = 0, per_cu = 0;
        if (hipGetDevice(&dev) != hipSuccess || hipDeviceGetAttribute(&cus, hipDeviceAttributeMultiprocessorCount, dev) != hipSuccess) { grid = -1; return; }
        if (hipFuncSetAttribute((const void*)mk_fwd, hipFuncAttributeMaxDynamicSharedMemorySize, LDS_BYTES) != hipSuccess) { fprintf(stderr, "kernel_launch: hipFuncSetAttribute failed\n"); grid = -1; return; }
        if (hipOccupancyMaxActiveBlocksPerMultiprocessor(&per_cu, (const void*)mk_fwd, NTHREADS, LDS_BYTES) != hipSuccess || per_cu < 1) { fprintf(stderr, "kernel_launch: occupancy query gives %d\n", per_cu); per_cu = 1; }
        (void)hipGetLastError();
        grid = cus;
    }
    if (grid < 0) return;
    Args a{};
    for (int i = 0; i < 24; ++i) a.in[i] = (const float*)d_in[i];
    a.out = (float*)d_out; a.ws = (unsigned char*)d_ws;
    if (hipMemsetAsync(d_ws, 0, CTL_ZERO_BYTES, stream) != hipSuccess) { fprintf(stderr, "kernel_launch: memset of the control words failed\n"); return; }
#if MK_N_LAUNCHES == 1
    a.ph_lo = 0; a.ph_hi = N_PHASES;
    { void* args[] = {&a}; hipError_t e = hipLaunchCooperativeKernel((const void*)mk_fwd, dim3(grid), dim3(NTHREADS), args, LDS_BYTES, stream);
      if (e != hipSuccess) fprintf(stderr, "kernel_launch: cooperative launch failed: %s (grid %d)\n", hipGetErrorString(e), grid); }
#else
    for (int p = 0; p < N_PHASES; ++p) { a.ph_lo = p; a.ph_hi = p + 1; void* args[] = {&a};
        hipError_t e = hipLaunchCooperativeKernel((const void*)mk_fwd, dim3(grid), dim3(NTHREADS), args, LDS_BYTES, stream);
        if (e != hipSuccess) { fprintf(stderr, "kernel_launch: launch %d failed: %s\n", p, hipGetErrorString(e)); break; } }
#endif
}
```

```cpp
#include <hip/hip_runtime.h>
#include <hip/hip_cooperative_groups.h>
#include <cstdio>
#include <cstdint>
namespace cg = cooperative_groups;
namespace pg8 {
#define PG8_LAS __attribute__((address_space(3)))
typedef unsigned short bf16_t;
typedef short bf16x8 __attribute__((ext_vector_type(8)));
typedef float f32x4 __attribute__((ext_vector_type(4)));
typedef unsigned u32x4 __attribute__((ext_vector_type(4)));
constexpr int BM = 256, BK = 64, HALF = 128, HTB = HALF * BK * 2  , STAGE_BYTES = 8 * HTB, NXCD = 8, WGM = 8;

__host__ __device__ __forceinline__ int lds_byte(int r, int c) { const int st = (r >> 4) * 2 + (c >> 5), rr = r & 15, cc = c & 31, ob = rr * 64 + cc * 2; return st * 1024 + (ob ^ (((ob >> 9) & 1) << 5)); }
__host__ __device__ __forceinline__ void stage_rc(int b, int& R, int& C) { const int st = b / 1024, sb = b % 1024, swz = sb ^ (((sb >> 9) & 1) << 5); R = (st >> 1) * 16 + swz / 64; C = (st & 1) * 32 + (swz % 64) / 2; }
__host__ __device__ __forceinline__ int perm32(int rho) { const int n = rho >> 4, i = rho & 15; return 8 * (i >> 2) + 4 * n + (i & 3); }

struct Unit { int pm, pn, idx; };
struct Gemm { const bf16_t* A; const bf16_t* Bt; int M, N, K; };

struct StaticOrder {
    int nM, nN, nwg, G, c;
    __host__ __device__ void init(int M, int N, int G_, int c_) { nM = M / BM; nN = N / BM; nwg = nM * nN; G = G_; c = c_; }
    __host__ __device__ bool next(int i, Unit& u) const {
        const long L = (long)i * G + c; if (L >= nwg) return false;
        int wgid = (int)L; { const int q = nwg / NXCD, r = nwg % NXCD, xcd = wgid % NXCD, off = wgid / NXCD; wgid = (xcd < r ? xcd * (q + 1) : r * (q + 1) + (xcd - r) * q) + off; }
        const int nig = WGM * nN, gid = wgid / nig, fm = gid * WGM, gsz = (nM - fm) < WGM ? (nM - fm) : WGM;
        u.pm = fm + ((wgid % nig) % gsz); u.pn = (wgid % nig) / gsz; u.idx = i; return true;
    }
    __device__ __forceinline__ void a_ready(const Unit&) const {}
    __device__ __forceinline__ void done(const Unit&) const {}
};
__device__ __forceinline__ unsigned cvt_pk_bf16(float lo, float hi) { unsigned r; asm volatile("v_cvt_pk_bf16_f32 %0, %1, %2" : "=v"(r) : "v"(lo), "v"(hi)); return r; }
__device__ __forceinline__ float row_rscale(const float* ss, int row) { const f32x4* p = (const f32x4*)(ss + (size_t)row * 16); const f32x4 a = (p[0] + p[1]) + (p[2] + p[3]);
    return __builtin_amdgcn_rsqf(((a[0] + a[1]) + (a[2] + a[3])) * (1.0f / 1024.0f) + 1e-6f); }
template <bool KSS = false> struct EpiBf16PT {
    static constexpr bool PERM = true, AFTER_DRAIN = false;
    bf16_t* O; int ldc; const PG8_LAS float* rst; float* kss; int mrows;
    __device__ __forceinline__ void operator()(const f32x4 (&acc)[2][2][4][2], const Unit& u, int wr, int wc, int fr, int fq) const {
        const int row0 = u.pm * BM + wr * 64 + fr, col0 = u.pn * BM + wc * 32 + 8 * fq;
        const bool kt = KSS && u.pn >= 4 && u.pn < 8;
#pragma unroll
        for (int ai = 0; ai < 2; ++ai)
#pragma unroll
            for (int m = 0; m < 4; ++m) { const int row = row0 + ai * HALF + m * 16; bf16_t* rowp = O + (size_t)row * ldc + col0; const float rs = rst[u.idx * 256 + wr * 64 + fr + ai * HALF + m * 16];
#pragma unroll
                for (int bj = 0; bj < 2; ++bj) { const f32x4 v0 = acc[ai][bj][m][0] * rs, v1 = acc[ai][bj][m][1] * rs;
                    u32x4 w; w.x = cvt_pk_bf16(v0[0], v0[1]); w.y = cvt_pk_bf16(v0[2], v0[3]); w.z = cvt_pk_bf16(v1[0], v1[1]); w.w = cvt_pk_bf16(v1[2], v1[3]);
                    *(u32x4*)(rowp + bj * HALF) = w;
                    if (kt) { float q = ((v0[0] * v0[0] + v0[1] * v0[1]) + (v0[2] * v0[2] + v0[3] * v0[3])) + ((v1[0] * v1[0] + v1[1] * v1[1]) + (v1[2] * v1[2] + v1[3] * v1[3]));
                        q += __shfl_xor(q, 16); q += __shfl_xor(q, 32);
                        if (fq == 0) kss[(size_t)((u.pn - 4) * 8 + bj * 4 + wc) * mrows + row] = q; } }
                if (KSS) asm volatile("" ::: "memory"); }
    }
};
typedef EpiBf16PT<false> EpiBf16P;
__device__ __forceinline__ float silu_mul(float g, float u) { return g * __builtin_amdgcn_rcpf(1.0f + __expf(-g)) * u; }
struct EpiSwiGLU {
    static constexpr bool PERM = true, AFTER_DRAIN = false;
    bf16_t* H; int ldh; const PG8_LAS float* rst;
    __device__ __forceinline__ void operator()(const f32x4 (&acc)[2][2][4][2], const Unit& u, int wr, int wc, int fr, int fq) const {
        const int row0 = u.pm * BM + wr * 64 + fr, col0 = u.pn * HALF + wc * 32 + 8 * fq;
#pragma unroll
        for (int ai = 0; ai < 2; ++ai)
#pragma unroll
            for (int m = 0; m < 4; ++m) { bf16_t* rowp = H + (size_t)(row0 + ai * HALF + m * 16) * ldh + col0; const float rs = rst[u.idx * 256 + wr * 64 + fr + ai * HALF + m * 16];
                const f32x4 g0 = acc[ai][0][m][0] * rs, g1 = acc[ai][0][m][1] * rs, u0 = acc[ai][1][m][0] * rs, u1 = acc[ai][1][m][1] * rs;
                u32x4 w; w.x = cvt_pk_bf16(silu_mul(g0[0], u0[0]), silu_mul(g0[1], u0[1])); w.y = cvt_pk_bf16(silu_mul(g0[2], u0[2]), silu_mul(g0[3], u0[3]));
                w.z = cvt_pk_bf16(silu_mul(g1[0], u1[0]), silu_mul(g1[1], u1[1])); w.w = cvt_pk_bf16(silu_mul(g1[2], u1[2]), silu_mul(g1[3], u1[3]));
                *(u32x4*)rowp = w; }
    }
};
typedef unsigned u32x2 __attribute__((ext_vector_type(2)));
struct EpiShortIn {
    static constexpr bool PERM = true, AFTER_DRAIN = false;
    bf16_t* CU; bf16_t* BG; const PG8_LAS float* rst;
    __device__ __forceinline__ void operator()(const f32x4 (&acc)[2][2][4][2], const Unit& u, int wr, int wc, int fr, int fq) const {
        const int row0 = u.pm * BM + wr * 64 + fr;
#pragma unroll
        for (int ai = 0; ai < 2; ++ai)
#pragma unroll
            for (int m = 0; m < 4; ++m) { const int row = row0 + ai * HALF + m * 16; const float rs = rst[u.idx * 256 + wr * 64 + fr + ai * HALF + m * 16];
                if (u.pn < 8) { const float r2 = rs * rs; const f32x4 c0 = acc[ai][0][m][0], c1 = acc[ai][0][m][1], u0 = acc[ai][1][m][0], u1 = acc[ai][1][m][1];
                    u32x4 w; w.x = cvt_pk_bf16(c0[0] * u0[0] * r2, c0[1] * u0[1] * r2); w.y = cvt_pk_bf16(c0[2] * u0[2] * r2, c0[3] * u0[3] * r2);
                    w.z = cvt_pk_bf16(c1[0] * u1[0] * r2, c1[1] * u1[1] * r2); w.w = cvt_pk_bf16(c1[2] * u1[2] * r2, c1[3] * u1[3] * r2);
                    *(u32x4*)(CU + (size_t)row * 1024 + u.pn * HALF + wc * 32 + 8 * fq) = w; }
                else { bf16_t* rowp = BG + (size_t)row * 1024 + (u.pn - 8) * BM + wc * 32 + 8 * fq;
#pragma unroll
                    for (int bj = 0; bj < 2; ++bj) { const f32x4 v0 = acc[ai][bj][m][0] * rs, v1 = acc[ai][bj][m][1] * rs;
                        u32x4 w; w.x = cvt_pk_bf16(v0[0], v0[1]); w.y = cvt_pk_bf16(v0[2], v0[3]); w.z = cvt_pk_bf16(v1[0], v1[1]); w.w = cvt_pk_bf16(v1[2], v1[3]);
                        *(u32x4*)(rowp + bj * HALF) = w; } } }
    }
};
template <bool LAST = false> struct EpiResNormT {
    static constexpr bool PERM = true, AFTER_DRAIN = false;
    float* out; bf16_t* xb; float* ss; int ldc;
    __device__ __forceinline__ void operator()(const f32x4 (&acc)[2][2][4][2], const Unit& u, int wr, int wc, int fr, int fq) const {
        const int row0 = u.pm * BM + wr * 64 + fr, col0 = u.pn * BM + wc * 32 + 8 * fq;
#pragma unroll
        for (int ai = 0; ai < 2; ++ai)
#pragma unroll
            for (int m = 0; m < 4; ++m) { const int row = row0 + ai * HALF + m * 16; const size_t off = (size_t)row * ldc + col0; float s = 0.f;
#pragma unroll
                for (int bj = 0; bj < 2; ++bj) { const size_t o = off + bj * HALF; const u32x4 b = *(const u32x4*)(xb + o);
                    f32x4 r0, r1;
                    r0[0] = __uint_as_float(b.x << 16) + acc[ai][bj][m][0][0]; r0[1] = __uint_as_float(b.x & 0xffff0000u) + acc[ai][bj][m][0][1];
                    r0[2] = __uint_as_float(b.y << 16) + acc[ai][bj][m][0][2]; r0[3] = __uint_as_float(b.y & 0xffff0000u) + acc[ai][bj][m][0][3];
                    r1[0] = __uint_as_float(b.z << 16) + acc[ai][bj][m][1][0]; r1[1] = __uint_as_float(b.z & 0xffff0000u) + acc[ai][bj][m][1][1];
                    r1[2] = __uint_as_float(b.w << 16) + acc[ai][bj][m][1][2]; r1[3] = __uint_as_float(b.w & 0xffff0000u) + acc[ai][bj][m][1][3];
                    if (LAST) { *(f32x4*)(out + o) = r0; *(f32x4*)(out + o + 4) = r1; }
                    else { s += ((r0[0] * r0[0] + r0[1] * r0[1]) + (r0[2] * r0[2] + r0[3] * r0[3])) + ((r1[0] * r1[0] + r1[1] * r1[1]) + (r1[2] * r1[2] + r1[3] * r1[3]));
                        u32x4 w; w.x = cvt_pk_bf16(r0[0], r0[1]); w.y = cvt_pk_bf16(r0[2], r0[3]); w.z = cvt_pk_bf16(r1[0], r1[1]); w.w = cvt_pk_bf16(r1[2], r1[3]); *(u32x4*)(xb + o) = w; } }
                if (!LAST) { s += __shfl_xor(s, 16); s += __shfl_xor(s, 32); if (fq == 0) ss[(size_t)row * 16 + u.pn * 4 + wc] = s; }
                asm volatile("" ::: "memory"); }
    }
};
typedef EpiResNormT<false> EpiResNorm;
template <class Epi, class Sched, bool ALIGN_EPI = false, bool SP2 = false>
__device__ __forceinline__ void gemm_phase(PG8_LAS unsigned char* lds, const Gemm g, const Sched& S, const Epi& E) {
    const int tid = threadIdx.x, wid = __builtin_amdgcn_readfirstlane(tid >> 6), lane = tid & 63, wr = wid >> 2, wc = wid & 3, fr = lane & 15, fq = lane >> 4;
    const int K = g.K, nt = K / BK;
    unsigned voffA[2], voffB[2];
#pragma unroll
    for (int i = 0; i < 2; ++i) { int R, C; stage_rc(tid * 16 + i * 8192, R, C); const int Rb = Epi::PERM ? ((R & ~31) + perm32(R & 31)) : R;
        voffA[i] = (unsigned)(R * K + C) * 2u; voffB[i] = (unsigned)(Rb * K + C) * 2u; }
    const size_t kstep = (size_t)(BK * 2);
    const size_t hstep = (size_t)HALF * K * 2;
    const size_t tstep = 2 * hstep;
    const unsigned ldsw = (unsigned)wid * 1024u;
    const int aoff = lds_byte(wr * 64 + fr, fq * 8), boff = lds_byte(wc * 32 + fr, fq * 8);
#define PG8_SA(b, h) (((b) * 2 + (h)) * HTB)
#define PG8_SB(b, h) ((4 + (b) * 2 + (h)) * HTB)
#define PG8_STAGE(bufoff, gbase, voff) do { _Pragma("unroll") for (int _i = 0; _i < 2; ++_i) \
        __builtin_amdgcn_global_load_lds((const unsigned*)((const char*)(gbase) + (voff)[_i]), (PG8_LAS unsigned*)(lds + (bufoff) + ldsw + _i * 8192), 16, 0, 0); } while (0)
#define PG8_LDA(dst, b, h) do { _Pragma("unroll") for (int m = 0; m < 4; ++m) _Pragma("unroll") for (int k = 0; k < 2; ++k) dst[m][k] = *(const PG8_LAS bf16x8*)(lds + PG8_SA(b, h) + aoff + m * 2048 + k * 1024); } while (0)
#define PG8_LDB(dst, b, h) do { _Pragma("unroll") for (int n = 0; n < 2; ++n) _Pragma("unroll") for (int k = 0; k < 2; ++k) dst[n][k] = *(const PG8_LAS bf16x8*)(lds + PG8_SB(b, h) + boff + n * 2048 + k * 1024); } while (0)
#define PG8_MMA(ai, bj, At, Bt) do { __builtin_amdgcn_s_setprio(1); _Pragma("unroll") for (int m = 0; m < 4; ++m) _Pragma("unroll") for (int n = 0; n < 2; ++n) _Pragma("unroll") for (int k = 0; k < 2; ++k) \
        acc[ai][bj][m][n] = __builtin_amdgcn_mfma_f32_16x16x32_bf16(Bt[n][k], At[m][k], acc[ai][bj][m][n], 0, 0, 0); __builtin_amdgcn_s_setprio(0); } while (0)
#define PG8_WAIT_V(n) asm volatile("s_waitcnt vmcnt(" #n ")" ::: "memory")
#define PG8_WAIT_L(n) asm volatile("s_waitcnt lgkmcnt(" #n ")" ::: "memory")
#define PG8_BAR __builtin_amdgcn_s_barrier()
#define PG8_SCHED __builtin_amdgcn_sched_barrier(0)
    Unit cur, nxt; int ui = 0;
    if (!S.next(0, cur)) return;
    f32x4 acc[2][2][4][2];
#pragma unroll
    for (int a = 0; a < 2; ++a)
#pragma unroll
        for (int b = 0; b < 2; ++b)
#pragma unroll
            for (int m = 0; m < 4; ++m)
#pragma unroll
                for (int n = 0; n < 2; ++n) acc[a][b][m][n] = (f32x4){0.f, 0.f, 0.f, 0.f};
    bf16x8 At[4][2], B0[2][2], B1[2][2];
    const char* cA = (const char*)g.A + (size_t)cur.pm * tstep; const char* cB = (const char*)g.Bt + (size_t)cur.pn * tstep;
    S.a_ready(cur);
    if constexpr (SP2) {
        PG8_STAGE(PG8_SB(0, 0), cB, voffB); PG8_STAGE(PG8_SB(0, 1), cB + hstep, voffB); PG8_STAGE(PG8_SA(0, 0), cA, voffA); PG8_STAGE(PG8_SA(0, 1), cA + hstep, voffA);
        if (wr == 1) PG8_BAR;
        PG8_WAIT_V(2); PG8_BAR;
        PG8_STAGE(PG8_SB(1, 0), cB + kstep, voffB); PG8_STAGE(PG8_SA(1, 0), cA + kstep, voffA); PG8_STAGE(PG8_SB(1, 1), cB + hstep + kstep, voffB);
        PG8_WAIT_V(6); PG8_BAR;
    } else {
        PG8_STAGE(PG8_SB(0, 0), cB, voffB); PG8_STAGE(PG8_SA(0, 0), cA, voffA); PG8_STAGE(PG8_SB(0, 1), cB + hstep, voffB); PG8_STAGE(PG8_SA(0, 1), cA + hstep, voffA);
        if (wr == 1) PG8_BAR;
        PG8_WAIT_V(4); PG8_BAR;
        PG8_STAGE(PG8_SB(1, 0), cB + kstep, voffB); PG8_STAGE(PG8_SA(1, 0), cA + kstep, voffA); PG8_STAGE(PG8_SB(1, 1), cB + hstep + kstep, voffB);
        PG8_WAIT_V(6); PG8_BAR;
    }
    for (;;) {
        const bool has_next = S.next(ui + 1, nxt);
        const char* nA = has_next ? (const char*)g.A + (size_t)nxt.pm * tstep : cA; const char* nB = has_next ? (const char*)g.Bt + (size_t)nxt.pn * tstep : cB;
        for (int t = 0; t < nt; t += 2) {
            const bool last = (t == nt - 2);
            const char* a1 = cA + (size_t)(t + 1) * kstep;
            const char* a2 = last ? nA : cA + (size_t)(t + 2) * kstep; const char* b2 = last ? nB : cB + (size_t)(t + 2) * kstep;
            const char* a3 = a2 + kstep; const char* b3 = b2 + kstep;
            if (last && has_next) S.a_ready(nxt);
            if constexpr (SP2) {
            PG8_LDB(B0, 0, 0); PG8_LDB(B1, 0, 1); PG8_SCHED; PG8_LDA(At, 0, 0); PG8_STAGE(PG8_SA(1, 1), a1 + hstep, voffA);
            PG8_WAIT_V(8); PG8_WAIT_L(0); PG8_BAR; PG8_MMA(0, 0, At, B0); PG8_MMA(0, 1, At, B1); PG8_BAR; PG8_SCHED;
            PG8_LDA(At, 0, 1); PG8_STAGE(PG8_SB(0, 0), b2, voffB); PG8_STAGE(PG8_SB(0, 1), b2 + hstep, voffB); PG8_STAGE(PG8_SA(0, 0), a2, voffA);
            PG8_WAIT_V(8); PG8_WAIT_L(0); PG8_BAR; PG8_MMA(1, 0, At, B0); PG8_MMA(1, 1, At, B1); PG8_BAR; PG8_SCHED;
            PG8_LDB(B0, 1, 0); PG8_LDB(B1, 1, 1); PG8_SCHED; PG8_LDA(At, 1, 0); PG8_STAGE(PG8_SA(0, 1), a2 + hstep, voffA);
            PG8_WAIT_V(8); PG8_WAIT_L(0); PG8_BAR; PG8_MMA(0, 0, At, B0); PG8_MMA(0, 1, At, B1); PG8_BAR; PG8_SCHED;
            PG8_LDA(At, 1, 1); PG8_STAGE(PG8_SB(1, 0), b3, voffB); PG8_STAGE(PG8_SB(1, 1), b3 + hstep, voffB); PG8_STAGE(PG8_SA(1, 0), a3, voffA);
            PG8_WAIT_V(8); PG8_WAIT_L(0); PG8_BAR; PG8_MMA(1, 0, At, B0); PG8_MMA(1, 1, At, B1); PG8_BAR; PG8_SCHED;
            } else {
            PG8_LDB(B0, 0, 0); PG8_SCHED; PG8_LDA(At, 0, 0); PG8_STAGE(PG8_SA(1, 1), a1 + hstep, voffA);
            PG8_WAIT_L(8); PG8_BAR; PG8_WAIT_L(0); PG8_MMA(0, 0, At, B0); PG8_BAR; PG8_SCHED;
            PG8_LDB(B1, 0, 1); PG8_STAGE(PG8_SB(0, 0), b2, voffB);
            PG8_BAR; PG8_WAIT_L(0); PG8_MMA(0, 1, At, B1); PG8_BAR;
            PG8_LDA(At, 0, 1); PG8_STAGE(PG8_SA(0, 0), a2, voffA);
            PG8_BAR; PG8_WAIT_L(0); PG8_MMA(1, 0, At, B0); PG8_BAR; PG8_SCHED;
            PG8_STAGE(PG8_SB(0, 1), b2 + hstep, voffB);
            PG8_WAIT_V(6); PG8_BAR; PG8_MMA(1, 1, At, B1); PG8_BAR;
            PG8_LDB(B0, 1, 0); PG8_SCHED; PG8_LDA(At, 1, 0); PG8_STAGE(PG8_SA(0, 1), a2 + hstep, voffA);
            PG8_WAIT_L(8); PG8_BAR; PG8_WAIT_L(0); PG8_MMA(0, 0, At, B0); PG8_BAR; PG8_SCHED;
            PG8_LDB(B1, 1, 1); PG8_STAGE(PG8_SB(1, 0), b3, voffB);
            PG8_BAR; PG8_WAIT_L(0); PG8_MMA(0, 1, At, B1); PG8_BAR;
            PG8_LDA(At, 1, 1); PG8_STAGE(PG8_SA(1, 0), a3, voffA);
            PG8_BAR; PG8_WAIT_L(0); PG8_MMA(1, 0, At, B0); PG8_BAR; PG8_SCHED;
            PG8_STAGE(PG8_SB(1, 1), b3 + hstep, voffB);
            PG8_WAIT_V(6); PG8_BAR; PG8_MMA(1, 1, At, B1); PG8_BAR;
            }
        }
        if constexpr (ALIGN_EPI) { if (wr == 0) PG8_BAR; }
        if constexpr (!Epi::AFTER_DRAIN) { E(acc, cur, wr, wc, fr, fq); S.done(cur); }
        if (!has_next) break;
#pragma unroll
        for (int a = 0; a < 2; ++a)
#pragma unroll
            for (int b = 0; b < 2; ++b)
#pragma unroll
                for (int m = 0; m < 4; ++m)
#pragma unroll
                    for (int n = 0; n < 2; ++n) acc[a][b][m][n] = (f32x4){0.f, 0.f, 0.f, 0.f};
        cur = nxt; cA = nA; cB = nB; ++ui;
        if constexpr (ALIGN_EPI) { if (wr == 1) PG8_BAR; }
    }
    PG8_WAIT_V(0);
    if constexpr (!ALIGN_EPI) { if (wr == 0) PG8_BAR; }
    PG8_BAR;
    if constexpr (Epi::AFTER_DRAIN) { E.fused(acc, cur, wr, wc, fr, fq, lds, wid, lane); S.done(cur); }
#undef PG8_SA
#undef PG8_SB
#undef PG8_STAGE
#undef PG8_LDA
#undef PG8_LDB
#undef PG8_MMA
#undef PG8_WAIT_V
#undef PG8_WAIT_L
#undef PG8_BAR
#undef PG8_SCHED
}
}

#ifndef MK_N_LAUNCHES
#define MK_N_LAUNCHES 1
#endif
constexpr int NB = 16, SEQ = 2048, DM = 1024, MTOK = NB * SEQ, NQKV = 3072, FFH = 2816, NW13 = 2 * FFH, NLAYER = 4;
constexpr float RMS_EPS = 1e-6f;
constexpr int NWAVES = 8, NTHREADS = 512;
constexpr size_t MiB = 1u << 20;
constexpr size_t WS_W = 1 * MiB, W_LAYER = 49 * MiB / 2;
constexpr size_t W_IN = 0, W_OUT = 6 * MiB, W_13 = 8 * MiB, W_2 = 19 * MiB;
constexpr size_t WS_SS = 439 * MiB;
constexpr size_t WS_HID = 100 * MiB;
constexpr size_t WS_KF = 102 * MiB;
constexpr int KF_LEN = 4112;
constexpr size_t WS_XN = 119 * MiB;
constexpr size_t WS_MIXO = 183 * MiB;
constexpr size_t WS_BIG = 247 * MiB;
constexpr size_t WS_VT = 441 * MiB;
constexpr size_t WS_KSS = 505 * MiB;
constexpr size_t WS_END = 509 * MiB;
constexpr int MISC_OFF = 163776, RST_OFF = 131072;
constexpr size_t WS_BAR = 16384, CTL_ZERO_BYTES = 65536;
constexpr int LDS_BYTES = 163840;
#define LAS __attribute__((address_space(3)))
typedef unsigned short bf16;
typedef unsigned v4u __attribute__((ext_vector_type(4)));
typedef unsigned v2u __attribute__((ext_vector_type(2)));
typedef float f32x4 __attribute__((ext_vector_type(4)));
typedef short bf16x8 __attribute__((ext_vector_type(8)));
typedef short v4i16_t __attribute__((ext_vector_type(4)));
#define LDS_WAIT() asm volatile("s_waitcnt lgkmcnt(0)" ::: "memory")
typedef float f32x2_cv __attribute__((ext_vector_type(2))); typedef __bf16 bf16x2_cv __attribute__((ext_vector_type(2)));
__device__ __forceinline__ unsigned pk2c(float lo, float hi) { const f32x2_cv v = {lo, hi}; const bf16x2_cv b = __builtin_convertvector(v, bf16x2_cv); return __builtin_bit_cast(unsigned, b); }
__device__ __forceinline__ unsigned pk2(float lo, float hi) { return pg8::cvt_pk_bf16(lo, hi); }
__device__ __forceinline__ float bflo(unsigned w) { return __uint_as_float(w << 16); }
__device__ __forceinline__ float bfhi(unsigned w) { return __uint_as_float(w & 0xffff0000u); }
__device__ __forceinline__ float bf2f(unsigned short b) { return __uint_as_float(((unsigned)b) << 16); }
__device__ __forceinline__ unsigned short f2bf(float f) { return (unsigned short)(pk2(f, 0.f) & 0xffffu); }
__device__ __forceinline__ float wave_sum(float v) {
#pragma unroll
    for (int o = 1; o < 64; o <<= 1) v += __shfl_xor(v, o);
    return v;
}

#define RLX_AGENT __ATOMIC_RELAXED, __HIP_MEMORY_SCOPE_AGENT
#define XB_TMO      128
#define XB_XCNT(j)  (256  + 64 * (j))
#define XB_XSUB(j)  (1280 + 64 * (j))
#define XB_XGEN(j)  (2304 + 64 * (j))
#define XB_TOP      3328
#define XB_TOPGEN   3392
#define XCD_BAR_WORDS 3456
#define XB_SPIN_CAP (1u << 18)

__device__ __forceinline__ unsigned xb_ld(unsigned* p)              { return __hip_atomic_load(p, __ATOMIC_RELAXED, __HIP_MEMORY_SCOPE_AGENT); }
__device__ __forceinline__ unsigned xb_add(unsigned* p, unsigned v) { return __hip_atomic_fetch_add(p, v, __ATOMIC_RELAXED, __HIP_MEMORY_SCOPE_AGENT); }
__device__ __forceinline__ unsigned xb_xcc_id() { return (unsigned)__builtin_amdgcn_s_getreg((3 << 11) | 20) & 0xFu; }
#define XB_SPIN(cond, bar) do { unsigned _sp = 0; while (cond) { __builtin_amdgcn_s_sleep(1); \
    if ((++_sp & 255u) == 0u) { if (xb_ld(&(bar)[XB_TMO])) break; if (_sp > XB_SPIN_CAP) { atomicAdd(&(bar)[XB_TMO], 1u); break; } } } } while (0)

struct XcdBarrier {
    unsigned* bar; unsigned x;
    volatile LAS unsigned* st;
};

__device__ __forceinline__ XcdBarrier xcd_barrier_post(unsigned* bar, volatile LAS unsigned* st) {
    XcdBarrier b; b.bar = bar; b.x = xb_xcc_id(); b.st = st;
    if (threadIdx.x == 0) (void)xb_add(&bar[XB_XCNT(b.x)], 1u);
    return b;
}
__device__ __forceinline__ void xcd_barrier_complete(unsigned* bar, unsigned x, unsigned& nloc, unsigned& nx) {
    const unsigned G = gridDim.x * gridDim.y * gridDim.z;
    unsigned sum, cnt, mine, sp = 0u;
    for (;;) {
        sum = 0u; cnt = 0u; mine = 0u;
#pragma unroll
        for (unsigned j = 0; j < 16; ++j) { const unsigned c = xb_ld(&bar[XB_XCNT(j)]); sum += c; cnt += (c > 0u) ? 1u : 0u; mine = (j == x) ? c : mine; }
        if (sum == G) break;
        __builtin_amdgcn_s_sleep(1);
        if ((++sp & 255u) == 0u) { if (xb_ld(&bar[XB_TMO])) break; if (sp > XB_SPIN_CAP) { atomicAdd(&bar[XB_TMO], 1u); break; } }
    }
    nloc = mine > 0u ? mine : 1u; nx = cnt > 0u ? cnt : 1u;
}

__device__ __forceinline__ void xcd_barrier(const XcdBarrier& b) {
    asm volatile("s_waitcnt vmcnt(0)" ::: "memory");
    __syncthreads();
    if (threadIdx.x == 0) {
        unsigned* bar = b.bar;
        __builtin_amdgcn_s_waitcnt(0);
        unsigned nloc = b.st[0], nx = b.st[1];
        if (nloc == 0u) { xcd_barrier_complete(bar, b.x, nloc, nx); b.st[0] = nloc; b.st[1] = nx; }
        const unsigned old = xb_add(&bar[XB_XSUB(b.x)], 1u);
        const unsigned gen = old / nloc;
        if (old + 1u == (gen + 1u) * nloc) {
            __builtin_amdgcn_fence(__ATOMIC_RELEASE, "agent");
            asm volatile("s_waitcnt vmcnt(0)" ::: "memory");
            const unsigned og = xb_add(&bar[XB_TOP], 1u);
            const unsigned tg = og / nx;
            if (og + 1u == (tg + 1u) * nx) xb_add(&bar[XB_TOPGEN], 1u);
            else XB_SPIN(xb_ld(&bar[XB_TOPGEN]) == tg, bar);
            __builtin_amdgcn_fence(__ATOMIC_ACQUIRE, "agent");
            xb_add(&bar[XB_XGEN(b.x)], 1u);
            asm volatile("s_waitcnt vmcnt(0)" ::: "memory");
        } else {
            XB_SPIN(xb_ld(&bar[XB_XGEN(b.x)]) == gen, bar);
            __builtin_amdgcn_fence(__ATOMIC_ACQUIRE, "agent");
            asm volatile("s_waitcnt vmcnt(0)" ::: "memory");
        }
    }
    __syncthreads();
}

__device__ __forceinline__ void transpose_item(const float* __restrict__ W, int K, int N, const float* __restrict__ gain, bf16* WT, int dst_row0, LAS float* scr, int k0, int n0, int lane) {
    float tv[32];
#pragma unroll
    for (int i = 0; i < 32; ++i) { const int kk = 2 * i + (lane >> 5); tv[i] = W[(size_t)(k0 + kk) * N + n0 + (lane & 31)]; }
#pragma unroll
    for (int i = 0; i < 32; ++i) { const int kk = 2 * i + (lane >> 5); float v = tv[i]; if (gain) v *= gain[k0 + kk]; scr[kk * 33 + (lane & 31)] = v; }
    LDS_WAIT();
    const int c = lane & 7;
#pragma unroll
    for (int j = 0; j < 4; ++j) { const int n = (lane >> 3) + 8 * j; const LAS float* s = scr + (8 * c) * 33 + n;
        v4u o; o.x = pk2(s[0 * 33], s[1 * 33]); o.y = pk2(s[2 * 33], s[3 * 33]); o.z = pk2(s[4 * 33], s[5 * 33]); o.w = pk2(s[6 * 33], s[7 * 33]);
        *(v4u*)(WT + (size_t)(dst_row0 + n) * K + k0 + 8 * c) = o; }
    LDS_WAIT();
}

struct Args { const float* in[24]; float* out; unsigned char* ws; int ph_lo, ph_hi; };

__device__ __forceinline__ void phase_prologue(const Args& a, LAS unsigned char* lds, int gw, int ngw, int wave, int lane) {
    LAS float* scr = (LAS float*)(lds + wave * 16384);
    constexpr int I_IN = 16 * 96, I_OUT = 16 * 32, I_13 = 16 * 176, I_2 = 44 * 32, I_L = I_IN + I_OUT + I_13 + I_2;
    for (int it = gw; it < NLAYER * I_L; it += ngw) {
        const int L = it / I_L; int r = it - L * I_L;
        const float* win = (L == 1) ? a.in[6] : (L == 2) ? a.in[11] : (L == 0 ? a.in[3] : a.in[3] + (size_t)DM * NQKV);
        const float* wout = (L == 1) ? a.in[10] : (L == 2) ? a.in[21] : (L == 0 ? a.in[5] : a.in[5] + (size_t)DM * DM);
        bf16* wl = (bf16*)(a.ws + WS_W + (size_t)L * W_LAYER);
        if (r < I_IN) { const int kb = r / 96, nb = r % 96, n0 = 32 * nb; int dst = n0;
            if (L % 3 == 0) { const int j = n0 & 1023; dst = (n0 < DM) ? 2 * DM + n0 : 256 * (j / 128) + (n0 < 2 * DM ? 0 : 128) + (j % 128); }
            transpose_item(win, DM, NQKV, a.in[1] + L * DM, wl + W_IN / 2, dst, scr, 64 * kb, n0, lane); continue; }
        r -= I_IN;
        if (r < I_OUT) { const int kb = r / 32, nb = r % 32; transpose_item(wout, DM, DM, nullptr, wl + W_OUT / 2, 32 * nb, scr, 64 * kb, 32 * nb, lane); continue; }
        r -= I_OUT;
        if (r < I_13) { const int kb = r / 176, nb = r % 176, n0 = 32 * nb, half = n0 / FFH, j = n0 % FFH, dst = 256 * (j / 128) + 128 * half + (j % 128);
            transpose_item(a.in[22] + (size_t)L * DM * NW13, DM, NW13, a.in[2] + L * DM, wl + W_13 / 2, dst, scr, 64 * kb, n0, lane); continue; }
        r -= I_13;
        { const int kb = r / 32, nb = r % 32; transpose_item(a.in[23] + (size_t)L * FFH * DM, FFH, DM, nullptr, wl + W_2 / 2, 32 * nb, scr, 64 * kb, 32 * nb, lane); }
    }
    const float* w1 = a.in[14]; const float* b1 = a.in[15]; const float* w2 = a.in[16]; const float* b2 = a.in[17]; const float* fr = a.in[19];
    float* hid = (float*)(a.ws + WS_HID);
    for (int t = gw; t < SEQ; t += ngw) {
        float zv = 0.f;
        if (lane == 0) zv = (float)t / (float)(SEQ - 1);
        else if (lane <= 32) { const int k = (lane - 1) & 15; const float band = 1e-4f + (float)k * ((15.0f - 1e-4f) / 15.0f);
            const float ang = ((6.283185307179586f * (float)t) / (float)SEQ) * band; zv = (lane <= 16) ? cosf(ang) : -sinf(ang); }
        float a1 = b1[lane];
        for (int e = 0; e < 33; ++e) a1 += __shfl(zv, e) * w1[e * 64 + lane];
        const float f = fr[lane];
        const float h1 = sinf(f * a1);
        float a2 = b2[lane];
        for (int i = 0; i < 64; ++i) a2 += __shfl(h1, i) * w2[i * 64 + lane];
        hid[t * 64 + lane] = sinf(f * a2);
    }
}

__device__ __forceinline__ void phase_filters(const Args& a, LAS unsigned char* lds, int vcu, int G, int wave, int lane, int tid) {
    const float* hid = (const float*)(a.ws + WS_HID); const float* w3 = a.in[18]; bf16* KF = (bf16*)(a.ws + WS_KF);
    constexpr int HS = 272;
    for (int p0 = vcu * NWAVES; p0 < 2 * DM; p0 += G * NWAVES) {
        const int p = p0 + wave, o = p >> 10, d = p & 1023, cf = o * 2048 + d, cr = cf + 1024;
        const float delta = 4.605170185988091f * (1.0f / 1.5f + (float)d * ((1.0f / 0.3f - 1.0f / 1.5f) / 1023.0f));
        bf16* kf = KF + (size_t)p * KF_LEN;
        LAS float* wcol = (LAS float*)(lds + 17408 + NWAVES * 16384 + wave * 512);
        wcol[lane] = w3[(size_t)lane * 4096 + cf]; wcol[64 + lane] = w3[(size_t)lane * 4096 + cr];
        float asum = 0.f;
        LAS float* vals = (LAS float*)(lds + 17408 + wave * 16384);
        v4u hreg[2];
#pragma unroll
        for (int i = 0; i < 2; ++i) { const int idx = tid + 512 * i; hreg[i] = *(const v4u*)(hid + (size_t)(idx >> 4) * 64 + (idx & 15) * 4); }
#pragma unroll 1
        for (int tb = 0; tb < 32; ++tb) {
            __syncthreads();
#pragma unroll
            for (int i = 0; i < 2; ++i) { const int idx = tid + 512 * i; *(LAS v4u*)(lds + (idx >> 4) * HS + (idx & 15) * 16) = hreg[i]; }
            if (tb < 31) {
#pragma unroll
                for (int i = 0; i < 2; ++i) { const int idx = tid + 512 * i; hreg[i] = *(const v4u*)(hid + (size_t)((tb + 1) * 64 + (idx >> 4)) * 64 + (idx & 15) * 4); } }
            __syncthreads();
            const int t = tb * 64 + lane; const LAS f32x4* hr = (const LAS f32x4*)(lds + lane * HS);
            float af = 0.f, ar = 0.f;
#pragma unroll
            for (int j4 = 0; j4 < 16; ++j4) { const f32x4 h = hr[j4]; const f32x4 a4 = ((const LAS f32x4*)wcol)[j4], b4 = ((const LAS f32x4*)wcol)[16 + j4];
                af += h[0] * a4[0] + h[1] * a4[1] + h[2] * a4[2] + h[3] * a4[3];
                ar += h[0] * b4[0] + h[1] * b4[1] + h[2] * b4[2] + h[3] * b4[3]; }
            const float dec = __expf(-((float)t / (float)(SEQ - 1)) * delta);
            af *= dec; ar *= dec; vals[(2 * tb) * 64 + lane] = af; vals[(2 * tb + 1) * 64 + lane] = ar;
            asum += (t == 0) ? fabsf(af + ar) : (fabsf(af) + fabsf(ar));
        }
        const float inv = 1.0f / wave_sum(asum);
#pragma unroll 4
        for (int tb = 0; tb < 32; ++tb) { const int t = tb * 64 + lane; const float vf = vals[(2 * tb) * 64 + lane], vr = vals[(2 * tb + 1) * 64 + lane];
            if (t == 0) kf[2048] = f2bf((vf + vr) * inv); else { kf[2048 - t] = f2bf(vf * inv); kf[2048 + t] = f2bf(vr * inv); } }
        if (lane < 17) kf[lane == 0 ? 0 : 4095 + lane] = 0;
    }
    __syncthreads();
}

__device__ __forceinline__ void phase_norm0(const float* __restrict__ x, bf16* __restrict__ xn, float* __restrict__ ss, int gw, int ngw, int lane) {
    for (int m = gw; m < MTOK; m += ngw) {
        const f32x4* xr = (const f32x4*)(x + (size_t)m * DM) + lane;
        f32x4 v[4]; float s = 0.f;
#pragma unroll
        for (int j = 0; j < 4; ++j) { v[j] = xr[64 * j]; s += (v[j].x * v[j].x + v[j].y * v[j].y) + (v[j].z * v[j].z + v[j].w * v[j].w); }
        s = wave_sum(s);
        if (lane < 16) ss[(size_t)m * 16 + lane] = (lane == 0) ? s : 0.f;
        unsigned long long* o8 = (unsigned long long*)(xn + (size_t)m * DM) + lane;
#pragma unroll
        for (int j = 0; j < 4; ++j) o8[64 * j] = (unsigned long long)pk2(v[j].x, v[j].y) | ((unsigned long long)pk2(v[j].z, v[j].w) << 32);
    }
}

__device__ __forceinline__ void fill_row_scales(const pg8::StaticOrder& S, const float* ss, LAS float* rst, int tid) {
    for (int idx = tid; idx < 11 * 256; idx += NTHREADS) { pg8::Unit u; if (!S.next(idx >> 8, u)) break; rst[idx] = pg8::row_rscale(ss, u.pm * 256 + (idx & 255)); }
    __syncthreads();
}

__device__ __forceinline__ void phase_shortconv(const bf16* __restrict__ cu, const bf16* __restrict__ bg, const float* __restrict__ cw, bf16* __restrict__ outp, int gtid, int ngt) {
    for (int idx = gtid; idx < MTOK * 128; idx += ngt) {
        const int m = idx >> 7, d0 = (idx & 127) * 8, t = m & (SEQ - 1);
        const size_t o = (size_t)m * DM + d0;
        const v4u bv = *(const v4u*)(bg + o), c1 = *(const v4u*)(cu + o);
        v4u c0 = {0u, 0u, 0u, 0u}, c2 = c0;
        if (t > 0) c0 = *(const v4u*)(cu + o - DM);
        if (t < SEQ - 1) c2 = *(const v4u*)(cu + o + DM);
        const f32x4 wa0 = *(const f32x4*)(cw + d0), wa1 = *(const f32x4*)(cw + d0 + 4), wb0 = *(const f32x4*)(cw + DM + d0), wb1 = *(const f32x4*)(cw + DM + d0 + 4),
                    wc0 = *(const f32x4*)(cw + 2 * DM + d0), wc1 = *(const f32x4*)(cw + 2 * DM + d0 + 4);
        v4u ov;
#pragma unroll
        for (int k = 0; k < 4; ++k) {
            const float w0l = (k < 2) ? wa0[2 * k] : wa1[2 * k - 4], w0h = (k < 2) ? wa0[2 * k + 1] : wa1[2 * k - 3];
            const float w1l = (k < 2) ? wb0[2 * k] : wb1[2 * k - 4], w1h = (k < 2) ? wb0[2 * k + 1] : wb1[2 * k - 3];
            const float w2l = (k < 2) ? wc0[2 * k] : wc1[2 * k - 4], w2h = (k < 2) ? wc0[2 * k + 1] : wc1[2 * k - 3];
            const float lo = bflo(bv[k]) * (w0l * bflo(c0[k]) + w1l * bflo(c1[k]) + w2l * bflo(c2[k]));
            const float hi = bfhi(bv[k]) * (w0h * bfhi(c0[k]) + w1h * bfhi(c1[k]) + w2h * bfhi(c2[k]));
            ov[k] = pk2(lo, hi);
        }
        *(v4u*)(outp + o) = ov;
    }
}

__device__ __forceinline__ void norm_frag(const v4u r0, const v4u r1, const LAS float* g, int quad, float extra, bf16x8& f0, bf16x8& f1) {
    float x[16];
#pragma unroll
    for (int k = 0; k < 4; ++k) { x[2 * k] = bflo(r0[k]); x[2 * k + 1] = bfhi(r0[k]); x[8 + 2 * k] = bflo(r1[k]); x[9 + 2 * k] = bfhi(r1[k]); }
    float ss = 0.f;
#pragma unroll
    for (int k = 0; k < 16; ++k) ss += x[k] * x[k];
    ss += __shfl_xor(ss, 16); ss += __shfl_xor(ss, 32);
    const float r = rsqrtf(ss * (1.0f / 64.0f) + RMS_EPS) * extra;
    v4u o0, o1;
#pragma unroll
    for (int k = 0; k < 4; ++k) { o0[k] = pk2c(x[2 * k] * r * g[8 * quad + 2 * k], x[2 * k + 1] * r * g[8 * quad + 2 * k + 1]);
        o1[k] = pk2c(x[8 + 2 * k] * r * g[32 + 8 * quad + 2 * k], x[9 + 2 * k] * r * g[32 + 8 * quad + 2 * k + 1]); }
    f0 = __builtin_bit_cast(bf16x8, o0); f1 = __builtin_bit_cast(bf16x8, o1);
}

constexpr int AR_SLOT = 16640, AR_V = 8192, AR_RK = 16384, AR_NSLOT = 9, AR_RPB = AR_NSLOT * AR_SLOT, AR_G = AR_RPB + 1920;
__device__ __forceinline__ int ar_off(int k, int c) { return k * 128 + ((c ^ (k & 7)) << 4); }

constexpr int A3_NSLOT = 8, A3_RPB = A3_NSLOT * AR_SLOT, A3_G = A3_RPB + 1920, A3_CMB = A3_G + 256, A3_CMB_BYTES = 4608;
static_assert(A3_CMB + 4 * A3_CMB_BYTES <= MISC_OFF, "attention LDS map");
__device__ __forceinline__ void phase_natten3(const bf16* qkv, const float* qg, const float* kg, const float* rpb, const float* kss, bf16* outp, LAS unsigned char* lds, int vcu, int G, int wave, int lane, int tid) {
    LAS float* rpb_l = (LAS float*)(lds + A3_RPB); LAS float* g_l = (LAS float*)(lds + A3_G);
    const int n = lane & 15, quad = lane >> 4, qq = (lane >> 2) & 3, p = lane & 3;
    const int cb = wave & 3, kh = wave >> 2;
    LAS unsigned char* cmb = lds + A3_CMB + cb * A3_CMB_BYTES;
    const int lk = (tid >> 3) & 63, lc = tid & 7;
    for (int unit = vcu; unit < NB * 16; unit += G) {
        const int b = unit >> 4, h = unit & 15;
        const bf16* kvbase = qkv + (size_t)b * SEQ * NQKV + DM + h * 64 + lc * 8 + (size_t)lk * NQKV;
        const float* ksbase = kss + (size_t)(2 * h) * MTOK + (size_t)b * SEQ + tid;
        __syncthreads();
        for (int i = tid; i < 15 * 31; i += NTHREADS) rpb_l[i] = rpb[h * (15 * 31) + i] * 1.4426950408889634f;
        if (tid < 64) g_l[tid] = qg[tid] * kg[tid];
        {   v4u rk_[8], rv_[8]; float rs_[8];
#pragma unroll
            for (int rho = 0; rho < 8; ++rho) { const bf16* pp = kvbase + (size_t)rho * 64 * NQKV; rk_[rho] = *(const v4u*)pp; rv_[rho] = *(const v4u*)(pp + DM);
                rs_[rho] = (tid < 64) ? ksbase[rho * 64] + ksbase[MTOK + rho * 64] : 0.f; }
#pragma unroll
            for (int rho = 0; rho < 8; ++rho) { LAS unsigned char* slot = lds + rho * AR_SLOT; *(LAS v4u*)(slot + ar_off(lk, lc)) = rk_[rho]; *(LAS v4u*)(slot + AR_V + ar_off(lk, lc)) = rv_[rho];
                if (tid < 64) *(LAS float*)(slot + AR_RK + 4 * tid) = __builtin_amdgcn_rsqf(rs_[rho] * (1.0f / 64.0f) + RMS_EPS); } }
        int start = cb * 16 - 8; start = start < 0 ? 0 : (start > 32 ? 32 : start);
        const int qc = cb * 16 + n; int cs = qc - 8; cs = cs < 0 ? 0 : (cs > 48 ? 48 : cs);
        const bf16* qbase = qkv + (size_t)(b * SEQ + cb * 16 + n) * NQKV + h * 64 + 8 * quad;
        v4u qr0 = *(const v4u*)qbase, qr1 = *(const v4u*)(qbase + 32);
        __syncthreads();
        float bia[4][2][4]; int prev_d0 = 1000;
#pragma unroll 1
        for (int r = 0; r < 32; ++r) {
            int rs = r - 4; rs = rs < 0 ? 0 : (rs > 24 ? 24 : rs);
            int rsn = r - 3; rsn = rsn < 0 ? 0 : (rsn > 24 ? 24 : rsn);
            const bool slide = (r < 31) && (rsn != rs);
            v4u nk = {0u, 0u, 0u, 0u}, nv = nk; float nss = 0.f;
            if (slide) { const bf16* pp = kvbase + (size_t)(rs + 8) * 64 * NQKV; nk = *(const v4u*)pp; nv = *(const v4u*)(pp + DM); if (tid < 64) nss = ksbase[(rs + 8) * 64] + ksbase[MTOK + (rs + 8) * 64]; }
            bf16x8 qf0, qf1;
            norm_frag(qr0, qr1, g_l, quad, 0.125f * 1.4426950408889634f, qf0, qf1);
            if (r < 31) { const bf16* qp = qbase + (size_t)(r + 1) * 64 * NQKV; qr0 = *(const v4u*)qp; qr1 = *(const v4u*)(qp + 32); }
            f32x4 st[4][2];
#pragma unroll
            for (int jj = 0; jj < 4; ++jj) { const LAS unsigned char* slot = lds + ((rs + 4 * kh + jj) & 7) * AR_SLOT;
#pragma unroll
                for (int kt = 0; kt < 2; ++kt) { const int k = start + 16 * kt + n;
                    const bf16x8 kf0 = *(const LAS bf16x8*)(slot + ar_off(k, quad)), kf1 = *(const LAS bf16x8*)(slot + ar_off(k, quad + 4));
                    f32x4 sacc = {0.f, 0.f, 0.f, 0.f};
                    sacc = __builtin_amdgcn_mfma_f32_16x16x32_bf16(kf0, qf0, sacc, 0, 0, 0);
                    sacc = __builtin_amdgcn_mfma_f32_16x16x32_bf16(kf1, qf1, sacc, 0, 0, 0);
                    st[jj][kt] = sacc; } }
            if (rs - r != prev_d0) { prev_d0 = rs - r;
#pragma unroll
                for (int jj = 0; jj < 4; ++jj) { const int dr = rs + 4 * kh + jj - r + 7;
#pragma unroll
                    for (int kt = 0; kt < 2; ++kt)
#pragma unroll
                        for (int i = 0; i < 4; ++i) { const int kc = start + 16 * kt + 4 * quad + i; int dc = kc - qc + 15; dc = dc < 0 ? 0 : (dc > 30 ? 30 : dc);
                            bia[jj][kt][i] = ((kc >= cs) && (kc < cs + 16)) ? rpb_l[dr * 31 + dc] : -3.0e38f; } } }
            float mx = -3.0e38f;
#pragma unroll
            for (int jj = 0; jj < 4; ++jj) { const LAS unsigned char* slot = lds + ((rs + 4 * kh + jj) & 7) * AR_SLOT;
#pragma unroll
                for (int kt = 0; kt < 2; ++kt) { const f32x4 rk = *(const LAS f32x4*)(slot + AR_RK + 4 * (start + 16 * kt + 4 * quad));
#pragma unroll
                    for (int i = 0; i < 4; ++i) { const float v = st[jj][kt][i] * rk[i] + bia[jj][kt][i]; st[jj][kt][i] = v; mx = fmaxf(mx, v); } } }
            mx = fmaxf(mx, __shfl_xor(mx, 16)); mx = fmaxf(mx, __shfl_xor(mx, 32));
            float sum = 0.f;
#pragma unroll
            for (int jj = 0; jj < 4; ++jj)
#pragma unroll
                for (int kt = 0; kt < 2; ++kt)
#pragma unroll
                    for (int i = 0; i < 4; ++i) { const float e = __builtin_amdgcn_exp2f(st[jj][kt][i] - mx); st[jj][kt][i] = e; sum += e; }
            sum += __shfl_xor(sum, 16); sum += __shfl_xor(sum, 32);
            f32x4 oacc[4];
#pragma unroll
            for (int dt = 0; dt < 4; ++dt) oacc[dt] = (f32x4){0.f, 0.f, 0.f, 0.f};
            const int kl = start + 4 * quad + qq;
            v4i16_t lo[4][4], hi[4][4];
#pragma unroll
            for (int jj = 0; jj < 4; ++jj) {
                const unsigned vs = (unsigned)(unsigned long long)(lds + ((rs + 4 * kh + jj) & 7) * AR_SLOT + AR_V) + 8 * (p & 1);
#pragma unroll
                for (int dt = 0; dt < 4; ++dt) { const unsigned a_lo = vs + ar_off(kl, 2 * dt + (p >> 1)), a_hi = vs + ar_off(kl + 16, 2 * dt + (p >> 1));
                    asm volatile("ds_read_b64_tr_b16 %0, %1" : "=v"(lo[jj][dt]) : "v"(a_lo) : "memory");
                    asm volatile("ds_read_b64_tr_b16 %0, %1" : "=v"(hi[jj][dt]) : "v"(a_hi) : "memory"); } }
            bf16x8 pf[4];
#pragma unroll
            for (int jj = 0; jj < 4; ++jj) { const f32x4 s0 = st[jj][0], s1 = st[jj][1];
                v4u pw; pw.x = pk2c(s0[0], s0[1]); pw.y = pk2c(s0[2], s0[3]); pw.z = pk2c(s1[0], s1[1]); pw.w = pk2c(s1[2], s1[3]); pf[jj] = __builtin_bit_cast(bf16x8, pw); }
            asm volatile("s_waitcnt lgkmcnt(0)" ::: "memory"); __builtin_amdgcn_sched_barrier(0);
#pragma unroll
            for (int jj = 0; jj < 4; ++jj)
#pragma unroll
                for (int dt = 0; dt < 4; ++dt) {
                    const bf16x8 vf = (bf16x8){lo[jj][dt][0], lo[jj][dt][1], lo[jj][dt][2], lo[jj][dt][3], hi[jj][dt][0], hi[jj][dt][1], hi[jj][dt][2], hi[jj][dt][3]};
                    oacc[dt] = __builtin_amdgcn_mfma_f32_16x16x32_bf16(vf, pf[jj], oacc[dt], 0, 0, 0);
                }
            if (kh == 1) {
#pragma unroll
                for (int dt = 0; dt < 4; ++dt) *(LAS f32x4*)(cmb + (dt * 64 + lane) * 16) = oacc[dt];
                *(LAS float*)(cmb + 4096 + lane * 8) = mx; *(LAS float*)(cmb + 4096 + lane * 8 + 4) = sum;
            }
            __syncthreads();
            if (kh == 0) {
                const float mb = *(const LAS float*)(cmb + 4096 + lane * 8), lb = *(const LAS float*)(cmb + 4096 + lane * 8 + 4);
                const float M = fmaxf(mx, mb), fa = __builtin_amdgcn_exp2f(mx - M), fb = __builtin_amdgcn_exp2f(mb - M), inv = 1.0f / (sum * fa + lb * fb), wa = fa * inv, wb = fb * inv;
                bf16* op = outp + (size_t)(b * SEQ + r * 64 + cb * 16 + n) * DM + h * 64 + 4 * quad;
#pragma unroll
                for (int dt = 0; dt < 4; ++dt) { const f32x4 ob = *(const LAS f32x4*)(cmb + (dt * 64 + lane) * 16); const f32x4 o = oacc[dt] * wa + ob * wb;
                    v2u w; w.x = pk2c(o[0], o[1]); w.y = pk2c(o[2], o[3]); *(v2u*)(op + 16 * dt) = w; }
            }
            if (slide) { LAS unsigned char* slot = lds + ((rs + 8) & 7) * AR_SLOT; *(LAS v4u*)(slot + ar_off(lk, lc)) = nk; *(LAS v4u*)(slot + AR_V + ar_off(lk, lc)) = nv;
                if (tid < 64) *(LAS float*)(slot + AR_RK + 4 * tid) = __builtin_amdgcn_rsqf(nss * (1.0f / 64.0f) + RMS_EPS); }
            __syncthreads();
        }
    }
}

constexpr int CT_STRIDE = 144, CT_BYTES = 66 * CT_STRIDE;
__device__ __forceinline__ void hyena_pre_fetch(const bf16* big, int id, int lane, v4u (&v)[9]) {
    const int ct = id & 31, tt = id >> 5, b = tt >> 5, t0 = (tt & 31) * 64, c0 = ct * 64;
#pragma unroll
    for (int ps = 0; ps < 9; ++ps) { const int rr = ps * 8 + (lane >> 3), part = lane & 7, t = t0 - 1 + rr;
        v[ps] = (v4u){0u, 0u, 0u, 0u};
        if (rr < 66 && t >= 0 && t < SEQ) v[ps] = *(const v4u*)(big + (size_t)(b * SEQ + t) * NQKV + c0 + part * 8); }
}
__device__ __forceinline__ void phase_hyena_pre(const bf16* big, const float* sw, const float* sb, bf16* VTp, bf16* X1Tp, LAS unsigned char* lds, int gw, int ngw, int wave, int lane) {
    LAS unsigned char* scr = lds + wave * 16384;
    v4u vin[9];
    if (gw < 512 * 32) hyena_pre_fetch(big, gw, lane, vin);
    for (int id = gw; id < 512 * 32; id += ngw) {
        const int ct = id & 31, tt = id >> 5, b = tt >> 5, t0 = (tt & 31) * 64, c0 = ct * 64;
#pragma unroll
        for (int ps = 0; ps < 9; ++ps) { const int rr = ps * 8 + (lane >> 3), part = lane & 7; if (rr < 66) *(LAS v4u*)(scr + rr * CT_STRIDE + part * 16) = vin[ps]; }
        if (id + ngw < 512 * 32) hyena_pre_fetch(big, id + ngw, lane, vin);
        LDS_WAIT();
        const int cg = c0 + lane; const float w0 = sw[cg], w1 = sw[NQKV + cg], w2 = sw[2 * NQKV + cg], bias = sb[cg];
        const LAS unsigned short* col = (const LAS unsigned short*)(scr + 2 * lane);
        float pa = bf2f(col[0]), pb = bf2f(col[CT_STRIDE / 2]);
        v4u o[8];
#pragma unroll
        for (int g8 = 0; g8 < 8; ++g8) { float y[8];
#pragma unroll
            for (int k = 0; k < 8; ++k) { const float pc = bf2f(col[(g8 * 8 + k + 2) * (CT_STRIDE / 2)]); y[k] = w0 * pa + w1 * pb + w2 * pc + bias; pa = pb; pb = pc; }
            o[g8].x = pk2(y[0], y[1]); o[g8].y = pk2(y[2], y[3]); o[g8].z = pk2(y[4], y[5]); o[g8].w = pk2(y[6], y[7]); }
        LDS_WAIT();
#pragma unroll
        for (int g8 = 0; g8 < 8; ++g8) *(LAS v4u*)(scr + lane * CT_STRIDE + g8 * 16) = o[g8];
        LDS_WAIT();
#pragma unroll
        for (int ps = 0; ps < 8; ++ps) { const int cl = ps * 8 + (lane >> 3), part = lane & 7, cc = c0 + cl;
            const v4u v = *(const LAS v4u*)(scr + cl * CT_STRIDE + part * 16);
            bf16* op = (cc < DM ? VTp + (size_t)cc * NB * SEQ : X1Tp + (size_t)(cc - DM) * NB * SEQ) + (size_t)b * SEQ + t0 + part * 8;
            *(v4u*)op = v; }
        LDS_WAIT();
    }
}
constexpr int U_STRIDE = 4112, U_BYTES = 16 * U_STRIDE, CP_OFF = U_BYTES, CP_STRIDE = 8224;
struct HyFilt { v4u a, b; };
__device__ __forceinline__ HyFilt hyena_fetch_filter(const bf16* kf, int tid) { HyFilt f; const v4u* src = (const v4u*)kf; f.a = src[tid]; f.b = (tid < 2) ? src[512 + tid] : (v4u){0u, 0u, 0u, 0u}; return f; }
__device__ __forceinline__ void hyena_put_filter(LAS unsigned char* lds, const HyFilt& f, int tid) {
    *(LAS v4u*)(lds + CP_OFF + 16 * tid) = f.a;
    if (tid < 2) *(LAS v4u*)(lds + CP_OFF + 16 * (512 + tid)) = f.b;
    __syncthreads();
    const v4u lo = *(LAS v4u*)(lds + CP_OFF + 16 * tid), hi = *(LAS v4u*)(lds + CP_OFF + 16 * tid + 16);
    const unsigned s[8] = {lo.x, lo.y, lo.z, lo.w, hi.x, hi.y, hi.z, hi.w};
#pragma unroll
    for (int r = 1; r < 8; ++r) { v4u o;
#pragma unroll
        for (int w = 0; w < 4; ++w) { const int q = w + r / 2; o[w] = (r & 1) ? ((s[q] >> 16) | (s[q + 1] << 16)) : s[q]; }
        *(LAS v4u*)(lds + CP_OFF + r * CP_STRIDE + 16 * tid) = o; }
    __syncthreads();
}
__device__ __forceinline__ void hyena_conv(LAS unsigned char* lds, f32x4 (&acc)[16], unsigned toep0, unsigned uaddr0) {
#pragma unroll
    for (int ti = 0; ti < 16; ++ti) acc[ti] = (f32x4){0.f, 0.f, 0.f, 0.f};
#pragma unroll 1
    for (int k8 = 0; k8 < 8; ++k8) {
        bf16x8 uf[8];
#pragma unroll
        for (int s = 0; s < 8; ++s) uf[s] = *(const LAS bf16x8*)(lds + uaddr0 + 512 * k8 + 64 * s);
#pragma unroll
        for (int x = 0; x < 30; ++x) {
            const bf16x8 tf = *(const LAS bf16x8*)(lds + toep0 + 512 * k8 + 32 * x);
#pragma unroll
            for (int s = 0; s < 8; ++s) { const int ti = 15 + 2 * s - x; if (ti >= 0 && ti < 16) acc[ti] = __builtin_amdgcn_mfma_f32_16x16x32_bf16(tf, uf[s], acc[ti], 0, 0, 0); }
        }
    }
}
__device__ __forceinline__ void phase_hyena(bf16* VT, const bf16* X1T, const bf16* KF, const float* skip, LAS unsigned char* lds, int vcu, int G, int wave, int lane, int tid) {
    const int n = lane & 15, quad = lane >> 4, rho = (-n) & 7;
    const int base = 2048 - 256 * wave - n + 8 * quad;
    const unsigned toep0 = CP_OFF + rho * CP_STRIDE + 16 * ((base >> 3) - 30);
    const unsigned uaddr0 = n * U_STRIDE + 16 * quad;
    v4u ur[8]; HyFilt f0;
    if (vcu < DM) { const v4u* src = (const v4u*)(VT + (size_t)vcu * NB * SEQ);
#pragma unroll
        for (int k = 0; k < 8; ++k) ur[k] = src[tid + 512 * k];
        f0 = hyena_fetch_filter(KF + (size_t)vcu * KF_LEN, tid); }
    for (int d = vcu; d < DM; d += G) {
        bf16* vrow = VT + (size_t)d * NB * SEQ;
#pragma unroll
        for (int k = 0; k < 8; ++k) { const int c = tid + 512 * k; *(LAS v4u*)(lds + (c >> 8) * U_STRIDE + 16 * (c & 255)) = ur[k]; }
        hyena_put_filter(lds, f0, tid);
        const HyFilt f1 = hyena_fetch_filter(KF + (size_t)(DM + d) * KF_LEN, tid);
        v2u xx[16];
#pragma unroll
        for (int ti = 0; ti < 16; ++ti) xx[ti] = *(const v2u*)(X1T + ((size_t)d * NB + n) * SEQ + 256 * wave + 16 * ti + 4 * quad);
        f32x4 acc[16];
        hyena_conv(lds, acc, toep0, uaddr0);
        const float sk0 = skip[d], sk1 = skip[DM + d];
        v2u z[16];
#pragma unroll
        for (int ti = 0; ti < 16; ++ti) { const int t = 256 * wave + 16 * ti + 4 * quad;
            const v2u vv = *(const LAS v2u*)(lds + n * U_STRIDE + 2 * t);
            const float z0 = bflo(xx[ti].x) * (acc[ti][0] + sk0 * bflo(vv.x)), z1 = bfhi(xx[ti].x) * (acc[ti][1] + sk0 * bfhi(vv.x));
            const float z2 = bflo(xx[ti].y) * (acc[ti][2] + sk0 * bflo(vv.y)), z3 = bfhi(xx[ti].y) * (acc[ti][3] + sk0 * bfhi(vv.y));
            z[ti].x = pk2(z0, z1); z[ti].y = pk2(z2, z3); }
        __syncthreads();
#pragma unroll
        for (int ti = 0; ti < 16; ++ti) { const int t = 256 * wave + 16 * ti + 4 * quad; *(LAS v2u*)(lds + n * U_STRIDE + 2 * t) = z[ti]; }
        hyena_put_filter(lds, f1, tid);
        if (d + G < DM) { const v4u* src = (const v4u*)(VT + (size_t)(d + G) * NB * SEQ);
#pragma unroll
            for (int k = 0; k < 8; ++k) ur[k] = src[tid + 512 * k];
            f0 = hyena_fetch_filter(KF + (size_t)(d + G) * KF_LEN, tid); }
        hyena_conv(lds, acc, toep0, uaddr0);
        __syncthreads();
#pragma unroll
        for (int ti = 0; ti < 16; ++ti) { const int t = 256 * wave + 16 * ti + 4 * quad;
            const float o0 = acc[ti][0] + sk1 * bflo(z[ti].x), o1 = acc[ti][1] + sk1 * bfhi(z[ti].x), o2 = acc[ti][2] + sk1 * bflo(z[ti].y), o3 = acc[ti][3] + sk1 * bfhi(z[ti].y);
            v2u w; w.x = pk2(o0, o1); w.y = pk2(o2, o3); *(LAS v2u*)(lds + n * U_STRIDE + 2 * t) = w; }
        __syncthreads();
        {   v4u* dst = (v4u*)vrow;
#pragma unroll
            for (int k = 0; k < 8; ++k) { const int c = tid + 512 * k; dst[c] = *(const LAS v4u*)(lds + (c >> 8) * U_STRIDE + 16 * (c & 255)); } }
        __syncthreads();
    }
}
constexpr int C5_STRIDE = 132;
__device__ __forceinline__ void phase_hyena_post(const bf16* big, const float* sw, const float* sb, const bf16* ZT, bf16* outp, LAS unsigned char* lds, int gw, int ngw, int wave, int lane) {
    LAS unsigned char* scr = lds + wave * 16384;
    for (int id = gw; id < 512 * 16; id += ngw) {
        const int dtile = id & 15, tt = id >> 4, b = tt >> 5, t0 = (tt & 31) * 64, d0 = dtile * 64;
        const int cg = 2 * DM + d0 + lane; const float w0 = sw[cg], w1 = sw[NQKV + cg], w2 = sw[2 * NQKV + cg], bias = sb[cg];
        const bf16* pp = big + (size_t)(b * SEQ + t0) * NQKV + cg;
        unsigned short pr[66];
#pragma unroll
        for (int k = 0; k < 66; ++k) { const int t = t0 - 1 + k; pr[k] = (t >= 0 && t < SEQ) ? pp[(long)(k - 1) * NQKV] : (unsigned short)0; }
        v4u zv[8];
#pragma unroll
        for (int ps = 0; ps < 8; ++ps) { const int dd = ps * 8 + (lane >> 3), part = lane & 7; zv[ps] = *(const v4u*)(ZT + ((size_t)(d0 + dd) * NB + b) * SEQ + t0 + part * 8); }
#pragma unroll
        for (int ps = 0; ps < 8; ++ps) { const int dd = ps * 8 + (lane >> 3), part = lane & 7;
            LAS unsigned* w = (LAS unsigned*)(scr + dd * C5_STRIDE + part * 16); w[0] = zv[ps].x; w[1] = zv[ps].y; w[2] = zv[ps].z; w[3] = zv[ps].w; }
        LDS_WAIT();
        const LAS unsigned short* zr = (const LAS unsigned short*)(scr + lane * C5_STRIDE);
        bf16* op = outp + (size_t)(b * SEQ + t0) * DM + d0 + lane;
#pragma unroll
        for (int k = 0; k < 64; ++k) { const float y = (w0 * bf2f(pr[k]) + w1 * bf2f(pr[k + 1]) + w2 * bf2f(pr[k + 2]) + bias) * bf2f(zr[k]); op[(size_t)k * DM] = f2bf(y); }
        LDS_WAIT();
    }
}

__global__ void __launch_bounds__(NTHREADS, 2) mk_fwd(Args a) {
    extern __shared__ __attribute__((aligned(16))) unsigned char lds_raw[];
    LAS unsigned char* lds = (LAS unsigned char*)lds_raw;
    cg::grid_group grid = cg::this_grid();
    const int tid = threadIdx.x, lane = tid & 63, wave = __builtin_amdgcn_readfirstlane(tid >> 6);
    const int G = gridDim.x, bx = blockIdx.x;
    const int vcu = (G % 8 == 0) ? (bx % 8) * (G / 8) + bx / 8 : bx;
    const int gw = vcu * NWAVES + wave, ngw = G * NWAVES;
    unsigned char* ws = a.ws;
    float* SS = (float*)(ws + WS_SS); bf16* XN = (bf16*)(ws + WS_XN); bf16* VT = (bf16*)(ws + WS_VT); bf16* MIXO = (bf16*)(ws + WS_MIXO); bf16* BIG = (bf16*)(ws + WS_BIG);
    const int lo = a.ph_lo, hi = a.ph_hi; int ph = 0;
    volatile LAS unsigned* MISC = (volatile LAS unsigned*)(lds + MISC_OFF);
    if (tid < 16) MISC[tid] = 0u;
    __syncthreads();
    XcdBarrier xbar = xcd_barrier_post((unsigned*)(ws + WS_BAR), MISC);
#define PH_BEGIN if (ph >= lo && ph < hi) {
#define PH_END   if (ph + 1 < hi) { if (ph == 0) grid.sync(); else xcd_barrier(xbar); } } ++ph;

    PH_BEGIN phase_prologue(a, lds, gw, ngw, wave, lane);
    PH_END
    PH_BEGIN phase_filters(a, lds, vcu, G, wave, lane, tid); phase_norm0(a.in[0], XN, SS, gw, ngw, lane); PH_END

    { constexpr int L = 0;

        constexpr int kind = L % 3;
        const bf16* wl = (const bf16*)(ws + WS_W + (size_t)L * W_LAYER);
        PH_BEGIN { pg8::Gemm g{XN, wl + W_IN / 2, MTOK, NQKV, DM}; pg8::StaticOrder S; S.init(MTOK, NQKV, G, bx); fill_row_scales(S, SS, (LAS float*)(lds + RST_OFF), tid);
                   if constexpr (kind == 0) { pg8::EpiShortIn E{BIG, BIG + (size_t)MTOK * DM, (const LAS float*)(lds + RST_OFF)}; pg8::gemm_phase<pg8::EpiShortIn, pg8::StaticOrder, true, true>(lds, g, S, E); }
                   else { pg8::EpiBf16PT<(kind == 1)> E{BIG, NQKV, (const LAS float*)(lds + RST_OFF), (float*)(ws + WS_KSS), MTOK};
                   pg8::gemm_phase<pg8::EpiBf16PT<(kind == 1)>, pg8::StaticOrder, true, true>(lds, g, S, E); }
 } PH_END
        if (kind == 0) {
            PH_BEGIN phase_shortconv(BIG, BIG + (size_t)MTOK * DM, a.in[4] + (size_t)(L / 3) * 3 * DM, MIXO, vcu * NTHREADS + tid, G * NTHREADS);
            PH_END
        } else if (kind == 1) {
            PH_BEGIN
            phase_natten3(BIG, a.in[7], a.in[8], a.in[9], (const float*)(ws + WS_KSS), MIXO, lds, vcu, G, wave, lane, tid); PH_END
        } else {
            PH_BEGIN phase_hyena_pre(BIG, a.in[12], a.in[13], VT, MIXO, lds, gw, ngw, wave, lane);
            PH_END
            PH_BEGIN
            phase_hyena(VT, MIXO, (const bf16*)(ws + WS_KF), a.in[20], lds, vcu, G, wave, lane, tid); PH_END
            PH_BEGIN phase_hyena_post(BIG, a.in[12], a.in[13], VT, MIXO, lds, gw, ngw, wave, lane);
            PH_END
        }
        PH_BEGIN { pg8::Gemm g{MIXO, wl + W_OUT / 2, MTOK, DM, DM}; pg8::StaticOrder S; S.init(MTOK, DM, G, bx); pg8::EpiResNorm E{a.out, XN, SS, DM};
                   pg8::gemm_phase<pg8::EpiResNorm, pg8::StaticOrder, true, true>(lds, g, S, E); } PH_END
        PH_BEGIN { pg8::Gemm g{XN, wl + W_13 / 2, MTOK, NW13, DM}; pg8::StaticOrder S; S.init(MTOK, NW13, G, bx); pg8::EpiSwiGLU E{BIG, FFH, (const LAS float*)(lds + RST_OFF)}; fill_row_scales(S, SS, (LAS float*)(lds + RST_OFF), tid);
                   pg8::gemm_phase<pg8::EpiSwiGLU, pg8::StaticOrder, true, true>(lds, g, S, E);
 } PH_END
        PH_BEGIN { pg8::Gemm g{BIG, wl + W_2 / 2, MTOK, DM, FFH}; pg8::StaticOrder S; S.init(MTOK, DM, G, bx); pg8::EpiResNormT<(L == NLAYER - 1)> E{a.out, XN, SS, DM};
                   pg8::gemm_phase<pg8::EpiResNormT<(L == NLAYER - 1)>, pg8::StaticOrder, true, true>(lds, g, S, E); } PH_END
        }
    { constexpr int L = 1;

        constexpr int kind = L % 3;
        const bf16* wl = (const bf16*)(ws + WS_W + (size_t)L * W_LAYER);
        PH_BEGIN { pg8::Gemm g{XN, wl + W_IN / 2, MTOK, NQKV, DM}; pg8::StaticOrder S; S.init(MTOK, NQKV, G, bx); fill_row_scales(S, SS, (LAS float*)(lds + RST_OFF), tid);
                   if constexpr (kind == 0) { pg8::EpiShortIn E{BIG, BIG + (size_t)MTOK * DM, (const LAS float*)(lds + RST_OFF)}; pg8::gemm_phase<pg8::EpiShortIn, pg8::StaticOrder, true, true>(lds, g, S, E); }
                   else { pg8::EpiBf16PT<(kind == 1)> E{BIG, NQKV, (const LAS float*)(lds + RST_OFF), (float*)(ws + WS_KSS), MTOK};
                   pg8::gemm_phase<pg8::EpiBf16PT<(kind == 1)>, pg8::StaticOrder, true, true>(lds, g, S, E); }
 } PH_END
        if (kind == 0) {
            PH_BEGIN phase_shortconv(BIG, BIG + (size_t)MTOK * DM, a.in[4] + (size_t)(L / 3) * 3 * DM, MIXO, vcu * NTHREADS + tid, G * NTHREADS);
            PH_END
        } else if (kind == 1) {
            PH_BEGIN
            phase_natten3(BIG, a.in[7], a.in[8], a.in[9], (const float*)(ws + WS_KSS), MIXO, lds, vcu, G, wave, lane, tid); PH_END
        } else {
            PH_BEGIN phase_hyena_pre(BIG, a.in[12], a.in[13], VT, MIXO, lds, gw, ngw, wave, lane);
            PH_END
            PH_BEGIN
            phase_hyena(VT, MIXO, (const bf16*)(ws + WS_KF), a.in[20], lds, vcu, G, wave, lane, tid); PH_END
            PH_BEGIN phase_hyena_post(BIG, a.in[12], a.in[13], VT, MIXO, lds, gw, ngw, wave, lane);
            PH_END
        }
        PH_BEGIN { pg8::Gemm g{MIXO, wl + W_OUT / 2, MTOK, DM, DM}; pg8::StaticOrder S; S.init(MTOK, DM, G, bx); pg8::EpiResNorm E{a.out, XN, SS, DM};
                   pg8::gemm_phase<pg8::EpiResNorm, pg8::StaticOrder, true, true>(lds, g, S, E); } PH_END
        PH_BEGIN { pg8::Gemm g{XN, wl + W_13 / 2, MTOK, NW13, DM}; pg8::StaticOrder S; S.init(MTOK, NW13, G, bx); pg8::EpiSwiGLU E{BIG, FFH, (const LAS float*)(lds + RST_OFF)}; fill_row_scales(S, SS, (LAS float*)(lds + RST_OFF), tid);
                   pg8::gemm_phase<pg8::EpiSwiGLU, pg8::StaticOrder, true, true>(lds, g, S, E);
 } PH_END
        PH_BEGIN { pg8::Gemm g{BIG, wl + W_2 / 2, MTOK, DM, FFH}; pg8::StaticOrder S; S.init(MTOK, DM, G, bx); pg8::EpiResNormT<(L == NLAYER - 1)> E{a.out, XN, SS, DM};
                   pg8::gemm_phase<pg8::EpiResNormT<(L == NLAYER - 1)>, pg8::StaticOrder, true, true>(lds, g, S, E); } PH_END
        }
    { constexpr int L = 2;

        constexpr int kind = L % 3;
        const bf16* wl = (const bf16*)(ws + WS_W + (size_t)L * W_LAYER);
        PH_BEGIN { pg8::Gemm g{XN, wl + W_IN / 2, MTOK, NQKV, DM}; pg8::StaticOrder S; S.init(MTOK, NQKV, G, bx); fill_row_scales(S, SS, (LAS float*)(lds + RST_OFF), tid);
                   if constexpr (kind == 0) { pg8::EpiShortIn E{BIG, BIG + (size_t)MTOK * DM, (const LAS float*)(lds + RST_OFF)}; pg8::gemm_phase<pg8::EpiShortIn, pg8::StaticOrder, true, true>(lds, g, S, E); }
                   else { pg8::EpiBf16PT<(kind == 1)> E{BIG, NQKV, (const LAS float*)(lds + RST_OFF), (float*)(ws + WS_KSS), MTOK};
                   pg8::gemm_phase<pg8::EpiBf16PT<(kind == 1)>, pg8::StaticOrder, true, true>(lds, g, S, E); }
 } PH_END
        if (kind == 0) {
            PH_BEGIN phase_shortconv(BIG, BIG + (size_t)MTOK * DM, a.in[4] + (size_t)(L / 3) * 3 * DM, MIXO, vcu * NTHREADS + tid, G * NTHREADS);
            PH_END
        } else if (kind == 1) {
            PH_BEGIN
            phase_natten3(BIG, a.in[7], a.in[8], a.in[9], (const float*)(ws + WS_KSS), MIXO, lds, vcu, G, wave, lane, tid); PH_END
        } else {
            PH_BEGIN phase_hyena_pre(BIG, a.in[12], a.in[13], VT, MIXO, lds, gw, ngw, wave, lane);
            PH_END
            PH_BEGIN
            phase_hyena(VT, MIXO, (const bf16*)(ws + WS_KF), a.in[20], lds, vcu, G, wave, lane, tid); PH_END
            PH_BEGIN phase_hyena_post(BIG, a.in[12], a.in[13], VT, MIXO, lds, gw, ngw, wave, lane);
            PH_END
        }
        PH_BEGIN { pg8::Gemm g{MIXO, wl + W_OUT / 2, MTOK, DM, DM}; pg8::StaticOrder S; S.init(MTOK, DM, G, bx); pg8::EpiResNorm E{a.out, XN, SS, DM};
                   pg8::gemm_phase<pg8::EpiResNorm, pg8::StaticOrder, true, true>(lds, g, S, E); } PH_END
        PH_BEGIN { pg8::Gemm g{XN, wl + W_13 / 2, MTOK, NW13, DM}; pg8::StaticOrder S; S.init(MTOK, NW13, G, bx); pg8::EpiSwiGLU E{BIG, FFH, (const LAS float*)(lds + RST_OFF)}; fill_row_scales(S, SS, (LAS float*)(lds + RST_OFF), tid);
                   pg8::gemm_phase<pg8::EpiSwiGLU, pg8::StaticOrder, true, true>(lds, g, S, E);
 } PH_END
        PH_BEGIN { pg8::Gemm g{BIG, wl + W_2 / 2, MTOK, DM, FFH}; pg8::StaticOrder S; S.init(MTOK, DM, G, bx); pg8::EpiResNormT<(L == NLAYER - 1)> E{a.out, XN, SS, DM};
                   pg8::gemm_phase<pg8::EpiResNormT<(L == NLAYER - 1)>, pg8::StaticOrder, true, true>(lds, g, S, E); } PH_END
        }
    { constexpr int L = 3;

        constexpr int kind = L % 3;
        const bf16* wl = (const bf16*)(ws + WS_W + (size_t)L * W_LAYER);
        PH_BEGIN { pg8::Gemm g{XN, wl + W_IN / 2, MTOK, NQKV, DM}; pg8::StaticOrder S; S.init(MTOK, NQKV, G, bx); fill_row_scales(S, SS, (LAS float*)(lds + RST_OFF), tid);
                   if constexpr (kind == 0) { pg8::EpiShortIn E{BIG, BIG + (size_t)MTOK * DM, (const LAS float*)(lds + RST_OFF)}; pg8::gemm_phase<pg8::EpiShortIn, pg8::StaticOrder, true, true>(lds, g, S, E); }
                   else { pg8::EpiBf16PT<(kind == 1)> E{BIG, NQKV, (const LAS float*)(lds + RST_OFF), (float*)(ws + WS_KSS), MTOK};
                   pg8::gemm_phase<pg8::EpiBf16PT<(kind == 1)>, pg8::StaticOrder, true, true>(lds, g, S, E); }
 } PH_END
        if (kind == 0) {
            PH_BEGIN phase_shortconv(BIG, BIG + (size_t)MTOK * DM, a.in[4] + (size_t)(L / 3) * 3 * DM, MIXO, vcu * NTHREADS + tid, G * NTHREADS);
            PH_END
        } else if (kind == 1) {
            PH_BEGIN
            phase_natten3(BIG, a.in[7], a.in[8], a.in[9], (const float*)(ws + WS_KSS), MIXO, lds, vcu, G, wave, lane, tid); PH_END
        } else {
            PH_BEGIN phase_hyena_pre(BIG, a.in[12], a.in[13], VT, MIXO, lds, gw, ngw, wave, lane);
            PH_END
            PH_BEGIN
            phase_hyena(VT, MIXO, (const bf16*)(ws + WS_KF), a.in[20], lds, vcu, G, wave, lane, tid); PH_END
            PH_BEGIN phase_hyena_post(BIG, a.in[12], a.in[13], VT, MIXO, lds, gw, ngw, wave, lane);
            PH_END
        }
        PH_BEGIN { pg8::Gemm g{MIXO, wl + W_OUT / 2, MTOK, DM, DM}; pg8::StaticOrder S; S.init(MTOK, DM, G, bx); pg8::EpiResNorm E{a.out, XN, SS, DM};
                   pg8::gemm_phase<pg8::EpiResNorm, pg8::StaticOrder, true, true>(lds, g, S, E); } PH_END
        PH_BEGIN { pg8::Gemm g{XN, wl + W_13 / 2, MTOK, NW13, DM}; pg8::StaticOrder S; S.init(MTOK, NW13, G, bx); pg8::EpiSwiGLU E{BIG, FFH, (const LAS float*)(lds + RST_OFF)}; fill_row_scales(S, SS, (LAS float*)(lds + RST_OFF), tid);
                   pg8::gemm_phase<pg8::EpiSwiGLU, pg8::StaticOrder, true, true>(lds, g, S, E);
 } PH_END
        PH_BEGIN { pg8::Gemm g{BIG, wl + W_2 / 2, MTOK, DM, FFH}; pg8::StaticOrder S; S.init(MTOK, DM, G, bx); pg8::EpiResNormT<(L == NLAYER - 1)> E{a.out, XN, SS, DM};
                   pg8::gemm_phase<pg8::EpiResNormT<(L == NLAYER - 1)>, pg8::StaticOrder, true, true>(lds, g, S, E); } PH_END
        }
#undef PH_BEGIN
#undef PH_END
}
#ifndef MK_NPH
#define MK_NPH (2 + 5 + 5 + 7 + 5)
#endif
constexpr int N_PHASES = MK_NPH;

extern "C" void kernel_launch(void* const* d_in, const int* in_sizes, int n_in, void* d_out, int out_size, void* d_ws, size_t ws_size, hipStream_t stream) {
    static int grid = 0;
    if (grid == 0) {
        if (n_in != 24 || out_size != MTOK * DM || ws_size < WS_END) { fprintf(stderr, "kernel_launch: unexpected shapes (n_in %d, out %d, ws %zu); nothing launched\n", n_in, out_size, ws_size); grid = -1; return; }
        int dev = 0, cus = 0, per_cu = 0;
        if (hipGetDevice(&dev) != hipSuccess || hipDeviceGetAttribute(&cus, hipDeviceAttributeMultiprocessorCount, dev) != hipSuccess) { grid = -1; return; }
        if (hipFuncSetAttribute((const void*)mk_fwd, hipFuncAttributeMaxDynamicSharedMemorySize, LDS_BYTES) != hipSuccess) { fprintf(stderr, "kernel_launch: hipFuncSetAttribute failed\n"); grid = -1; return; }
        if (hipOccupancyMaxActiveBlocksPerMultiprocessor(&per_cu, (const void*)mk_fwd, NTHREADS, LDS_BYTES) != hipSuccess || per_cu < 1) { fprintf(stderr, "kernel_launch: occupancy query gives %d\n", per_cu); per_cu = 1; }
        (void)hipGetLastError();
        grid = cus;
    }
    if (grid < 0) return;
    Args a{};
    for (int i = 0; i < 24; ++i) a.in[i] = (const float*)d_in[i];
    a.out = (float*)d_out; a.ws = (unsigned char*)d_ws;
    if (hipMemsetAsync(d_ws, 0, CTL_ZERO_BYTES, stream) != hipSuccess) { fprintf(stderr, "kernel_launch: memset of the control words failed\n"); return; }
#if MK_N_LAUNCHES == 1
    a.ph_lo = 0; a.ph_hi = N_PHASES;
    { void* args[] = {&a}; hipError_t e = hipLaunchCooperativeKernel((const void*)mk_fwd, dim3(grid), dim3(NTHREADS), args, LDS_BYTES, stream);
      if (e != hipSuccess) fprintf(stderr, "kernel_launch: cooperative launch failed: %s (grid %d)\n", hipGetErrorString(e), grid); }
#else
    for (int p = 0; p < N_PHASES; ++p) { a.ph_lo = p; a.ph_hi = p + 1; void* args[] = {&a};
        hipError_t e = hipLaunchCooperativeKernel((const void*)mk_fwd, dim3(grid), dim3(NTHREADS), args, LDS_BYTES, stream);
        if (e != hipSuccess) { fprintf(stderr, "kernel_launch: launch %d failed: %s\n", p, hipGetErrorString(e)); break; } }
#endif
}
```

```cpp
#include <hip/hip_runtime.h>
#include <hip/hip_cooperative_groups.h>
#include <cstdio>
#include <cstdint>
namespace cg = cooperative_groups;
namespace pg8 {
#define PG8_LAS __attribute__((address_space(3)))
typedef unsigned short bf16_t;
typedef short bf16x8 __attribute__((ext_vector_type(8)));
typedef float f32x4 __attribute__((ext_vector_type(4)));
typedef unsigned u32x4 __attribute__((ext_vector_type(4)));
constexpr int BM = 256, BK = 64, HALF = 128, HTB = HALF * BK * 2  , STAGE_BYTES = 8 * HTB, NXCD = 8, WGM = 8;

__host__ __device__ __forceinline__ int lds_byte(int r, int c) { const int st = (r >> 4) * 2 + (c >> 5), rr = r & 15, cc = c & 31, ob = rr * 64 + cc * 2; return st * 1024 + (ob ^ (((ob >> 9) & 1) << 5)); }
__host__ __device__ __forceinline__ void stage_rc(int b, int& R, int& C) { const int st = b / 1024, sb = b % 1024, swz = sb ^ (((sb >> 9) & 1) << 5); R = (st >> 1) * 16 + swz / 64; C = (st & 1) * 32 + (swz % 64) / 2; }
__host__ __device__ __forceinline__ int perm32(int rho) { const int n = rho >> 4, i = rho & 15; return 8 * (i >> 2) + 4 * n + (i & 3); }

struct Unit { int pm, pn, idx; };
struct Gemm { const bf16_t* A; const bf16_t* Bt; int M, N, K; };

struct StaticOrder {
    int nM, nN, nwg, G, c;
    __host__ __device__ void init(int M, int N, int G_, int c_) { nM = M / BM; nN = N / BM; nwg = nM * nN; G = G_; c = c_; }
    __host__ __device__ bool next(int i, Unit& u) const {
        const long L = (long)i * G + c; if (L >= nwg) return false;
        int wgid = (int)L; { const int q = nwg / NXCD, r = nwg % NXCD, xcd = wgid % NXCD, off = wgid / NXCD; wgid = (xcd < r ? xcd * (q + 1) : r * (q + 1) + (xcd - r) * q) + off; }
        const int nig = WGM * nN, gid = wgid / nig, fm = gid * WGM, gsz = (nM - fm) < WGM ? (nM - fm) : WGM;
        u.pm = fm + ((wgid % nig) % gsz); u.pn = (wgid % nig) / gsz; u.idx = i; return true;
    }
    __device__ __forceinline__ void a_ready(const Unit&) const {}
    __device__ __forceinline__ void done(const Unit&) const {}
};
__device__ __forceinline__ unsigned cvt_pk_bf16(float lo, float hi) { unsigned r; asm volatile("v_cvt_pk_bf16_f32 %0, %1, %2" : "=v"(r) : "v"(lo), "v"(hi)); return r; }
__device__ __forceinline__ float row_rscale(const float* ss, int row) { const f32x4* p = (const f32x4*)(ss + (size_t)row * 16); const f32x4 a = (p[0] + p[1]) + (p[2] + p[3]);
    return __builtin_amdgcn_rsqf(((a[0] + a[1]) + (a[2] + a[3])) * (1.0f / 1024.0f) + 1e-6f); }
template <bool KSS = false> struct EpiBf16PT {
    static constexpr bool PERM = true, AFTER_DRAIN = false;
    bf16_t* O; int ldc; const PG8_LAS float* rst; float* kss; int mrows;
    __device__ __forceinline__ void operator()(const f32x4 (&acc)[2][2][4][2], const Unit& u, int wr, int wc, int fr, int fq) const {
        const int row0 = u.pm * BM + wr * 64 + fr, col0 = u.pn * BM + wc * 32 + 8 * fq;
        const bool kt = KSS && u.pn >= 4 && u.pn < 8;
#pragma unroll
        for (int ai = 0; ai < 2; ++ai)
#pragma unroll
            for (int m = 0; m < 4; ++m) { const int row = row0 + ai * HALF + m * 16; bf16_t* rowp = O + (size_t)row * ldc + col0; const float rs = rst[u.idx * 256 + wr * 64 + fr + ai * HALF + m * 16];
#pragma unroll
                for (int bj = 0; bj < 2; ++bj) { const f32x4 v0 = acc[ai][bj][m][0] * rs, v1 = acc[ai][bj][m][1] * rs;
                    u32x4 w; w.x = cvt_pk_bf16(v0[0], v0[1]); w.y = cvt_pk_bf16(v0[2], v0[3]); w.z = cvt_pk_bf16(v1[0], v1[1]); w.w = cvt_pk_bf16(v1[2], v1[3]);
                    *(u32x4*)(rowp + bj * HALF) = w;
                    if (kt) { float q = ((v0[0] * v0[0] + v0[1] * v0[1]) + (v0[2] * v0[2] + v0[3] * v0[3])) + ((v1[0] * v1[0] + v1[1] * v1[1]) + (v1[2] * v1[2] + v1[3] * v1[3]));
                        q += __shfl_xor(q, 16); q += __shfl_xor(q, 32);
                        if (fq == 0) kss[(size_t)((u.pn - 4) * 8 + bj * 4 + wc) * mrows + row] = q; } }
                if (KSS) asm volatile("" ::: "memory"); }
    }
};
typedef EpiBf16PT<false> EpiBf16P;
__device__ __forceinline__ float silu_mul(float g, float u) { return g * __builtin_amdgcn_rcpf(1.0f + __expf(-g)) * u; }
struct EpiSwiGLU {
    static constexpr bool PERM = true, AFTER_DRAIN = false;
    bf16_t* H; int ldh; const PG8_LAS float* rst;
    __device__ __forceinline__ void operator()(const f32x4 (&acc)[2][2][4][2], const Unit& u, int wr, int wc, int fr, int fq) const {
        const int row0 = u.pm * BM + wr * 64 + fr, col0 = u.pn * HALF + wc * 32 + 8 * fq;
#pragma unroll
        for (int ai = 0; ai < 2; ++ai)
#pragma unroll
            for (int m = 0; m < 4; ++m) { bf16_t* rowp = H + (size_t)(row0 + ai * HALF + m * 16) * ldh + col0; const float rs = rst[u.idx * 256 + wr * 64 + fr + ai * HALF + m * 16];
                const f32x4 g0 = acc[ai][0][m][0] * rs, g1 = acc[ai][0][m][1] * rs, u0 = acc[ai][1][m][0] * rs, u1 = acc[ai][1][m][1] * rs;
                u32x4 w; w.x = cvt_pk_bf16(silu_mul(g0[0], u0[0]), silu_mul(g0[1], u0[1])); w.y = cvt_pk_bf16(silu_mul(g0[2], u0[2]), silu_mul(g0[3], u0[3]));
                w.z = cvt_pk_bf16(silu_mul(g1[0], u1[0]), silu_mul(g1[1], u1[1])); w.w = cvt_pk_bf16(silu_mul(g1[2], u1[2]), silu_mul(g1[3], u1[3]));
                *(u32x4*)rowp = w; }
    }
};
typedef unsigned u32x2 __attribute__((ext_vector_type(2)));
struct EpiShortIn {
    static constexpr bool PERM = true, AFTER_DRAIN = false;
    bf16_t* CU; bf16_t* BG; const PG8_LAS float* rst;
    __device__ __forceinline__ void operator()(const f32x4 (&acc)[2][2][4][2], const Unit& u, int wr, int wc, int fr, int fq) const {
        const int row0 = u.pm * BM + wr * 64 + fr;
#pragma unroll
        for (int ai = 0; ai < 2; ++ai)
#pragma unroll
            for (int m = 0; m < 4; ++m) { const int row = row0 + ai * HALF + m * 16; const float rs = rst[u.idx * 256 + wr * 64 + fr + ai * HALF + m * 16];
                if (u.pn < 8) { const float r2 = rs * rs; const f32x4 c0 = acc[ai][0][m][0], c1 = acc[ai][0][m][1], u0 = acc[ai][1][m][0], u1 = acc[ai][1][m][1];
                    u32x4 w; w.x = cvt_pk_bf16(c0[0] * u0[0] * r2, c0[1] * u0[1] * r2); w.y = cvt_pk_bf16(c0[2] * u0[2] * r2, c0[3] * u0[3] * r2);
                    w.z = cvt_pk_bf16(c1[0] * u1[0] * r2, c1[1] * u1[1] * r2); w.w = cvt_pk_bf16(c1[2] * u1[2] * r2, c1[3] * u1[3] * r2);
                    *(u32x4*)(CU + (size_t)row * 1024 + u.pn * HALF + wc * 32 + 8 * fq) = w; }
                else { bf16_t* rowp = BG + (size_t)row * 1024 + (u.pn - 8) * BM + wc * 32 + 8 * fq;
#pragma unroll
                    for (int bj = 0; bj < 2; ++bj) { const f32x4 v0 = acc[ai][bj][m][0] * rs, v1 = acc[ai][bj][m][1] * rs;
                        u32x4 w; w.x = cvt_pk_bf16(v0[0], v0[1]); w.y = cvt_pk_bf16(v0[2], v0[3]); w.z = cvt_pk_bf16(v1[0], v1[1]); w.w = cvt_pk_bf16(v1[2], v1[3]);
                        *(u32x4*)(rowp + bj * HALF) = w; } } }
    }
};
template <bool LAST = false> struct EpiResNormT {
    static constexpr bool PERM = true, AFTER_DRAIN = false;
    float* out; bf16_t* xb; float* ss; int ldc;
    __device__ __forceinline__ void operator()(const f32x4 (&acc)[2][2][4][2], const Unit& u, int wr, int wc, int fr, int fq) const {
        const int row0 = u.pm * BM + wr * 64 + fr, col0 = u.pn * BM + wc * 32 + 8 * fq;
#pragma unroll
        for (int ai = 0; ai < 2; ++ai)
#pragma unroll
            for (int m = 0; m < 4; ++m) { const int row = row0 + ai * HALF + m * 16; const size_t off = (size_t)row * ldc + col0; float s = 0.f;
#pragma unroll
                for (int bj = 0; bj < 2; ++bj) { const size_t o = off + bj * HALF; const u32x4 b = *(const u32x4*)(xb + o);
                    f32x4 r0, r1;
                    r0[0] = __uint_as_float(b.x << 16) + acc[ai][bj][m][0][0]; r0[1] = __uint_as_float(b.x & 0xffff0000u) + acc[ai][bj][m][0][1];
                    r0[2] = __uint_as_float(b.y << 16) + acc[ai][bj][m][0][2]; r0[3] = __uint_as_float(b.y & 0xffff0000u) + acc[ai][bj][m][0][3];
                    r1[0] = __uint_as_float(b.z << 16) + acc[ai][bj][m][1][0]; r1[1] = __uint_as_float(b.z & 0xffff0000u) + acc[ai][bj][m][1][1];
                    r1[2] = __uint_as_float(b.w << 16) + acc[ai][bj][m][1][2]; r1[3] = __uint_as_float(b.w & 0xffff0000u) + acc[ai][bj][m][1][3];
                    if (LAST) { *(f32x4*)(out + o) = r0; *(f32x4*)(out + o + 4) = r1; }
                    else { s += ((r0[0] * r0[0] + r0[1] * r0[1]) + (r0[2] * r0[2] + r0[3] * r0[3])) + ((r1[0] * r1[0] + r1[1] * r1[1]) + (r1[2] * r1[2] + r1[3] * r1[3]));
                        u32x4 w; w.x = cvt_pk_bf16(r0[0], r0[1]); w.y = cvt_pk_bf16(r0[2], r0[3]); w.z = cvt_pk_bf16(r1[0], r1[1]); w.w = cvt_pk_bf16(r1[2], r1[3]); *(u32x4*)(xb + o) = w; } }
                if (!LAST) { s += __shfl_xor(s, 16); s += __shfl_xor(s, 32); if (fq == 0) ss[(size_t)row * 16 + u.pn * 4 + wc] = s; }
                asm volatile("" ::: "memory"); }
    }
};
typedef EpiResNormT<false> EpiResNorm;
template <class Epi, class Sched, bool ALIGN_EPI = false, bool SP2 = false>
__device__ __forceinline__ void gemm_phase(PG8_LAS unsigned char* lds, const Gemm g, const Sched& S, const Epi& E) {
    const int tid = threadIdx.x, wid = __builtin_amdgcn_readfirstlane(tid >> 6), lane = tid & 63, wr = wid >> 2, wc = wid & 3, fr = lane & 15, fq = lane >> 4;
    const int K = g.K, nt = K / BK;
    unsigned voffA[2], voffB[2];
#pragma unroll
    for (int i = 0; i < 2; ++i) { int R, C; stage_rc(tid * 16 + i * 8192, R, C); const int Rb = Epi::PERM ? ((R & ~31) + perm32(R & 31)) : R;
        voffA[i] = (unsigned)(R * K + C) * 2u; voffB[i] = (unsigned)(Rb * K + C) * 2u; }
    const size_t kstep = (size_t)(BK * 2);
    const size_t hstep = (size_t)HALF * K * 2;
    const size_t tstep = 2 * hstep;
    const unsigned ldsw = (unsigned)wid * 1024u;
    const int aoff = lds_byte(wr * 64 + fr, fq * 8), boff = lds_byte(wc * 32 + fr, fq * 8);
#define PG8_SA(b, h) (((b) * 2 + (h)) * HTB)
#define PG8_SB(b, h) ((4 + (b) * 2 + (h)) * HTB)
#define PG8_STAGE(bufoff, gbase, voff) do { _Pragma("unroll") for (int _i = 0; _i < 2; ++_i) \
        __builtin_amdgcn_global_load_lds((const unsigned*)((const char*)(gbase) + (voff)[_i]), (PG8_LAS unsigned*)(lds + (bufoff) + ldsw + _i * 8192), 16, 0, 0); } while (0)
#define PG8_LDA(dst, b, h) do { _Pragma("unroll") for (int m = 0; m < 4; ++m) _Pragma("unroll") for (int k = 0; k < 2; ++k) dst[m][k] = *(const PG8_LAS bf16x8*)(lds + PG8_SA(b, h) + aoff + m * 2048 + k * 1024); } while (0)
#define PG8_LDB(dst, b, h) do { _Pragma("unroll") for (int n = 0; n < 2; ++n) _Pragma("unroll") for (int k = 0; k < 2; ++k) dst[n][k] = *(const PG8_LAS bf16x8*)(lds + PG8_SB(b, h) + boff + n * 2048 + k * 1024); } while (0)
#define PG8_MMA(ai, bj, At, Bt) do { __builtin_amdgcn_s_setprio(1); _Pragma("unroll") for (int m = 0; m < 4; ++m) _Pragma("unroll") for (int n = 0; n < 2; ++n) _Pragma("unroll") for (int k = 0; k < 2; ++k) \
        acc[ai][bj][m][n] = __builtin_amdgcn_mfma_f32_16x16x32_bf16(Bt[n][k], At[m][k], acc[ai][bj][m][n], 0, 0, 0); __builtin_amdgcn_s_setprio(0); } while (0)
#define PG8_WAIT_V(n) asm volatile("s_waitcnt vmcnt(" #n ")" ::: "memory")
#define PG8_WAIT_L(n) asm volatile("s_waitcnt lgkmcnt(" #n ")" ::: "memory")
#define PG8_BAR __builtin_amdgcn_s_barrier()
#define PG8_SCHED __builtin_amdgcn_sched_barrier(0)
    Unit cur, nxt; int ui = 0;
    if (!S.next(0, cur)) return;
    f32x4 acc[2][2][4][2];
#pragma unroll
    for (int a = 0; a < 2; ++a)
#pragma unroll
        for (int b = 0; b < 2; ++b)
#pragma unroll
            for (int m = 0; m < 4; ++m)
#pragma unroll
                for (int n = 0; n < 2; ++n) acc[a][b][m][n] = (f32x4){0.f, 0.f, 0.f, 0.f};
    bf16x8 At[4][2], B0[2][2], B1[2][2];
    const char* cA = (const char*)g.A + (size_t)cur.pm * tstep; const char* cB = (const char*)g.Bt + (size_t)cur.pn * tstep;
    S.a_ready(cur);
    if constexpr (SP2) {
        PG8_STAGE(PG8_SB(0, 0), cB, voffB); PG8_STAGE(PG8_SB(0, 1), cB + hstep, voffB); PG8_STAGE(PG8_SA(0, 0), cA, voffA); PG8_STAGE(PG8_SA(0, 1), cA + hstep, voffA);
        if (wr == 1) PG8_BAR;
        PG8_WAIT_V(2); PG8_BAR;
        PG8_STAGE(PG8_SB(1, 0), cB + kstep, voffB); PG8_STAGE(PG8_SA(1, 0), cA + kstep, voffA); PG8_STAGE(PG8_SB(1, 1), cB + hstep + kstep, voffB);
        PG8_WAIT_V(6); PG8_BAR;
    } else {
        PG8_STAGE(PG8_SB(0, 0), cB, voffB); PG8_STAGE(PG8_SA(0, 0), cA, voffA); PG8_STAGE(PG8_SB(0, 1), cB + hstep, voffB); PG8_STAGE(PG8_SA(0, 1), cA + hstep, voffA);
        if (wr == 1) PG8_BAR;
        PG8_WAIT_V(4); PG8_BAR;
        PG8_STAGE(PG8_SB(1, 0), cB + kstep, voffB); PG8_STAGE(PG8_SA(1, 0), cA + kstep, voffA); PG8_STAGE(PG8_SB(1, 1), cB + hstep + kstep, voffB);
        PG8_WAIT_V(6); PG8_BAR;
    }
    for (;;) {
        const bool has_next = S.next(ui + 1, nxt);
        const char* nA = has_next ? (const char*)g.A + (size_t)nxt.pm * tstep : cA; const char* nB = has_next ? (const char*)g.Bt + (size_t)nxt.pn * tstep : cB;
        for (int t = 0; t < nt; t += 2) {
            const bool last = (t == nt - 2);
            const char* a1 = cA + (size_t)(t + 1) * kstep;
            const char* a2 = last ? nA : cA + (size_t)(t + 2) * kstep; const char* b2 = last ? nB : cB + (size_t)(t + 2) * kstep;
            const char* a3 = a2 + kstep; const char* b3 = b2 + kstep;
            if (last && has_next) S.a_ready(nxt);
            if constexpr (SP2) {
            PG8_LDB(B0, 0, 0); PG8_LDB(B1, 0, 1); PG8_SCHED; PG8_LDA(At, 0, 0); PG8_STAGE(PG8_SA(1, 1), a1 + hstep, voffA);
            PG8_WAIT_V(8); PG8_WAIT_L(0); PG8_BAR; PG8_MMA(0, 0, At, B0); PG8_MMA(0, 1, At, B1); PG8_BAR; PG8_SCHED;
            PG8_LDA(At, 0, 1); PG8_STAGE(PG8_SB(0, 0), b2, voffB); PG8_STAGE(PG8_SB(0, 1), b2 + hstep, voffB); PG8_STAGE(PG8_SA(0, 0), a2, voffA);
            PG8_WAIT_V(8); PG8_WAIT_L(0); PG8_BAR; PG8_MMA(1, 0, At, B0); PG8_MMA(1, 1, At, B1); PG8_BAR; PG8_SCHED;
            PG8_LDB(B0, 1, 0); PG8_LDB(B1, 1, 1); PG8_SCHED; PG8_LDA(At, 1, 0); PG8_STAGE(PG8_SA(0, 1), a2 + hstep, voffA);
            PG8_WAIT_V(8); PG8_WAIT_L(0); PG8_BAR; PG8_MMA(0, 0, At, B0); PG8_MMA(0, 1, At, B1); PG8_BAR; PG8_SCHED;
            PG8_LDA(At, 1, 1); PG8_STAGE(PG8_SB(1, 0), b3, voffB); PG8_STAGE(PG8_SB(1, 1), b3 + hstep, voffB); PG8_STAGE(PG8_SA(1, 0), a3, voffA);
            PG8_WAIT_V(8); PG8_WAIT_L(0); PG8_BAR; PG8_MMA(1, 0, At, B0); PG8_MMA(1, 1, At, B1); PG8_BAR; PG8_SCHED;
            } else {
            PG8_LDB(B0, 0, 0); PG8_SCHED; PG8_LDA(At, 0, 0); PG8_STAGE(PG8_SA(1, 1), a1 + hstep, voffA);
            PG8_WAIT_L(8); PG8_BAR; PG8_WAIT_L(0); PG8_MMA(0, 0, At, B0); PG8_BAR; PG8_SCHED;
            PG8_LDB(B1, 0, 1); PG8_STAGE(PG8_SB(0, 0), b2, voffB);
            PG8_BAR; PG8_WAIT_L(0); PG8_MMA(0, 1, At, B1); PG8_BAR;
            PG8_LDA(At, 0, 1); PG8_STAGE(PG8_SA(0, 0), a2, voffA);
            PG8_BAR; PG8_WAIT_L(0); PG8_MMA(1, 0, At, B0); PG8_BAR; PG8_SCHED;
            PG8_STAGE(PG8_SB(0, 1), b2 + hstep, voffB);
            PG8_WAIT_V(6); PG8_BAR; PG8_MMA(1, 1, At, B1); PG8_BAR;
            PG8_LDB(B0, 1, 0); PG8_SCHED; PG8_LDA(At, 1, 0); PG8_STAGE(PG8_SA(0, 1), a2 + hstep, voffA);
            PG8_WAIT_L(8); PG8_BAR; PG8_WAIT_L(0); PG8_MMA(0, 0, At, B0); PG8_BAR; PG8_SCHED;
            PG8_LDB(B1, 1, 1); PG8_STAGE(PG8_SB(1, 0), b3, voffB);
            PG8_BAR; PG8_WAIT_L(0); PG8_MMA(0, 1, At, B1); PG8_BAR;
            PG8_LDA(At, 1, 1); PG8_STAGE(PG8_SA(1, 0), a3, voffA);
            PG8_BAR; PG8_WAIT_L(0); PG8_MMA(1, 0, At, B0); PG8_BAR; PG8_SCHED;
            PG8_STAGE(PG8_SB(1, 1), b3 + hstep, voffB);
            PG8_WAIT_V(6); PG8_BAR; PG8_MMA(1, 1, At, B1); PG8_BAR;
            }
        }
        if constexpr (ALIGN_EPI) { if (wr == 0) PG8_BAR; }
        if constexpr (!Epi::AFTER_DRAIN) { E(acc, cur, wr, wc, fr, fq); S.done(cur); }
        if (!has_next) break;
#pragma unroll
        for (int a = 0; a < 2; ++a)
#pragma unroll
            for (int b = 0; b < 2; ++b)
#pragma unroll
                for (int m = 0; m < 4; ++m)
#pragma unroll
                    for (int n = 0; n < 2; ++n) acc[a][b][m][n] = (f32x4){0.f, 0.f, 0.f, 0.f};
        cur = nxt; cA = nA; cB = nB; ++ui;
        if constexpr (ALIGN_EPI) { if (wr == 1) PG8_BAR; }
    }
    PG8_WAIT_V(0);
    if constexpr (!ALIGN_EPI) { if (wr == 0) PG8_BAR; }
    PG8_BAR;
    if constexpr (Epi::AFTER_DRAIN) { E.fused(acc, cur, wr, wc, fr, fq, lds, wid, lane); S.done(cur); }
#undef PG8_SA
#undef PG8_SB
#undef PG8_STAGE
#undef PG8_LDA
#undef PG8_LDB
#undef PG8_MMA
#undef PG8_WAIT_V
#undef PG8_WAIT_L
#undef PG8_BAR
#undef PG8_SCHED
}
}

#ifndef MK_N_LAUNCHES
#define MK_N_LAUNCHES 1
#endif
constexpr int NB = 16, SEQ = 2048, DM = 1024, MTOK = NB * SEQ, NQKV = 3072, FFH = 2816, NW13 = 2 * FFH, NLAYER = 4;
constexpr float RMS_EPS = 1e-6f;
constexpr int NWAVES = 8, NTHREADS = 512;
constexpr size_t MiB = 1u << 20;
constexpr size_t WS_W = 1 * MiB, W_LAYER = 49 * MiB / 2;
constexpr size_t W_IN = 0, W_OUT = 6 * MiB, W_13 = 8 * MiB, W_2 = 19 * MiB;
constexpr size_t WS_SS = 439 * MiB;
constexpr size_t WS_HID = 100 * MiB;
constexpr size_t WS_KF = 102 * MiB;
constexpr int KF_LEN = 4112;
constexpr size_t WS_XN = 119 * MiB;
constexpr size_t WS_MIXO = 183 * MiB;
constexpr size_t WS_BIG = 247 * MiB;
constexpr size_t WS_VT = 441 * MiB;
constexpr size_t WS_KSS = 505 * MiB;
constexpr size_t WS_END = 509 * MiB;
constexpr int MISC_OFF = 163776, RST_OFF = 131072;
constexpr size_t WS_BAR = 16384, CTL_ZERO_BYTES = 65536;
constexpr int LDS_BYTES = 163840;
#define LAS __attribute__((address_space(3)))
typedef unsigned short bf16;
typedef unsigned v4u __attribute__((ext_vector_type(4)));
typedef unsigned v2u __attribute__((ext_vector_type(2)));
typedef float f32x4 __attribute__((ext_vector_type(4)));
typedef short bf16x8 __attribute__((ext_vector_type(8)));
typedef short v4i16_t __attribute__((ext_vector_type(4)));
#define LDS_WAIT() asm volatile("s_waitcnt lgkmcnt(0)" ::: "memory")
typedef float f32x2_cv __attribute__((ext_vector_type(2))); typedef __bf16 bf16x2_cv __attribute__((ext_vector_type(2)));
__device__ __forceinline__ unsigned pk2c(float lo, float hi) { const f32x2_cv v = {lo, hi}; const bf16x2_cv b = __builtin_convertvector(v, bf16x2_cv); return __builtin_bit_cast(unsigned, b); }
__device__ __forceinline__ unsigned pk2(float lo, float hi) { return pg8::cvt_pk_bf16(lo, hi); }
__device__ __forceinline__ float bflo(unsigned w) { return __uint_as_float(w << 16); }
__device__ __forceinline__ float bfhi(unsigned w) { return __uint_as_float(w & 0xffff0000u); }
__device__ __forceinline__ float bf2f(unsigned short b) { return __uint_as_float(((unsigned)b) << 16); }
__device__ __forceinline__ unsigned short f2bf(float f) { return (unsigned short)(pk2(f, 0.f) & 0xffffu); }
__device__ __forceinline__ float wave_sum(float v) {
#pragma unroll
    for (int o = 1; o < 64; o <<= 1) v += __shfl_xor(v, o);
    return v;
}

#define RLX_AGENT __ATOMIC_RELAXED, __HIP_MEMORY_SCOPE_AGENT
#define XB_TMO      128
#define XB_XCNT(j)  (256  + 64 * (j))
#define XB_XSUB(j)  (1280 + 64 * (j))
#define XB_XGEN(j)  (2304 + 64 * (j))
#define XB_TOP      3328
#define XB_TOPGEN   3392
#define XCD_BAR_WORDS 3456
#define XB_SPIN_CAP (1u << 18)

__device__ __forceinline__ unsigned xb_ld(unsigned* p)              { return __hip_atomic_load(p, __ATOMIC_RELAXED, __HIP_MEMORY_SCOPE_AGENT); }
__device__ __forceinline__ unsigned xb_add(unsigned* p, unsigned v) { return __hip_atomic_fetch_add(p, v, __ATOMIC_RELAXED, __HIP_MEMORY_SCOPE_AGENT); }
__device__ __forceinline__ unsigned xb_xcc_id() { return (unsigned)__builtin_amdgcn_s_getreg((3 << 11) | 20) & 0xFu; }
#define XB_SPIN(cond, bar) do { unsigned _sp = 0; while (cond) { __builtin_amdgcn_s_sleep(1); \
    if ((++_sp & 255u) == 0u) { if (xb_ld(&(bar)[XB_TMO])) break; if (_sp > XB_SPIN_CAP) { atomicAdd(&(bar)[XB_TMO], 1u); break; } } } } while (0)

struct XcdBarrier {
    unsigned* bar; unsigned x;
    volatile LAS unsigned* st;
};

__device__ __forceinline__ XcdBarrier xcd_barrier_post(unsigned* bar, volatile LAS unsigned* st) {
    XcdBarrier b; b.bar = bar; b.x = xb_xcc_id(); b.st = st;
    if (threadIdx.x == 0) (void)xb_add(&bar[XB_XCNT(b.x)], 1u);
    return b;
}
__device__ __forceinline__ void xcd_barrier_complete(unsigned* bar, unsigned x, unsigned& nloc, unsigned& nx) {
    const unsigned G = gridDim.x * gridDim.y * gridDim.z;
    unsigned sum, cnt, mine, sp = 0u;
    for (;;) {
        sum = 0u; cnt = 0u; mine = 0u;
#pragma unroll
        for (unsigned j = 0; j < 16; ++j) { const unsigned c = xb_ld(&bar[XB_XCNT(j)]); sum += c; cnt += (c > 0u) ? 1u : 0u; mine = (j == x) ? c : mine; }
        if (sum == G) break;
        __builtin_amdgcn_s_sleep(1);
        if ((++sp & 255u) == 0u) { if (xb_ld(&bar[XB_TMO])) break; if (sp > XB_SPIN_CAP) { atomicAdd(&bar[XB_TMO], 1u); break; } }
    }
    nloc = mine > 0u ? mine : 1u; nx = cnt > 0u ? cnt : 1u;
}

__device__ __forceinline__ void xcd_barrier(const XcdBarrier& b) {
    asm volatile("s_waitcnt vmcnt(0)" ::: "memory");
    __syncthreads();
    if (threadIdx.x == 0) {
        unsigned* bar = b.bar;
        __builtin_amdgcn_s_waitcnt(0);
        unsigned nloc = b.st[0], nx = b.st[1];
        if (nloc == 0u) { xcd_barrier_complete(bar, b.x, nloc, nx); b.st[0] = nloc; b.st[1] = nx; }
        const unsigned old = xb_add(&bar[XB_XSUB(b.x)], 1u);
        const unsigned gen = old / nloc;
        if (old + 1u == (gen + 1u) * nloc) {
            __builtin_amdgcn_fence(__ATOMIC_RELEASE, "agent");
            asm volatile("s_waitcnt vmcnt(0)" ::: "memory");
            const unsigned og = xb_add(&bar[XB_TOP], 1u);
            const unsigned tg = og / nx;
            if (og + 1u == (tg + 1u) * nx) xb_add(&bar[XB_TOPGEN], 1u);
            else XB_SPIN(xb_ld(&bar[XB_TOPGEN]) == tg, bar);
            __builtin_amdgcn_fence(__ATOMIC_ACQUIRE, "agent");
            xb_add(&bar[XB_XGEN(b.x)], 1u);
            asm volatile("s_waitcnt vmcnt(0)" ::: "memory");
        } else {
            XB_SPIN(xb_ld(&bar[XB_XGEN(b.x)]) == gen, bar);
            __builtin_amdgcn_fence(__ATOMIC_ACQUIRE, "agent");
            asm volatile("s_waitcnt vmcnt(0)" ::: "memory");
        }
    }
    __syncthreads();
}

__device__ __forceinline__ void transpose_item(const float* __restrict__ W, int K, int N, const float* __restrict__ gain, bf16* WT, int dst_row0, LAS float* scr, int k0, int n0, int lane) {
    float tv[32];
#pragma unroll
    for (int i = 0; i < 32; ++i) { const int kk = 2 * i + (lane >> 5); tv[i] = W[(size_t)(k0 + kk) * N + n0 + (lane & 31)]; }
#pragma unroll
    for (int i = 0; i < 32; ++i) { const int kk = 2 * i + (lane >> 5); float v = tv[i]; if (gain) v *= gain[k0 + kk]; scr[kk * 33 + (lane & 31)] = v; }
    LDS_WAIT();
    const int c = lane & 7;
#pragma unroll
    for (int j = 0; j < 4; ++j) { const int n = (lane >> 3) + 8 * j; const LAS float* s = scr + (8 * c) * 33 + n;
        v4u o; o.x = pk2(s[0 * 33], s[1 * 33]); o.y = pk2(s[2 * 33], s[3 * 33]); o.z = pk2(s[4 * 33], s[5 * 33]); o.w = pk2(s[6 * 33], s[7 * 33]);
        *(v4u*)(WT + (size_t)(dst_row0 + n) * K + k0 + 8 * c) = o; }
    LDS_WAIT();
}

struct Args { const float* in[24]; float* out; unsigned char* ws; int ph_lo, ph_hi; };

__device__ __forceinline__ void phase_prologue(const Args& a, LAS unsigned char* lds, int gw, int ngw, int wave, int lane) {
    LAS float* scr = (LAS float*)(lds + wave * 16384);
    constexpr int I_IN = 16 * 96, I_OUT = 16 * 32, I_13 = 16 * 176, I_2 = 44 * 32, I_L = I_IN + I_OUT + I_13 + I_2;
    for (int it = gw; it < NLAYER * I_L; it += ngw) {
        const int L = it / I_L; int r = it - L * I_L;
        const float* win = (L == 1) ? a.in[6] : (L == 2) ? a.in[11] : (L == 0 ? a.in[3] : a.in[3] + (size_t)DM * NQKV);
        const float* wout = (L == 1) ? a.in[10] : (L == 2) ? a.in[21] : (L == 0 ? a.in[5] : a.in[5] + (size_t)DM * DM);
        bf16* wl = (bf16*)(a.ws + WS_W + (size_t)L * W_LAYER);
        if (r < I_IN) { const int kb = r / 96, nb = r % 96, n0 = 32 * nb; int dst = n0;
            if (L % 3 == 0) { const int j = n0 & 1023; dst = (n0 < DM) ? 2 * DM + n0 : 256 * (j / 128) + (n0 < 2 * DM ? 0 : 128) + (j % 128); }
            transpose_item(win, DM, NQKV, a.in[1] + L * DM, wl + W_IN / 2, dst, scr, 64 * kb, n0, lane); continue; }
        r -= I_IN;
        if (r < I_OUT) { const int kb = r / 32, nb = r % 32; transpose_item(wout, DM, DM, nullptr, wl + W_OUT / 2, 32 * nb, scr, 64 * kb, 32 * nb, lane); continue; }
        r -= I_OUT;
        if (r < I_13) { const int kb = r / 176, nb = r % 176, n0 = 32 * nb, half = n0 / FFH, j = n0 % FFH, dst = 256 * (j / 128) + 128 * half + (j % 128);
            transpose_item(a.in[22] + (size_t)L * DM * NW13, DM, NW13, a.in[2] + L * DM, wl + W_13 / 2, dst, scr, 64 * kb, n0, lane); continue; }
        r -= I_13;
        { const int kb = r / 32, nb = r % 32; transpose_item(a.in[23] + (size_t)L * FFH * DM, FFH, DM, nullptr, wl + W_2 / 2, 32 * nb, scr, 64 * kb, 32 * nb, lane); }
    }
    const float* w1 = a.in[14]; const float* b1 = a.in[15]; const float* w2 = a.in[16]; const float* b2 = a.in[17]; const float* fr = a.in[19];
    float* hid = (float*)(a.ws + WS_HID);
    for (int t = gw; t < SEQ; t += ngw) {
        float zv = 0.f;
        if (lane == 0) zv = (float)t / (float)(SEQ - 1);
        else if (lane <= 32) { const int k = (lane - 1) & 15; const float band = 1e-4f + (float)k * ((15.0f - 1e-4f) / 15.0f);
            const float ang = ((6.283185307179586f * (float)t) / (float)SEQ) * band; zv = (lane <= 16) ? cosf(ang) : -sinf(ang); }
        float a1 = b1[lane];
        for (int e = 0; e < 33; ++e) a1 += __shfl(zv, e) * w1[e * 64 + lane];
        const float f = fr[lane];
        const float h1 = sinf(f * a1);
        float a2 = b2[lane];
        for (int i = 0; i < 64; ++i) a2 += __shfl(h1, i) * w2[i * 64 + lane];
        hid[t * 64 + lane] = sinf(f * a2);
    }
}

__device__ __forceinline__ void phase_filters(const Args& a, LAS unsigned char* lds, int vcu, int G, int wave, int lane, int tid) {
    const float* hid = (const float*)(a.ws + WS_HID); const float* w3 = a.in[18]; bf16* KF = (bf16*)(a.ws + WS_KF);
    constexpr int HS = 272;
    for (int p0 = vcu * NWAVES; p0 < 2 * DM; p0 += G * NWAVES) {
        const int p = p0 + wave, o = p >> 10, d = p & 1023, cf = o * 2048 + d, cr = cf + 1024;
        const float delta = 4.605170185988091f * (1.0f / 1.5f + (float)d * ((1.0f / 0.3f - 1.0f / 1.5f) / 1023.0f));
        bf16* kf = KF + (size_t)p * KF_LEN;
        LAS float* wcol = (LAS float*)(lds + 17408 + NWAVES * 16384 + wave * 512);
        wcol[lane] = w3[(size_t)lane * 4096 + cf]; wcol[64 + lane] = w3[(size_t)lane * 4096 + cr];
        float asum = 0.f;
        LAS float* vals = (LAS float*)(lds + 17408 + wave * 16384);
        v4u hreg[2];
#pragma unroll
        for (int i = 0; i < 2; ++i) { const int idx = tid + 512 * i; hreg[i] = *(const v4u*)(hid + (size_t)(idx >> 4) * 64 + (idx & 15) * 4); }
#pragma unroll 1
        for (int tb = 0; tb < 32; ++tb) {
            __syncthreads();
#pragma unroll
            for (int i = 0; i < 2; ++i) { const int idx = tid + 512 * i; *(LAS v4u*)(lds + (idx >> 4) * HS + (idx & 15) * 16) = hreg[i]; }
            if (tb < 31) {
#pragma unroll
                for (int i = 0; i < 2; ++i) { const int idx = tid + 512 * i; hreg[i] = *(const v4u*)(hid + (size_t)((tb + 1) * 64 + (idx >> 4)) * 64 + (idx & 15) * 4); } }
            __syncthreads();
            const int t = tb * 64 + lane; const LAS f32x4* hr = (const LAS f32x4*)(lds + lane * HS);
            float af = 0.f, ar = 0.f;
#pragma unroll
            for (int j4 = 0; j4 < 16; ++j4) { const f32x4 h = hr[j4]; const f32x4 a4 = ((const LAS f32x4*)wcol)[j4], b4 = ((const LAS f32x4*)wcol)[16 + j4];
                af += h[0] * a4[0] + h[1] * a4[1] + h[2] * a4[2] + h[3] * a4[3];
                ar += h[0] * b4[0] + h[1] * b4[1] + h[2] * b4[2] + h[3] * b4[3]; }
            const float dec = __expf(-((float)t / (float)(SEQ - 1)) * delta);
            af *= dec; ar *= dec; vals[(2 * tb) * 64 + lane] = af; vals[(2 * tb + 1) * 64 + lane] = ar;
            asum += (t == 0) ? fabsf(af + ar) : (fabsf(af) + fabsf(ar));
        }
        const float inv = 1.0f / wave_sum(asum);
#pragma unroll 4
        for (int tb = 0; tb < 32; ++tb) { const int t = tb * 64 + lane; const float vf = vals[(2 * tb) * 64 + lane], vr = vals[(2 * tb + 1) * 64 + lane];
            if (t == 0) kf[2048] = f2bf((vf + vr) * inv); else { kf[2048 - t] = f2bf(vf * inv); kf[2048 + t] = f2bf(vr * inv); } }
        if (lane < 17) kf[lane == 0 ? 0 : 4095 + lane] = 0;
    }
    __syncthreads();
}

__device__ __forceinline__ void phase_norm0(const float* __restrict__ x, bf16* __restrict__ xn, float* __restrict__ ss, int gw, int ngw, int lane) {
    for (int m = gw; m < MTOK; m += ngw) {
        const f32x4* xr = (const f32x4*)(x + (size_t)m * DM) + lane;
        f32x4 v[4]; float s = 0.f;
#pragma unroll
        for (int j = 0; j < 4; ++j) { v[j] = xr[64 * j]; s += (v[j].x * v[j].x + v[j].y * v[j].y) + (v[j].z * v[j].z + v[j].w * v[j].w); }
        s = wave_sum(s);
        if (lane < 16) ss[(size_t)m * 16 + lane] = (lane == 0) ? s : 0.f;
        unsigned long long* o8 = (unsigned long long*)(xn + (size_t)m * DM) + lane;
#pragma unroll
        for (int j = 0; j < 4; ++j) o8[64 * j] = (unsigned long long)pk2(v[j].x, v[j].y) | ((unsigned long long)pk2(v[j].z, v[j].w) << 32);
    }
}

__device__ __forceinline__ void fill_row_scales(const pg8::StaticOrder& S, const float* ss, LAS float* rst, int tid) {
    for (int idx = tid; idx < 11 * 256; idx += NTHREADS) { pg8::Unit u; if (!S.next(idx >> 8, u)) break; rst[idx] = pg8::row_rscale(ss, u.pm * 256 + (idx & 255)); }
    __syncthreads();
}

__device__ __forceinline__ void phase_shortconv(const bf16* __restrict__ cu, const bf16* __restrict__ bg, const float* __restrict__ cw, bf16* __restrict__ outp, int gtid, int ngt) {
    for (int idx = gtid; idx < MTOK * 128; idx += ngt) {
        const int m = idx >> 7, d0 = (idx & 127) * 8, t = m & (SEQ - 1);
        const size_t o = (size_t)m * DM + d0;
        const v4u bv = *(const v4u*)(bg + o), c1 = *(const v4u*)(cu + o);
        v4u c0 = {0u, 0u, 0u, 0u}, c2 = c0;
        if (t > 0) c0 = *(const v4u*)(cu + o - DM);
        if (t < SEQ - 1) c2 = *(const v4u*)(cu + o + DM);
        const f32x4 wa0 = *(const f32x4*)(cw + d0), wa1 = *(const f32x4*)(cw + d0 + 4), wb0 = *(const f32x4*)(cw + DM + d0), wb1 = *(const f32x4*)(cw + DM + d0 + 4),
                    wc0 = *(const f32x4*)(cw + 2 * DM + d0), wc1 = *(const f32x4*)(cw + 2 * DM + d0 + 4);
        v4u ov;
#pragma unroll
        for (int k = 0; k < 4; ++k) {
            const float w0l = (k < 2) ? wa0[2 * k] : wa1[2 * k - 4], w0h = (k < 2) ? wa0[2 * k + 1] : wa1[2 * k - 3];
            const float w1l = (k < 2) ? wb0[2 * k] : wb1[2 * k - 4], w1h = (k < 2) ? wb0[2 * k + 1] : wb1[2 * k - 3];
            const float w2l = (k < 2) ? wc0[2 * k] : wc1[2 * k - 4], w2h = (k < 2) ? wc0[2 * k + 1] : wc1[2 * k - 3];
            const float lo = bflo(bv[k]) * (w0l * bflo(c0[k]) + w1l * bflo(c1[k]) + w2l * bflo(c2[k]));
            const float hi = bfhi(bv[k]) * (w0h * bfhi(c0[k]) + w1h * bfhi(c1[k]) + w2h * bfhi(c2[k]));
            ov[k] = pk2(lo, hi);
        }
        *(v4u*)(outp + o) = ov;
    }
}

__device__ __forceinline__ void norm_frag(const v4u r0, const v4u r1, const LAS float* g, int quad, float extra, bf16x8& f0, bf16x8& f1) {
    float x[16];
#pragma unroll
    for (int k = 0; k < 4; ++k) { x[2 * k] = bflo(r0[k]); x[2 * k + 1] = bfhi(r0[k]); x[8 + 2 * k] = bflo(r1[k]); x[9 + 2 * k] = bfhi(r1[k]); }
    float ss = 0.f;
#pragma unroll
    for (int k = 0; k < 16; ++k) ss += x[k] * x[k];
    ss += __shfl_xor(ss, 16); ss += __shfl_xor(ss, 32);
    const float r = rsqrtf(ss * (1.0f / 64.0f) + RMS_EPS) * extra;
    v4u o0, o1;
#pragma unroll
    for (int k = 0; k < 4; ++k) { o0[k] = pk2c(x[2 * k] * r * g[8 * quad + 2 * k], x[2 * k + 1] * r * g[8 * quad + 2 * k + 1]);
        o1[k] = pk2c(x[8 + 2 * k] * r * g[32 + 8 * quad + 2 * k], x[9 + 2 * k] * r * g[32 + 8 * quad + 2 * k + 1]); }
    f0 = __builtin_bit_cast(bf16x8, o0); f1 = __builtin_bit_cast(bf16x8, o1);
}

__device__ __forceinline__ void norm_frag_r(const v4u r0, const v4u r1, const float (&g)[16], float extra, bf16x8& f0, bf16x8& f1) {
    float x[16];
#pragma unroll
    for (int k = 0; k < 4; ++k) { x[2 * k] = bflo(r0[k]); x[2 * k + 1] = bfhi(r0[k]); x[8 + 2 * k] = bflo(r1[k]); x[9 + 2 * k] = bfhi(r1[k]); }
    float ss = 0.f;
#pragma unroll
    for (int k = 0; k < 16; ++k) ss += x[k] * x[k];
    ss += __shfl_xor(ss, 16); ss += __shfl_xor(ss, 32);
    const float r = rsqrtf(ss * (1.0f / 64.0f) + RMS_EPS) * extra;
    v4u o0, o1;
#pragma unroll
    for (int k = 0; k < 4; ++k) { o0[k] = pk2c(x[2 * k] * (r * g[2 * k]), x[2 * k + 1] * (r * g[2 * k + 1])); o1[k] = pk2c(x[8 + 2 * k] * (r * g[8 + 2 * k]), x[9 + 2 * k] * (r * g[9 + 2 * k])); }
    f0 = __builtin_bit_cast(bf16x8, o0); f1 = __builtin_bit_cast(bf16x8, o1);
}
constexpr int AR_SLOT = 16640, AR_V = 8192, AR_RK = 16384, AR_NSLOT = 9, AR_RPB = AR_NSLOT * AR_SLOT, AR_G = AR_RPB + 1920;
__device__ __forceinline__ int ar_off(int k, int c) { return k * 128 + ((c ^ (k & 7)) << 4); }

constexpr int A3_NSLOT = 8, A3_RPB = A3_NSLOT * AR_SLOT, A3_G = A3_RPB + 1920, A3_CMB = A3_G + 256, A3_CMB_BYTES = 4608;
static_assert(A3_CMB + 4 * A3_CMB_BYTES <= MISC_OFF, "attention LDS map");
__device__ __forceinline__ void phase_natten3(const bf16* qkv, const float* qg, const float* kg, const float* rpb, const float* kss, bf16* outp, LAS unsigned char* lds, int vcu, int G, int wave, int lane, int tid) {
    LAS float* rpb_l = (LAS float*)(lds + A3_RPB); LAS float* g_l = (LAS float*)(lds + A3_G);
    const int n = lane & 15, quad = lane >> 4, qq = (lane >> 2) & 3, p = lane & 3;
    const int cb = wave & 3, kh = wave >> 2;
    LAS unsigned char* cmb = lds + A3_CMB + cb * A3_CMB_BYTES;
    const int lk = (tid >> 3) & 63, lc = tid & 7;
    for (int unit = vcu; unit < NB * 16; unit += G) {
        const int b = unit >> 4, h = unit & 15;
        const bf16* kvbase = qkv + (size_t)b * SEQ * NQKV + DM + h * 64 + lc * 8 + (size_t)lk * NQKV;
        const float* ksbase = kss + (size_t)(2 * h) * MTOK + (size_t)b * SEQ + tid;
        __syncthreads();
        for (int i = tid; i < 15 * 31; i += NTHREADS) rpb_l[i] = rpb[h * (15 * 31) + i] * 1.4426950408889634f;
        if (tid < 64) g_l[tid] = qg[tid] * kg[tid];
        {   v4u rk_[8], rv_[8]; float rs_[8];
#pragma unroll
            for (int rho = 0; rho < 8; ++rho) { const bf16* pp = kvbase + (size_t)rho * 64 * NQKV; rk_[rho] = *(const v4u*)pp; rv_[rho] = *(const v4u*)(pp + DM);
                rs_[rho] = (tid < 64) ? ksbase[rho * 64] + ksbase[MTOK + rho * 64] : 0.f; }
#pragma unroll
            for (int rho = 0; rho < 8; ++rho) { LAS unsigned char* slot = lds + rho * AR_SLOT; *(LAS v4u*)(slot + ar_off(lk, lc)) = rk_[rho]; *(LAS v4u*)(slot + AR_V + ar_off(lk, lc)) = rv_[rho];
                if (tid < 64) *(LAS float*)(slot + AR_RK + 4 * tid) = __builtin_amdgcn_rsqf(rs_[rho] * (1.0f / 64.0f) + RMS_EPS); } }
        int start = cb * 16 - 8; start = start < 0 ? 0 : (start > 32 ? 32 : start);
        const int qc = cb * 16 + n; int cs = qc - 8; cs = cs < 0 ? 0 : (cs > 48 ? 48 : cs);
        const bf16* qbase = qkv + (size_t)(b * SEQ + cb * 16 + n) * NQKV + h * 64 + 8 * quad;
        v4u qr0 = *(const v4u*)qbase, qr1 = *(const v4u*)(qbase + 32);
        __syncthreads();
        float gq[16];
#pragma unroll
        for (int k = 0; k < 8; ++k) { gq[k] = g_l[8 * quad + k]; gq[8 + k] = g_l[32 + 8 * quad + k]; }
        float bia[4][2][4]; int prev_d0 = 1000;
#pragma unroll 1
        for (int r = 0; r < 32; ++r) {
            int rs = r - 4; rs = rs < 0 ? 0 : (rs > 24 ? 24 : rs);
            int rsn = r - 3; rsn = rsn < 0 ? 0 : (rsn > 24 ? 24 : rsn);
            const bool slide = (r < 31) && (rsn != rs);
            v4u nk = {0u, 0u, 0u, 0u}, nv = nk; float nss = 0.f;
            if (slide) { const bf16* pp = kvbase + (size_t)(rs + 8) * 64 * NQKV; nk = *(const v4u*)pp; nv = *(const v4u*)(pp + DM); if (tid < 64) nss = ksbase[(rs + 8) * 64] + ksbase[MTOK + (rs + 8) * 64]; }
            bf16x8 qf0, qf1;
            norm_frag_r(qr0, qr1, gq, 0.125f * 1.4426950408889634f, qf0, qf1);
            if (r < 31) { const bf16* qp = qbase + (size_t)(r + 1) * 64 * NQKV; qr0 = *(const v4u*)qp; qr1 = *(const v4u*)(qp + 32); }
            f32x4 st[4][2];
#pragma unroll
            for (int jj = 0; jj < 4; ++jj) { const LAS unsigned char* slot = lds + ((rs + 4 * kh + jj) & 7) * AR_SLOT;
#pragma unroll
                for (int kt = 0; kt < 2; ++kt) { const int k = start + 16 * kt + n;
                    const bf16x8 kf0 = *(const LAS bf16x8*)(slot + ar_off(k, quad)), kf1 = *(const LAS bf16x8*)(slot + ar_off(k, quad + 4));
                    f32x4 sacc = {0.f, 0.f, 0.f, 0.f};
                    sacc = __builtin_amdgcn_mfma_f32_16x16x32_bf16(kf0, qf0, sacc, 0, 0, 0);
                    sacc = __builtin_amdgcn_mfma_f32_16x16x32_bf16(kf1, qf1, sacc, 0, 0, 0);
                    st[jj][kt] = sacc; } }
            if (rs - r != prev_d0) { prev_d0 = rs - r;
#pragma unroll
                for (int jj = 0; jj < 4; ++jj) { const int dr = rs + 4 * kh + jj - r + 7;
#pragma unroll
                    for (int kt = 0; kt < 2; ++kt)
#pragma unroll
                        for (int i = 0; i < 4; ++i) { const int kc = start + 16 * kt + 4 * quad + i; int dc = kc - qc + 15; dc = dc < 0 ? 0 : (dc > 30 ? 30 : dc);
                            bia[jj][kt][i] = ((kc >= cs) && (kc < cs + 16)) ? rpb_l[dr * 31 + dc] : -3.0e38f; } } }
            float mx = -3.0e38f;
#pragma unroll
            for (int jj = 0; jj < 4; ++jj) { const LAS unsigned char* slot = lds + ((rs + 4 * kh + jj) & 7) * AR_SLOT;
#pragma unroll
                for (int kt = 0; kt < 2; ++kt) { const f32x4 rk = *(const LAS f32x4*)(slot + AR_RK + 4 * (start + 16 * kt + 4 * quad));
#pragma unroll
                    for (int i = 0; i < 4; ++i) { const float v = st[jj][kt][i] * rk[i] + bia[jj][kt][i]; st[jj][kt][i] = v; mx = fmaxf(mx, v); } } }
            mx = fmaxf(mx, __shfl_xor(mx, 16)); mx = fmaxf(mx, __shfl_xor(mx, 32));
            float sum = 0.f;
#pragma unroll
            for (int jj = 0; jj < 4; ++jj)
#pragma unroll
                for (int kt = 0; kt < 2; ++kt)
#pragma unroll
                    for (int i = 0; i < 4; ++i) { const float e = __builtin_amdgcn_exp2f(st[jj][kt][i] - mx); st[jj][kt][i] = e; sum += e; }
            sum += __shfl_xor(sum, 16); sum += __shfl_xor(sum, 32);
            f32x4 oacc[4];
#pragma unroll
            for (int dt = 0; dt < 4; ++dt) oacc[dt] = (f32x4){0.f, 0.f, 0.f, 0.f};
            const int kl = start + 4 * quad + qq;
            v4i16_t lo[4][4], hi[4][4];
#pragma unroll
            for (int jj = 0; jj < 4; ++jj) {
                const unsigned vs = (unsigned)(unsigned long long)(lds + ((rs + 4 * kh + jj) & 7) * AR_SLOT + AR_V) + 8 * (p & 1);
#pragma unroll
                for (int dt = 0; dt < 4; ++dt) { const unsigned a_lo = vs + ar_off(kl, 2 * dt + (p >> 1)), a_hi = vs + ar_off(kl + 16, 2 * dt + (p >> 1));
                    asm volatile("ds_read_b64_tr_b16 %0, %1" : "=v"(lo[jj][dt]) : "v"(a_lo) : "memory");
                    asm volatile("ds_read_b64_tr_b16 %0, %1" : "=v"(hi[jj][dt]) : "v"(a_hi) : "memory"); } }
            bf16x8 pf[4];
#pragma unroll
            for (int jj = 0; jj < 4; ++jj) { const f32x4 s0 = st[jj][0], s1 = st[jj][1];
                v4u pw; pw.x = pk2c(s0[0], s0[1]); pw.y = pk2c(s0[2], s0[3]); pw.z = pk2c(s1[0], s1[1]); pw.w = pk2c(s1[2], s1[3]); pf[jj] = __builtin_bit_cast(bf16x8, pw); }
            asm volatile("s_waitcnt lgkmcnt(0)" ::: "memory"); __builtin_amdgcn_sched_barrier(0);
#pragma unroll
            for (int jj = 0; jj < 4; ++jj)
#pragma unroll
                for (int dt = 0; dt < 4; ++dt) {
                    const bf16x8 vf = (bf16x8){lo[jj][dt][0], lo[jj][dt][1], lo[jj][dt][2], lo[jj][dt][3], hi[jj][dt][0], hi[jj][dt][1], hi[jj][dt][2], hi[jj][dt][3]};
                    oacc[dt] = __builtin_amdgcn_mfma_f32_16x16x32_bf16(vf, pf[jj], oacc[dt], 0, 0, 0);
                }
            if (kh == 1) {
#pragma unroll
                for (int dt = 0; dt < 4; ++dt) *(LAS f32x4*)(cmb + (dt * 64 + lane) * 16) = oacc[dt];
                *(LAS float*)(cmb + 4096 + lane * 8) = mx; *(LAS float*)(cmb + 4096 + lane * 8 + 4) = sum;
            }
            __syncthreads();
            if (kh == 0) {
                const float mb = *(const LAS float*)(cmb + 4096 + lane * 8), lb = *(const LAS float*)(cmb + 4096 + lane * 8 + 4);
                const float M = fmaxf(mx, mb), fa = __builtin_amdgcn_exp2f(mx - M), fb = __builtin_amdgcn_exp2f(mb - M), inv = 1.0f / (sum * fa + lb * fb), wa = fa * inv, wb = fb * inv;
                bf16* op = outp + (size_t)(b * SEQ + r * 64 + cb * 16 + n) * DM + h * 64 + 4 * quad;
#pragma unroll
                for (int dt = 0; dt < 4; ++dt) { const f32x4 ob = *(const LAS f32x4*)(cmb + (dt * 64 + lane) * 16); const f32x4 o = oacc[dt] * wa + ob * wb;
                    v2u w; w.x = pk2c(o[0], o[1]); w.y = pk2c(o[2], o[3]); *(v2u*)(op + 16 * dt) = w; }
            }
            if (slide) { LAS unsigned char* slot = lds + ((rs + 8) & 7) * AR_SLOT; *(LAS v4u*)(slot + ar_off(lk, lc)) = nk; *(LAS v4u*)(slot + AR_V + ar_off(lk, lc)) = nv;
                if (tid < 64) *(LAS float*)(slot + AR_RK + 4 * tid) = __builtin_amdgcn_rsqf(nss * (1.0f / 64.0f) + RMS_EPS); }
            __syncthreads();
        }
    }
}

constexpr int CT_STRIDE = 144, CT_BYTES = 66 * CT_STRIDE;
__device__ __forceinline__ void hyena_pre_fetch(const bf16* big, int id, int lane, v4u (&v)[9]) {
    const int ct = id & 31, tt = id >> 5, b = tt >> 5, t0 = (tt & 31) * 64, c0 = ct * 64;
#pragma unroll
    for (int ps = 0; ps < 9; ++ps) { const int rr = ps * 8 + (lane >> 3), part = lane & 7, t = t0 - 1 + rr;
        v[ps] = (v4u){0u, 0u, 0u, 0u};
        if (rr < 66 && t >= 0 && t < SEQ) v[ps] = *(const v4u*)(big + (size_t)(b * SEQ + t) * NQKV + c0 + part * 8); }
}
__device__ __forceinline__ void phase_hyena_pre(const bf16* big, const float* sw, const float* sb, bf16* VTp, bf16* X1Tp, LAS unsigned char* lds, int gw, int ngw, int wave, int lane) {
    LAS unsigned char* scr = lds + wave * 16384;
    v4u vin[9];
    if (gw < 512 * 32) hyena_pre_fetch(big, gw, lane, vin);
    for (int id = gw; id < 512 * 32; id += ngw) {
        const int ct = id & 31, tt = id >> 5, b = tt >> 5, t0 = (tt & 31) * 64, c0 = ct * 64;
#pragma unroll
        for (int ps = 0; ps < 9; ++ps) { const int rr = ps * 8 + (lane >> 3), part = lane & 7; if (rr < 66) *(LAS v4u*)(scr + rr * CT_STRIDE + part * 16) = vin[ps]; }
        if (id + ngw < 512 * 32) hyena_pre_fetch(big, id + ngw, lane, vin);
        LDS_WAIT();
        const int cg = c0 + lane; const float w0 = sw[cg], w1 = sw[NQKV + cg], w2 = sw[2 * NQKV + cg], bias = sb[cg];
        const LAS unsigned short* col = (const LAS unsigned short*)(scr + 2 * lane);
        float pa = bf2f(col[0]), pb = bf2f(col[CT_STRIDE / 2]);
        v4u o[8];
#pragma unroll
        for (int g8 = 0; g8 < 8; ++g8) { float y[8];
#pragma unroll
            for (int k = 0; k < 8; ++k) { const float pc = bf2f(col[(g8 * 8 + k + 2) * (CT_STRIDE / 2)]); y[k] = w0 * pa + w1 * pb + w2 * pc + bias; pa = pb; pb = pc; }
            o[g8].x = pk2(y[0], y[1]); o[g8].y = pk2(y[2], y[3]); o[g8].z = pk2(y[4], y[5]); o[g8].w = pk2(y[6], y[7]); }
        LDS_WAIT();
#pragma unroll
        for (int g8 = 0; g8 < 8; ++g8) *(LAS v4u*)(scr + lane * CT_STRIDE + g8 * 16) = o[g8];
        LDS_WAIT();
#pragma unroll
        for (int ps = 0; ps < 8; ++ps) { const int cl = ps * 8 + (lane >> 3), part = lane & 7, cc = c0 + cl;
            const v4u v = *(const LAS v4u*)(scr + cl * CT_STRIDE + part * 16);
            bf16* op = (cc < DM ? VTp + (size_t)cc * NB * SEQ : X1Tp + (size_t)(cc - DM) * NB * SEQ) + (size_t)b * SEQ + t0 + part * 8;
            *(v4u*)op = v; }
        LDS_WAIT();
    }
}
constexpr int U_STRIDE = 4112, U_BYTES = 16 * U_STRIDE, CP_OFF = U_BYTES, CP_STRIDE = 8224;
struct HyFilt { v4u a, b; };
__device__ __forceinline__ HyFilt hyena_fetch_filter(const bf16* kf, int tid) { HyFilt f; const v4u* src = (const v4u*)kf; f.a = src[tid]; f.b = (tid < 2) ? src[512 + tid] : (v4u){0u, 0u, 0u, 0u}; return f; }
__device__ __forceinline__ void hyena_put_filter(LAS unsigned char* lds, const HyFilt& f, int tid) {
    *(LAS v4u*)(lds + CP_OFF + 16 * tid) = f.a;
    if (tid < 2) *(LAS v4u*)(lds + CP_OFF + 16 * (512 + tid)) = f.b;
    __syncthreads();
    const v4u lo = *(LAS v4u*)(lds + CP_OFF + 16 * tid), hi = *(LAS v4u*)(lds + CP_OFF + 16 * tid + 16);
    const unsigned s[8] = {lo.x, lo.y, lo.z, lo.w, hi.x, hi.y, hi.z, hi.w};
#pragma unroll
    for (int r = 1; r < 8; ++r) { v4u o;
#pragma unroll
        for (int w = 0; w < 4; ++w) { const int q = w + r / 2; o[w] = (r & 1) ? ((s[q] >> 16) | (s[q + 1] << 16)) : s[q]; }
        *(LAS v4u*)(lds + CP_OFF + r * CP_STRIDE + 16 * tid) = o; }
    __syncthreads();
}
__device__ __forceinline__ void hyena_conv(LAS unsigned char* lds, f32x4 (&acc)[16], unsigned toep0, unsigned uaddr0) {
#pragma unroll
    for (int ti = 0; ti < 16; ++ti) acc[ti] = (f32x4){0.f, 0.f, 0.f, 0.f};
#pragma unroll 1
    for (int k8 = 0; k8 < 8; ++k8) {
        bf16x8 uf[8];
#pragma unroll
        for (int s = 0; s < 8; ++s) uf[s] = *(const LAS bf16x8*)(lds + uaddr0 + 512 * k8 + 64 * s);
#pragma unroll
        for (int x = 0; x < 30; ++x) {
            const bf16x8 tf = *(const LAS bf16x8*)(lds + toep0 + 512 * k8 + 32 * x);
#pragma unroll
            for (int s = 0; s < 8; ++s) { const int ti = 15 + 2 * s - x; if (ti >= 0 && ti < 16) acc[ti] = __builtin_amdgcn_mfma_f32_16x16x32_bf16(tf, uf[s], acc[ti], 0, 0, 0); }
        }
    }
}
__device__ __forceinline__ void phase_hyena(bf16* VT, const bf16* X1T, const bf16* KF, const float* skip, LAS unsigned char* lds, int vcu, int G, int wave, int lane, int tid) {
    const int n = lane & 15, quad = lane >> 4, rho = (-n) & 7;
    const int base = 2048 - 256 * wave - n + 8 * quad;
    const unsigned toep0 = CP_OFF + rho * CP_STRIDE + 16 * ((base >> 3) - 30);
    const unsigned uaddr0 = n * U_STRIDE + 16 * quad;
    v4u ur[8]; HyFilt f0;
    if (vcu < DM) { const v4u* src = (const v4u*)(VT + (size_t)vcu * NB * SEQ);
#pragma unroll
        for (int k = 0; k < 8; ++k) ur[k] = src[tid + 512 * k];
        f0 = hyena_fetch_filter(KF + (size_t)vcu * KF_LEN, tid); }
    for (int d = vcu; d < DM; d += G) {
        bf16* vrow = VT + (size_t)d * NB * SEQ;
#pragma unroll
        for (int k = 0; k < 8; ++k) { const int c = tid + 512 * k; *(LAS v4u*)(lds + (c >> 8) * U_STRIDE + 16 * (c & 255)) = ur[k]; }
        hyena_put_filter(lds, f0, tid);
        const HyFilt f1 = hyena_fetch_filter(KF + (size_t)(DM + d) * KF_LEN, tid);
        v2u xx[16];
#pragma unroll
        for (int ti = 0; ti < 16; ++ti) xx[ti] = *(const v2u*)(X1T + ((size_t)d * NB + n) * SEQ + 256 * wave + 16 * ti + 4 * quad);
        f32x4 acc[16];
        hyena_conv(lds, acc, toep0, uaddr0);
        const float sk0 = skip[d], sk1 = skip[DM + d];
        v2u z[16];
#pragma unroll
        for (int ti = 0; ti < 16; ++ti) { const int t = 256 * wave + 16 * ti + 4 * quad;
            const v2u vv = *(const LAS v2u*)(lds + n * U_STRIDE + 2 * t);
            const float z0 = bflo(xx[ti].x) * (acc[ti][0] + sk0 * bflo(vv.x)), z1 = bfhi(xx[ti].x) * (acc[ti][1] + sk0 * bfhi(vv.x));
            const float z2 = bflo(xx[ti].y) * (acc[ti][2] + sk0 * bflo(vv.y)), z3 = bfhi(xx[ti].y) * (acc[ti][3] + sk0 * bfhi(vv.y));
            z[ti].x = pk2(z0, z1); z[ti].y = pk2(z2, z3); }
        __syncthreads();
#pragma unroll
        for (int ti = 0; ti < 16; ++ti) { const int t = 256 * wave + 16 * ti + 4 * quad; *(LAS v2u*)(lds + n * U_STRIDE + 2 * t) = z[ti]; }
        hyena_put_filter(lds, f1, tid);
        if (d + G < DM) { const v4u* src = (const v4u*)(VT + (size_t)(d + G) * NB * SEQ);
#pragma unroll
            for (int k = 0; k < 8; ++k) ur[k] = src[tid + 512 * k];
            f0 = hyena_fetch_filter(KF + (size_t)(d + G) * KF_LEN, tid); }
        hyena_conv(lds, acc, toep0, uaddr0);
        __syncthreads();
#pragma unroll
        for (int ti = 0; ti < 16; ++ti) { const int t = 256 * wave + 16 * ti + 4 * quad;
            const float o0 = acc[ti][0] + sk1 * bflo(z[ti].x), o1 = acc[ti][1] + sk1 * bfhi(z[ti].x), o2 = acc[ti][2] + sk1 * bflo(z[ti].y), o3 = acc[ti][3] + sk1 * bfhi(z[ti].y);
            v2u w; w.x = pk2(o0, o1); w.y = pk2(o2, o3); *(LAS v2u*)(lds + n * U_STRIDE + 2 * t) = w; }
        __syncthreads();
        {   v4u* dst = (v4u*)vrow;
#pragma unroll
            for (int k = 0; k < 8; ++k) { const int c = tid + 512 * k; dst[c] = *(const LAS v4u*)(lds + (c >> 8) * U_STRIDE + 16 * (c & 255)); } }
        __syncthreads();
    }
}
constexpr int C5_STRIDE = 132;
__device__ __forceinline__ void phase_hyena_post(const bf16* big, const float* sw, const float* sb, const bf16* ZT, bf16* outp, LAS unsigned char* lds, int gw, int ngw, int wave, int lane) {
    LAS unsigned char* scr = lds + wave * 16384;
    for (int id = gw; id < 512 * 16; id += ngw) {
        const int dtile = id & 15, tt = id >> 4, b = tt >> 5, t0 = (tt & 31) * 64, d0 = dtile * 64;
        const int cg = 2 * DM + d0 + lane; const float w0 = sw[cg], w1 = sw[NQKV + cg], w2 = sw[2 * NQKV + cg], bias = sb[cg];
        const bf16* pp = big + (size_t)(b * SEQ + t0) * NQKV + cg;
        unsigned short pr[66];
#pragma unroll
        for (int k = 0; k < 66; ++k) { const int t = t0 - 1 + k; pr[k] = (t >= 0 && t < SEQ) ? pp[(long)(k - 1) * NQKV] : (unsigned short)0; }
        v4u zv[8];
#pragma unroll
        for (int ps = 0; ps < 8; ++ps) { const int dd = ps * 8 + (lane >> 3), part = lane & 7; zv[ps] = *(const v4u*)(ZT + ((size_t)(d0 + dd) * NB + b) * SEQ + t0 + part * 8); }
#pragma unroll
        for (int ps = 0; ps < 8; ++ps) { const int dd = ps * 8 + (lane >> 3), part = lane & 7;
            LAS unsigned* w = (LAS unsigned*)(scr + dd * C5_STRIDE + part * 16); w[0] = zv[ps].x; w[1] = zv[ps].y; w[2] = zv[ps].z; w[3] = zv[ps].w; }
        LDS_WAIT();
        const LAS unsigned short* zr = (const LAS unsigned short*)(scr + lane * C5_STRIDE);
        bf16* op = outp + (size_t)(b * SEQ + t0) * DM + d0 + lane;
#pragma unroll
        for (int k = 0; k < 64; ++k) { const float y = (w0 * bf2f(pr[k]) + w1 * bf2f(pr[k + 1]) + w2 * bf2f(pr[k + 2]) + bias) * bf2f(zr[k]); op[(size_t)k * DM] = f2bf(y); }
        LDS_WAIT();
    }
}

__global__ void __launch_bounds__(NTHREADS, 2) mk_fwd(Args a) {
    extern __shared__ __attribute__((aligned(16))) unsigned char lds_raw[];
    LAS unsigned char* lds = (LAS unsigned char*)lds_raw;
    cg::grid_group grid = cg::this_grid();
    const int tid = threadIdx.x, lane = tid & 63, wave = __builtin_amdgcn_readfirstlane(tid >> 6);
    const int G = gridDim.x, bx = blockIdx.x;
    const int vcu = (G % 8 == 0) ? (bx % 8) * (G / 8) + bx / 8 : bx;
    const int gw = vcu * NWAVES + wave, ngw = G * NWAVES;
    unsigned char* ws = a.ws;
    float* SS = (float*)(ws + WS_SS); bf16* XN = (bf16*)(ws + WS_XN); bf16* VT = (bf16*)(ws + WS_VT); bf16* MIXO = (bf16*)(ws + WS_MIXO); bf16* BIG = (bf16*)(ws + WS_BIG);
    const int lo = a.ph_lo, hi = a.ph_hi; int ph = 0;
    volatile LAS unsigned* MISC = (volatile LAS unsigned*)(lds + MISC_OFF);
    if (tid < 16) MISC[tid] = 0u;
    __syncthreads();
    XcdBarrier xbar = xcd_barrier_post((unsigned*)(ws + WS_BAR), MISC);
#define PH_BEGIN if (ph >= lo && ph < hi) {
#define PH_END   if (ph + 1 < hi) { if (ph == 0) grid.sync(); else xcd_barrier(xbar); } } ++ph;

    PH_BEGIN phase_prologue(a, lds, gw, ngw, wave, lane);
    PH_END
    PH_BEGIN phase_filters(a, lds, vcu, G, wave, lane, tid); phase_norm0(a.in[0], XN, SS, gw, ngw, lane); PH_END

    { constexpr int L = 0;

        constexpr int kind = L % 3;
        const bf16* wl = (const bf16*)(ws + WS_W + (size_t)L * W_LAYER);
        PH_BEGIN { pg8::Gemm g{XN, wl + W_IN / 2, MTOK, NQKV, DM}; pg8::StaticOrder S; S.init(MTOK, NQKV, G, bx); fill_row_scales(S, SS, (LAS float*)(lds + RST_OFF), tid);
                   if constexpr (kind == 0) { pg8::EpiShortIn E{BIG, BIG + (size_t)MTOK * DM, (const LAS float*)(lds + RST_OFF)}; pg8::gemm_phase<pg8::EpiShortIn, pg8::StaticOrder, true, true>(lds, g, S, E); }
                   else { pg8::EpiBf16PT<(kind == 1)> E{BIG, NQKV, (const LAS float*)(lds + RST_OFF), (float*)(ws + WS_KSS), MTOK};
                   pg8::gemm_phase<pg8::EpiBf16PT<(kind == 1)>, pg8::StaticOrder, true, true>(lds, g, S, E); }
 } PH_END
        if (kind == 0) {
            PH_BEGIN phase_shortconv(BIG, BIG + (size_t)MTOK * DM, a.in[4] + (size_t)(L / 3) * 3 * DM, MIXO, vcu * NTHREADS + tid, G * NTHREADS);
            PH_END
        } else if (kind == 1) {
            PH_BEGIN
            phase_natten3(BIG, a.in[7], a.in[8], a.in[9], (const float*)(ws + WS_KSS), MIXO, lds, vcu, G, wave, lane, tid); PH_END
        } else {
            PH_BEGIN phase_hyena_pre(BIG, a.in[12], a.in[13], VT, MIXO, lds, gw, ngw, wave, lane);
            PH_END
            PH_BEGIN
            phase_hyena(VT, MIXO, (const bf16*)(ws + WS_KF), a.in[20], lds, vcu, G, wave, lane, tid); PH_END
            PH_BEGIN phase_hyena_post(BIG, a.in[12], a.in[13], VT, MIXO, lds, gw, ngw, wave, lane);
            PH_END
        }
        PH_BEGIN { pg8::Gemm g{MIXO, wl + W_OUT / 2, MTOK, DM, DM}; pg8::StaticOrder S; S.init(MTOK, DM, G, bx); pg8::EpiResNorm E{a.out, XN, SS, DM};
                   pg8::gemm_phase<pg8::EpiResNorm, pg8::StaticOrder, true, true>(lds, g, S, E); } PH_END
        PH_BEGIN { pg8::Gemm g{XN, wl + W_13 / 2, MTOK, NW13, DM}; pg8::StaticOrder S; S.init(MTOK, NW13, G, bx); pg8::EpiSwiGLU E{BIG, FFH, (const LAS float*)(lds + RST_OFF)}; fill_row_scales(S, SS, (LAS float*)(lds + RST_OFF), tid);
                   pg8::gemm_phase<pg8::EpiSwiGLU, pg8::StaticOrder, true, true>(lds, g, S, E);
 } PH_END
        PH_BEGIN { pg8::Gemm g{BIG, wl + W_2 / 2, MTOK, DM, FFH}; pg8::StaticOrder S; S.init(MTOK, DM, G, bx); pg8::EpiResNormT<(L == NLAYER - 1)> E{a.out, XN, SS, DM};
                   pg8::gemm_phase<pg8::EpiResNormT<(L == NLAYER - 1)>, pg8::StaticOrder, true, true>(lds, g, S, E); } PH_END
        }
    { constexpr int L = 1;

        constexpr int kind = L % 3;
        const bf16* wl = (const bf16*)(ws + WS_W + (size_t)L * W_LAYER);
        PH_BEGIN { pg8::Gemm g{XN, wl + W_IN / 2, MTOK, NQKV, DM}; pg8::StaticOrder S; S.init(MTOK, NQKV, G, bx); fill_row_scales(S, SS, (LAS float*)(lds + RST_OFF), tid);
                   if constexpr (kind == 0) { pg8::EpiShortIn E{BIG, BIG + (size_t)MTOK * DM, (const LAS float*)(lds + RST_OFF)}; pg8::gemm_phase<pg8::EpiShortIn, pg8::StaticOrder, true, true>(lds, g, S, E); }
                   else { pg8::EpiBf16PT<(kind == 1)> E{BIG, NQKV, (const LAS float*)(lds + RST_OFF), (float*)(ws + WS_KSS), MTOK};
                   pg8::gemm_phase<pg8::EpiBf16PT<(kind == 1)>, pg8::StaticOrder, true, true>(lds, g, S, E); }
 } PH_END
        if (kind == 0) {
            PH_BEGIN phase_shortconv(BIG, BIG + (size_t)MTOK * DM, a.in[4] + (size_t)(L / 3) * 3 * DM, MIXO, vcu * NTHREADS + tid, G * NTHREADS);
            PH_END
        } else if (kind == 1) {
            PH_BEGIN
            phase_natten3(BIG, a.in[7], a.in[8], a.in[9], (const float*)(ws + WS_KSS), MIXO, lds, vcu, G, wave, lane, tid); PH_END
        } else {
            PH_BEGIN phase_hyena_pre(BIG, a.in[12], a.in[13], VT, MIXO, lds, gw, ngw, wave, lane);
            PH_END
            PH_BEGIN
            phase_hyena(VT, MIXO, (const bf16*)(ws + WS_KF), a.in[20], lds, vcu, G, wave, lane, tid); PH_END
            PH_BEGIN phase_hyena_post(BIG, a.in[12], a.in[13], VT, MIXO, lds, gw, ngw, wave, lane);
            PH_END
        }
        PH_BEGIN { pg8::Gemm g{MIXO, wl + W_OUT / 2, MTOK, DM, DM}; pg8::StaticOrder S; S.init(MTOK, DM, G, bx); pg8::EpiResNorm E{a.out, XN, SS, DM};
                   pg8::gemm_phase<pg8::EpiResNorm, pg8::StaticOrder, true, true>(lds, g, S, E); } PH_END
        PH_BEGIN { pg8::Gemm g{XN, wl + W_13 / 2, MTOK, NW13, DM}; pg8::StaticOrder S; S.init(MTOK, NW13, G, bx); pg8::EpiSwiGLU E{BIG, FFH, (const LAS float*)(lds + RST_OFF)}; fill_row_scales(S, SS, (LAS float*)(lds + RST_OFF), tid);
                   pg8::gemm_phase<pg8::EpiSwiGLU, pg8::StaticOrder, true, true>(lds, g, S, E);
 } PH_END
        PH_BEGIN { pg8::Gemm g{BIG, wl + W_2 / 2, MTOK, DM, FFH}; pg8::StaticOrder S; S.init(MTOK, DM, G, bx); pg8::EpiResNormT<(L == NLAYER - 1)> E{a.out, XN, SS, DM};
                   pg8::gemm_phase<pg8::EpiResNormT<(L == NLAYER - 1)>, pg8::StaticOrder, true, true>(lds, g, S, E); } PH_END
        }
    { constexpr int L = 2;

        constexpr int kind = L % 3;
        const bf16* wl = (const bf16*)(ws + WS_W + (size_t)L * W_LAYER);
        PH_BEGIN { pg8::Gemm g{XN, wl + W_IN / 2, MTOK, NQKV, DM}; pg8::StaticOrder S; S.init(MTOK, NQKV, G, bx); fill_row_scales(S, SS, (LAS float*)(lds + RST_OFF), tid);
                   if constexpr (kind == 0) { pg8::EpiShortIn E{BIG, BIG + (size_t)MTOK * DM, (const LAS float*)(lds + RST_OFF)}; pg8::gemm_phase<pg8::EpiShortIn, pg8::StaticOrder, true, true>(lds, g, S, E); }
                   else { pg8::EpiBf16PT<(kind == 1)> E{BIG, NQKV, (const LAS float*)(lds + RST_OFF), (float*)(ws + WS_KSS), MTOK};
                   pg8::gemm_phase<pg8::EpiBf16PT<(kind == 1)>, pg8::StaticOrder, true, true>(lds, g, S, E); }
 } PH_END
        if (kind == 0) {
            PH_BEGIN phase_shortconv(BIG, BIG + (size_t)MTOK * DM, a.in[4] + (size_t)(L / 3) * 3 * DM, MIXO, vcu * NTHREADS + tid, G * NTHREADS);
            PH_END
        } else if (kind == 1) {
            PH_BEGIN
            phase_natten3(BIG, a.in[7], a.in[8], a.in[9], (const float*)(ws + WS_KSS), MIXO, lds, vcu, G, wave, lane, tid); PH_END
        } else {
            PH_BEGIN phase_hyena_pre(BIG, a.in[12], a.in[13], VT, MIXO, lds, gw, ngw, wave, lane);
            PH_END
            PH_BEGIN
            phase_hyena(VT, MIXO, (const bf16*)(ws + WS_KF), a.in[20], lds, vcu, G, wave, lane, tid); PH_END
            PH_BEGIN phase_hyena_post(BIG, a.in[12], a.in[13], VT, MIXO, lds, gw, ngw, wave, lane);
            PH_END
        }
        PH_BEGIN { pg8::Gemm g{MIXO, wl + W_OUT / 2, MTOK, DM, DM}; pg8::StaticOrder S; S.init(MTOK, DM, G, bx); pg8::EpiResNorm E{a.out, XN, SS, DM};
                   pg8::gemm_phase<pg8::EpiResNorm, pg8::StaticOrder, true, true>(lds, g, S, E); } PH_END
        PH_BEGIN { pg8::Gemm g{XN, wl + W_13 / 2, MTOK, NW13, DM}; pg8::StaticOrder S; S.init(MTOK, NW13, G, bx); pg8::EpiSwiGLU E{BIG, FFH, (const LAS float*)(lds + RST_OFF)}; fill_row_scales(S, SS, (LAS float*)(lds + RST_OFF), tid);
                   pg8::gemm_phase<pg8::EpiSwiGLU, pg8::StaticOrder, true, true>(lds, g, S, E);
 } PH_END
        PH_BEGIN { pg8::Gemm g{BIG, wl + W_2 / 2, MTOK, DM, FFH}; pg8::StaticOrder S; S.init(MTOK, DM, G, bx); pg8::EpiResNormT<(L == NLAYER - 1)> E{a.out, XN, SS, DM};
                   pg8::gemm_phase<pg8::EpiResNormT<(L == NLAYER - 1)>, pg8::StaticOrder, true, true>(lds, g, S, E); } PH_END
        }
    { constexpr int L = 3;

        constexpr int kind = L % 3;
        const bf16* wl = (const bf16*)(ws + WS_W + (size_t)L * W_LAYER);
        PH_BEGIN { pg8::Gemm g{XN, wl + W_IN / 2, MTOK, NQKV, DM}; pg8::StaticOrder S; S.init(MTOK, NQKV, G, bx); fill_row_scales(S, SS, (LAS float*)(lds + RST_OFF), tid);
                   if constexpr (kind == 0) { pg8::EpiShortIn E{BIG, BIG + (size_t)MTOK * DM, (const LAS float*)(lds + RST_OFF)}; pg8::gemm_phase<pg8::EpiShortIn, pg8::StaticOrder, true, true>(lds, g, S, E); }
                   else { pg8::EpiBf16PT<(kind == 1)> E{BIG, NQKV, (const LAS float*)(lds + RST_OFF), (float*)(ws + WS_KSS), MTOK};
                   pg8::gemm_phase<pg8::EpiBf16PT<(kind == 1)>, pg8::StaticOrder, true, true>(lds, g, S, E); }
 } PH_END
        if (kind == 0) {
            PH_BEGIN phase_shortconv(BIG, BIG + (size_t)MTOK * DM, a.in[4] + (size_t)(L / 3) * 3 * DM, MIXO, vcu * NTHREADS + tid, G * NTHREADS);
            PH_END
        } else if (kind == 1) {
            PH_BEGIN
            phase_natten3(BIG, a.in[7], a.in[8], a.in[9], (const float*)(ws + WS_KSS), MIXO, lds, vcu, G, wave, lane, tid); PH_END
        } else {
            PH_BEGIN phase_hyena_pre(BIG, a.in[12], a.in[13], VT, MIXO, lds, gw, ngw, wave, lane);
            PH_END
            PH_BEGIN
            phase_hyena(VT, MIXO, (const bf16*)(ws + WS_KF), a.in[20], lds, vcu, G, wave, lane, tid); PH_END
            PH_BEGIN phase_hyena_post(BIG, a.in[12], a.in[13], VT, MIXO, lds, gw, ngw, wave, lane);
            PH_END
        }
        PH_BEGIN { pg8::Gemm g{MIXO, wl + W_OUT / 2, MTOK, DM, DM}; pg8::StaticOrder S; S.init(MTOK, DM, G, bx); pg8::EpiResNorm E{a.out, XN, SS, DM};
                   pg8::gemm_phase<pg8::EpiResNorm, pg8::StaticOrder, true, true>(lds, g, S, E); } PH_END
        PH_BEGIN { pg8::Gemm g{XN, wl + W_13 / 2, MTOK, NW13, DM}; pg8::StaticOrder S; S.init(MTOK, NW13, G, bx); pg8::EpiSwiGLU E{BIG, FFH, (const LAS float*)(lds + RST_OFF)}; fill_row_scales(S, SS, (LAS float*)(lds + RST_OFF), tid);
                   pg8::gemm_phase<pg8::EpiSwiGLU, pg8::StaticOrder, true, true>(lds, g, S, E);
 } PH_END
        PH_BEGIN { pg8::Gemm g{BIG, wl + W_2 / 2, MTOK, DM, FFH}; pg8::StaticOrder S; S.init(MTOK, DM, G, bx); pg8::EpiResNormT<(L == NLAYER - 1)> E{a.out, XN, SS, DM};
                   pg8::gemm_phase<pg8::EpiResNormT<(L == NLAYER - 1)>, pg8::StaticOrder, true, true>(lds, g, S, E); } PH_END
        }
#undef PH_BEGIN
#undef PH_END
}
#ifndef MK_NPH
#define MK_NPH (2 + 5 + 5 + 7 + 5)
#endif
constexpr int N_PHASES = MK_NPH;

extern "C" void kernel_launch(void* const* d_in, const int* in_sizes, int n_in, void* d_out, int out_size, void* d_ws, size_t ws_size, hipStream_t stream) {
    static int grid = 0;
    if (grid == 0) {
        if (n_in != 24 || out_size != MTOK * DM || ws_size < WS_END) { fprintf(stderr, "kernel_launch: unexpected shapes (n_in %d, out %d, ws %zu); nothing launched\n", n_in, out_size, ws_size); grid = -1; return; }
        int dev = 0, cus = 0, per_cu = 0;
        if (hipGetDevice(&dev) != hipSuccess || hipDeviceGetAttribute(&cus, hipDeviceAttributeMultiprocessorCount, dev) != hipSuccess) { grid = -1; return; }
        if (hipFuncSetAttribute((const void*)mk_fwd, hipFuncAttributeMaxDynamicSharedMemorySize, LDS_BYTES) != hipSuccess) { fprintf(stderr, "kernel_launch: hipFuncSetAttribute failed\n"); grid = -1; return; }
        if (hipOccupancyMaxActiveBlocksPerMultiprocessor(&per_cu, (const void*)mk_fwd, NTHREADS, LDS_BYTES) != hipSuccess || per_cu < 1) { fprintf(stderr, "kernel_launch: occupancy query gives %d\n", per_cu); per_cu = 1; }
        (void)hipGetLastError();
        grid = cus;
    }
    if (grid < 0) return;
    Args a{};
    for (int i = 0; i < 24; ++i) a.in[i] = (const float*)d_in[i];
    a.out = (float*)d_out; a.ws = (unsigned char*)d_ws;
    if (hipMemsetAsync(d_ws, 0, CTL_ZERO_BYTES, stream) != hipSuccess) { fprintf(stderr, "kernel_launch: memset of the control words failed\n"); return; }
#if MK_N_LAUNCHES == 1
    a.ph_lo = 0; a.ph_hi = N_PHASES;
    { void* args[] = {&a}; hipError_t e = hipLaunchCooperativeKernel((const void*)mk_fwd, dim3(grid), dim3(NTHREADS), args, LDS_BYTES, stream);
      if (e != hipSuccess) fprintf(stderr, "kernel_launch: cooperative launch failed: %s (grid %d)\n", hipGetErrorString(e), grid); }
#else
    for (int p = 0; p < N_PHASES; ++p) { a.ph_lo = p; a.ph_hi = p + 1; void* args[] = {&a};
        hipError_t e = hipLaunchCooperativeKernel((const void*)mk_fwd, dim3(grid), dim3(NTHREADS), args, LDS_BYTES, stream);
        if (e != hipSuccess) { fprintf(stderr, "kernel_launch: launch %d failed: %s\n", p, hipGetErrorString(e)); break; } }
#endif
}
```

```cpp
#include <hip/hip_runtime.h>
#include <hip/hip_cooperative_groups.h>
#include <cstdio>
#include <cstdint>
namespace cg = cooperative_groups;
namespace pg8 {
#define PG8_LAS __attribute__((address_space(3)))
typedef unsigned short bf16_t;
typedef short bf16x8 __attribute__((ext_vector_type(8)));
typedef float f32x4 __attribute__((ext_vector_type(4)));
typedef unsigned u32x4 __attribute__((ext_vector_type(4)));
constexpr int BM = 256, BK = 64, HALF = 128, HTB = HALF * BK * 2  , STAGE_BYTES = 8 * HTB, NXCD = 8, WGM = 8;

__host__ __device__ __forceinline__ int lds_byte(int r, int c) { const int st = (r >> 4) * 2 + (c >> 5), rr = r & 15, cc = c & 31, ob = rr * 64 + cc * 2; return st * 1024 + (ob ^ (((ob >> 9) & 1) << 5)); }
__host__ __device__ __forceinline__ void stage_rc(int b, int& R, int& C) { const int st = b / 1024, sb = b % 1024, swz = sb ^ (((sb >> 9) & 1) << 5); R = (st >> 1) * 16 + swz / 64; C = (st & 1) * 32 + (swz % 64) / 2; }
__host__ __device__ __forceinline__ int perm32(int rho) { const int n = rho >> 4, i = rho & 15; return 8 * (i >> 2) + 4 * n + (i & 3); }

struct Unit { int pm, pn, idx; };
struct Gemm { const bf16_t* A; const bf16_t* Bt; int M, N, K; };

struct StaticOrder {
    int nM, nN, nwg, G, c;
    __host__ __device__ void init(int M, int N, int G_, int c_) { nM = M / BM; nN = N / BM; nwg = nM * nN; G = G_; c = c_; }
    __host__ __device__ bool next(int i, Unit& u) const {
        const long L = (long)i * G + c; if (L >= nwg) return false;
        int wgid = (int)L; { const int q = nwg / NXCD, r = nwg % NXCD, xcd = wgid % NXCD, off = wgid / NXCD; wgid = (xcd < r ? xcd * (q + 1) : r * (q + 1) + (xcd - r) * q) + off; }
        const int nig = WGM * nN, gid = wgid / nig, fm = gid * WGM, gsz = (nM - fm) < WGM ? (nM - fm) : WGM;
        u.pm = fm + ((wgid % nig) % gsz); u.pn = (wgid % nig) / gsz; u.idx = i; return true;
    }
    __device__ __forceinline__ void a_ready(const Unit&) const {}
    __device__ __forceinline__ void done(const Unit&) const {}
};
__device__ __forceinline__ unsigned cvt_pk_bf16(float lo, float hi) { unsigned r; asm volatile("v_cvt_pk_bf16_f32 %0, %1, %2" : "=v"(r) : "v"(lo), "v"(hi)); return r; }
__device__ __forceinline__ float row_rscale(const float* ss, int row) { const f32x4* p = (const f32x4*)(ss + (size_t)row * 16); const f32x4 a = (p[0] + p[1]) + (p[2] + p[3]);
    return __builtin_amdgcn_rsqf(((a[0] + a[1]) + (a[2] + a[3])) * (1.0f / 1024.0f) + 1e-6f); }
template <bool KSS = false> struct EpiBf16PT {
    static constexpr bool PERM = true, AFTER_DRAIN = false;
    bf16_t* O; int ldc; const PG8_LAS float* rst; float* kss; int mrows;
    __device__ __forceinline__ void operator()(const f32x4 (&acc)[2][2][4][2], const Unit& u, int wr, int wc, int fr, int fq) const {
        const int row0 = u.pm * BM + wr * 64 + fr, col0 = u.pn * BM + wc * 32 + 8 * fq;
        const bool kt = KSS && u.pn >= 4 && u.pn < 8;
#pragma unroll
        for (int ai = 0; ai < 2; ++ai)
#pragma unroll
            for (int m = 0; m < 4; ++m) { const int row = row0 + ai * HALF + m * 16; bf16_t* rowp = O + (size_t)row * ldc + col0; const float rs = rst[u.idx * 256 + wr * 64 + fr + ai * HALF + m * 16];
#pragma unroll
                for (int bj = 0; bj < 2; ++bj) { const f32x4 v0 = acc[ai][bj][m][0] * rs, v1 = acc[ai][bj][m][1] * rs;
                    u32x4 w; w.x = cvt_pk_bf16(v0[0], v0[1]); w.y = cvt_pk_bf16(v0[2], v0[3]); w.z = cvt_pk_bf16(v1[0], v1[1]); w.w = cvt_pk_bf16(v1[2], v1[3]);
                    *(u32x4*)(rowp + bj * HALF) = w;
                    if (kt) { float q = ((v0[0] * v0[0] + v0[1] * v0[1]) + (v0[2] * v0[2] + v0[3] * v0[3])) + ((v1[0] * v1[0] + v1[1] * v1[1]) + (v1[2] * v1[2] + v1[3] * v1[3]));
                        q += __shfl_xor(q, 16); q += __shfl_xor(q, 32);
                        if (fq == 0) kss[(size_t)((u.pn - 4) * 8 + bj * 4 + wc) * mrows + row] = q; } }
                if (KSS) asm volatile("" ::: "memory"); }
    }
};
typedef EpiBf16PT<false> EpiBf16P;
__device__ __forceinline__ float silu_mul(float g, float u) { return g * __builtin_amdgcn_rcpf(1.0f + __expf(-g)) * u; }
struct EpiSwiGLU {
    static constexpr bool PERM = true, AFTER_DRAIN = false;
    bf16_t* H; int ldh; const PG8_LAS float* rst;
    __device__ __forceinline__ void operator()(const f32x4 (&acc)[2][2][4][2], const Unit& u, int wr, int wc, int fr, int fq) const {
        const int row0 = u.pm * BM + wr * 64 + fr, col0 = u.pn * HALF + wc * 32 + 8 * fq;
#pragma unroll
        for (int ai = 0; ai < 2; ++ai)
#pragma unroll
            for (int m = 0; m < 4; ++m) { bf16_t* rowp = H + (size_t)(row0 + ai * HALF + m * 16) * ldh + col0; const float rs = rst[u.idx * 256 + wr * 64 + fr + ai * HALF + m * 16];
                const f32x4 g0 = acc[ai][0][m][0] * rs, g1 = acc[ai][0][m][1] * rs, u0 = acc[ai][1][m][0] * rs, u1 = acc[ai][1][m][1] * rs;
                u32x4 w; w.x = cvt_pk_bf16(silu_mul(g0[0], u0[0]), silu_mul(g0[1], u0[1])); w.y = cvt_pk_bf16(silu_mul(g0[2], u0[2]), silu_mul(g0[3], u0[3]));
                w.z = cvt_pk_bf16(silu_mul(g1[0], u1[0]), silu_mul(g1[1], u1[1])); w.w = cvt_pk_bf16(silu_mul(g1[2], u1[2]), silu_mul(g1[3], u1[3]));
                *(u32x4*)rowp = w; }
    }
};
typedef unsigned u32x2 __attribute__((ext_vector_type(2)));
struct EpiShortIn {
    static constexpr bool PERM = true, AFTER_DRAIN = false;
    bf16_t* CU; bf16_t* BG; const PG8_LAS float* rst;
    __device__ __forceinline__ void operator()(const f32x4 (&acc)[2][2][4][2], const Unit& u, int wr, int wc, int fr, int fq) const {
        const int row0 = u.pm * BM + wr * 64 + fr;
#pragma unroll
        for (int ai = 0; ai < 2; ++ai)
#pragma unroll
            for (int m = 0; m < 4; ++m) { const int row = row0 + ai * HALF + m * 16; const float rs = rst[u.idx * 256 + wr * 64 + fr + ai * HALF + m * 16];
                if (u.pn < 8) { const float r2 = rs * rs; const f32x4 c0 = acc[ai][0][m][0], c1 = acc[ai][0][m][1], u0 = acc[ai][1][m][0], u1 = acc[ai][1][m][1];
                    u32x4 w; w.x = cvt_pk_bf16(c0[0] * u0[0] * r2, c0[1] * u0[1] * r2); w.y = cvt_pk_bf16(c0[2] * u0[2] * r2, c0[3] * u0[3] * r2);
                    w.z = cvt_pk_bf16(c1[0] * u1[0] * r2, c1[1] * u1[1] * r2); w.w = cvt_pk_bf16(c1[2] * u1[2] * r2, c1[3] * u1[3] * r2);
                    *(u32x4*)(CU + (size_t)row * 1024 + u.pn * HALF + wc * 32 + 8 * fq) = w; }
                else { bf16_t* rowp = BG + (size_t)row * 1024 + (u.pn - 8) * BM + wc * 32 + 8 * fq;
#pragma unroll
                    for (int bj = 0; bj < 2; ++bj) { const f32x4 v0 = acc[ai][bj][m][0] * rs, v1 = acc[ai][bj][m][1] * rs;
                        u32x4 w; w.x = cvt_pk_bf16(v0[0], v0[1]); w.y = cvt_pk_bf16(v0[2], v0[3]); w.z = cvt_pk_bf16(v1[0], v1[1]); w.w = cvt_pk_bf16(v1[2], v1[3]);
                        *(u32x4*)(rowp + bj * HALF) = w; } } }
    }
};
template <bool LAST = false> struct EpiResNormT {
    static constexpr bool PERM = true, AFTER_DRAIN = false;
    float* out; bf16_t* xb; float* ss; int ldc;
    __device__ __forceinline__ void operator()(const f32x4 (&acc)[2][2][4][2], const Unit& u, int wr, int wc, int fr, int fq) const {
        const int row0 = u.pm * BM + wr * 64 + fr, col0 = u.pn * BM + wc * 32 + 8 * fq;
#pragma unroll
        for (int ai = 0; ai < 2; ++ai)
#pragma unroll
            for (int m = 0; m < 4; ++m) { const int row = row0 + ai * HALF + m * 16; const size_t off = (size_t)row * ldc + col0; float s = 0.f;
#pragma unroll
                for (int bj = 0; bj < 2; ++bj) { const size_t o = off + bj * HALF; const u32x4 b = *(const u32x4*)(xb + o);
                    f32x4 r0, r1;
                    r0[0] = __uint_as_float(b.x << 16) + acc[ai][bj][m][0][0]; r0[1] = __uint_as_float(b.x & 0xffff0000u) + acc[ai][bj][m][0][1];
                    r0[2] = __uint_as_float(b.y << 16) + acc[ai][bj][m][0][2]; r0[3] = __uint_as_float(b.y & 0xffff0000u) + acc[ai][bj][m][0][3];
                    r1[0] = __uint_as_float(b.z << 16) + acc[ai][bj][m][1][0]; r1[1] = __uint_as_float(b.z & 0xffff0000u) + acc[ai][bj][m][1][1];
                    r1[2] = __uint_as_float(b.w << 16) + acc[ai][bj][m][1][2]; r1[3] = __uint_as_float(b.w & 0xffff0000u) + acc[ai][bj][m][1][3];
                    if (LAST) { *(f32x4*)(out + o) = r0; *(f32x4*)(out + o + 4) = r1; }
                    else { s += ((r0[0] * r0[0] + r0[1] * r0[1]) + (r0[2] * r0[2] + r0[3] * r0[3])) + ((r1[0] * r1[0] + r1[1] * r1[1]) + (r1[2] * r1[2] + r1[3] * r1[3]));
                        u32x4 w; w.x = cvt_pk_bf16(r0[0], r0[1]); w.y = cvt_pk_bf16(r0[2], r0[3]); w.z = cvt_pk_bf16(r1[0], r1[1]); w.w = cvt_pk_bf16(r1[2], r1[3]); *(u32x4*)(xb + o) = w; } }
                if (!LAST) { s += __shfl_xor(s, 16); s += __shfl_xor(s, 32); if (fq == 0) ss[(size_t)row * 16 + u.pn * 4 + wc] = s; }
                asm volatile("" ::: "memory"); }
    }
};
typedef EpiResNormT<false> EpiResNorm;
template <class Epi, class Sched, bool ALIGN_EPI = false, bool SP2 = false>
__device__ __forceinline__ void gemm_phase(PG8_LAS unsigned char* lds, const Gemm g, const Sched& S, const Epi& E) {
    const int tid = threadIdx.x, wid = __builtin_amdgcn_readfirstlane(tid >> 6), lane = tid & 63, wr = wid >> 2, wc = wid & 3, fr = lane & 15, fq = lane >> 4;
    const int K = g.K, nt = K / BK;
    unsigned voffA[2], voffB[2];
#pragma unroll
    for (int i = 0; i < 2; ++i) { int R, C; stage_rc(tid * 16 + i * 8192, R, C); const int Rb = Epi::PERM ? ((R & ~31) + perm32(R & 31)) : R;
        voffA[i] = (unsigned)(R * K + C) * 2u; voffB[i] = (unsigned)(Rb * K + C) * 2u; }
    const size_t kstep = (size_t)(BK * 2);
    const size_t hstep = (size_t)HALF * K * 2;
    const size_t tstep = 2 * hstep;
    const unsigned ldsw = (unsigned)wid * 1024u;
    const int aoff = lds_byte(wr * 64 + fr, fq * 8), boff = lds_byte(wc * 32 + fr, fq * 8);
#define PG8_SA(b, h) (((b) * 2 + (h)) * HTB)
#define PG8_SB(b, h) ((4 + (b) * 2 + (h)) * HTB)
#define PG8_STAGE(bufoff, gbase, voff) do { _Pragma("unroll") for (int _i = 0; _i < 2; ++_i) \
        __builtin_amdgcn_global_load_lds((const unsigned*)((const char*)(gbase) + (voff)[_i]), (PG8_LAS unsigned*)(lds + (bufoff) + ldsw + _i * 8192), 16, 0, 0); } while (0)
#define PG8_LDA(dst, b, h) do { _Pragma("unroll") for (int m = 0; m < 4; ++m) _Pragma("unroll") for (int k = 0; k < 2; ++k) dst[m][k] = *(const PG8_LAS bf16x8*)(lds + PG8_SA(b, h) + aoff + m * 2048 + k * 1024); } while (0)
#define PG8_LDB(dst, b, h) do { _Pragma("unroll") for (int n = 0; n < 2; ++n) _Pragma("unroll") for (int k = 0; k < 2; ++k) dst[n][k] = *(const PG8_LAS bf16x8*)(lds + PG8_SB(b, h) + boff + n * 2048 + k * 1024); } while (0)
#define PG8_MMA(ai, bj, At, Bt) do { __builtin_amdgcn_s_setprio(1); _Pragma("unroll") for (int m = 0; m < 4; ++m) _Pragma("unroll") for (int n = 0; n < 2; ++n) _Pragma("unroll") for (int k = 0; k < 2; ++k) \
        acc[ai][bj][m][n] = __builtin_amdgcn_mfma_f32_16x16x32_bf16(Bt[n][k], At[m][k], acc[ai][bj][m][n], 0, 0, 0); __builtin_amdgcn_s_setprio(0); } while (0)
#define PG8_WAIT_V(n) asm volatile("s_waitcnt vmcnt(" #n ")" ::: "memory")
#define PG8_WAIT_L(n) asm volatile("s_waitcnt lgkmcnt(" #n ")" ::: "memory")
#define PG8_BAR __builtin_amdgcn_s_barrier()
#define PG8_SCHED __builtin_amdgcn_sched_barrier(0)
    Unit cur, nxt; int ui = 0;
    if (!S.next(0, cur)) return;
    f32x4 acc[2][2][4][2];
#pragma unroll
    for (int a = 0; a < 2; ++a)
#pragma unroll
        for (int b = 0; b < 2; ++b)
#pragma unroll
            for (int m = 0; m < 4; ++m)
#pragma unroll
                for (int n = 0; n < 2; ++n) acc[a][b][m][n] = (f32x4){0.f, 0.f, 0.f, 0.f};
    bf16x8 At[4][2], B0[2][2], B1[2][2];
    const char* cA = (const char*)g.A + (size_t)cur.pm * tstep; const char* cB = (const char*)g.Bt + (size_t)cur.pn * tstep;
    S.a_ready(cur);
    if constexpr (SP2) {
        PG8_STAGE(PG8_SB(0, 0), cB, voffB); PG8_STAGE(PG8_SB(0, 1), cB + hstep, voffB); PG8_STAGE(PG8_SA(0, 0), cA, voffA); PG8_STAGE(PG8_SA(0, 1), cA + hstep, voffA);
        if (wr == 1) PG8_BAR;
        PG8_WAIT_V(2); PG8_BAR;
        PG8_STAGE(PG8_SB(1, 0), cB + kstep, voffB); PG8_STAGE(PG8_SA(1, 0), cA + kstep, voffA); PG8_STAGE(PG8_SB(1, 1), cB + hstep + kstep, voffB);
        PG8_WAIT_V(6); PG8_BAR;
    } else {
        PG8_STAGE(PG8_SB(0, 0), cB, voffB); PG8_STAGE(PG8_SA(0, 0), cA, voffA); PG8_STAGE(PG8_SB(0, 1), cB + hstep, voffB); PG8_STAGE(PG8_SA(0, 1), cA + hstep, voffA);
        if (wr == 1) PG8_BAR;
        PG8_WAIT_V(4); PG8_BAR;
        PG8_STAGE(PG8_SB(1, 0), cB + kstep, voffB); PG8_STAGE(PG8_SA(1, 0), cA + kstep, voffA); PG8_STAGE(PG8_SB(1, 1), cB + hstep + kstep, voffB);
        PG8_WAIT_V(6); PG8_BAR;
    }
    for (;;) {
        const bool has_next = S.next(ui + 1, nxt);
        const char* nA = has_next ? (const char*)g.A + (size_t)nxt.pm * tstep : cA; const char* nB = has_next ? (const char*)g.Bt + (size_t)nxt.pn * tstep : cB;
        for (int t = 0; t < nt; t += 2) {
            const bool last = (t == nt - 2);
            const char* a1 = cA + (size_t)(t + 1) * kstep;
            const char* a2 = last ? nA : cA + (size_t)(t + 2) * kstep; const char* b2 = last ? nB : cB + (size_t)(t + 2) * kstep;
            const char* a3 = a2 + kstep; const char* b3 = b2 + kstep;
            if (last && has_next) S.a_ready(nxt);
            if constexpr (SP2) {
            PG8_LDB(B0, 0, 0); PG8_LDB(B1, 0, 1); PG8_SCHED; PG8_LDA(At, 0, 0); PG8_STAGE(PG8_SA(1, 1), a1 + hstep, voffA);
            PG8_WAIT_V(8); PG8_WAIT_L(0); PG8_BAR; PG8_MMA(0, 0, At, B0); PG8_MMA(0, 1, At, B1); PG8_BAR; PG8_SCHED;
            PG8_LDA(At, 0, 1); PG8_STAGE(PG8_SB(0, 0), b2, voffB); PG8_STAGE(PG8_SB(0, 1), b2 + hstep, voffB); PG8_STAGE(PG8_SA(0, 0), a2, voffA);
            PG8_WAIT_V(8); PG8_WAIT_L(0); PG8_BAR; PG8_MMA(1, 0, At, B0); PG8_MMA(1, 1, At, B1); PG8_BAR; PG8_SCHED;
            PG8_LDB(B0, 1, 0); PG8_LDB(B1, 1, 1); PG8_SCHED; PG8_LDA(At, 1, 0); PG8_STAGE(PG8_SA(0, 1), a2 + hstep, voffA);
            PG8_WAIT_V(8); PG8_WAIT_L(0); PG8_BAR; PG8_MMA(0, 0, At, B0); PG8_MMA(0, 1, At, B1); PG8_BAR; PG8_SCHED;
            PG8_LDA(At, 1, 1); PG8_STAGE(PG8_SB(1, 0), b3, voffB); PG8_STAGE(PG8_SB(1, 1), b3 + hstep, voffB); PG8_STAGE(PG8_SA(1, 0), a3, voffA);
            PG8_WAIT_V(8); PG8_WAIT_L(0); PG8_BAR; PG8_MMA(1, 0, At, B0); PG8_MMA(1, 1, At, B1); PG8_BAR; PG8_SCHED;
            } else {
            PG8_LDB(B0, 0, 0); PG8_SCHED; PG8_LDA(At, 0, 0); PG8_STAGE(PG8_SA(1, 1), a1 + hstep, voffA);
            PG8_WAIT_L(8); PG8_BAR; PG8_WAIT_L(0); PG8_MMA(0, 0, At, B0); PG8_BAR; PG8_SCHED;
            PG8_LDB(B1, 0, 1); PG8_STAGE(PG8_SB(0, 0), b2, voffB);
            PG8_BAR; PG8_WAIT_L(0); PG8_MMA(0, 1, At, B1); PG8_BAR;
            PG8_LDA(At, 0, 1); PG8_STAGE(PG8_SA(0, 0), a2, voffA);
            PG8_BAR; PG8_WAIT_L(0); PG8_MMA(1, 0, At, B0); PG8_BAR; PG8_SCHED;
            PG8_STAGE(PG8_SB(0, 1), b2 + hstep, voffB);
            PG8_WAIT_V(6); PG8_BAR; PG8_MMA(1, 1, At, B1); PG8_BAR;
            PG8_LDB(B0, 1, 0); PG8_SCHED; PG8_LDA(At, 1, 0); PG8_STAGE(PG8_SA(0, 1), a2 + hstep, voffA);
            PG8_WAIT_L(8); PG8_BAR; PG8_WAIT_L(0); PG8_MMA(0, 0, At, B0); PG8_BAR; PG8_SCHED;
            PG8_LDB(B1, 1, 1); PG8_STAGE(PG8_SB(1, 0), b3, voffB);
            PG8_BAR; PG8_WAIT_L(0); PG8_MMA(0, 1, At, B1); PG8_BAR;
            PG8_LDA(At, 1, 1); PG8_STAGE(PG8_SA(1, 0), a3, voffA);
            PG8_BAR; PG8_WAIT_L(0); PG8_MMA(1, 0, At, B0); PG8_BAR; PG8_SCHED;
            PG8_STAGE(PG8_SB(1, 1), b3 + hstep, voffB);
            PG8_WAIT_V(6); PG8_BAR; PG8_MMA(1, 1, At, B1); PG8_BAR;
            }
        }
        if constexpr (ALIGN_EPI) { if (wr == 0) PG8_BAR; }
        if constexpr (!Epi::AFTER_DRAIN) { E(acc, cur, wr, wc, fr, fq); S.done(cur); }
        if (!has_next) break;
#pragma unroll
        for (int a = 0; a < 2; ++a)
#pragma unroll
            for (int b = 0; b < 2; ++b)
#pragma unroll
                for (int m = 0; m < 4; ++m)
#pragma unroll
                    for (int n = 0; n < 2; ++n) acc[a][b][m][n] = (f32x4){0.f, 0.f, 0.f, 0.f};
        cur = nxt; cA = nA; cB = nB; ++ui;
        if constexpr (ALIGN_EPI) { if (wr == 1) PG8_BAR; }
    }
    PG8_WAIT_V(0);
    if constexpr (!ALIGN_EPI) { if (wr == 0) PG8_BAR; }
    PG8_BAR;
    if constexpr (Epi::AFTER_DRAIN) { E.fused(acc, cur, wr, wc, fr, fq, lds, wid, lane); S.done(cur); }
#undef PG8_SA
#undef PG8_SB
#undef PG8_STAGE
#undef PG8_LDA
#undef PG8_LDB
#undef PG8_MMA
#undef PG8_WAIT_V
#undef PG8_WAIT_L
#undef PG8_BAR
#undef PG8_SCHED
}
}

#ifndef MK_N_LAUNCHES
#define MK_N_LAUNCHES 1
#endif
constexpr int NB = 16, SEQ = 2048, DM = 1024, MTOK = NB * SEQ, NQKV = 3072, FFH = 2816, NW13 = 2 * FFH, NLAYER = 4;
constexpr float RMS_EPS = 1e-6f;
constexpr int NWAVES = 8, NTHREADS = 512;
constexpr size_t MiB = 1u << 20;
constexpr size_t WS_W = 1 * MiB, W_LAYER = 49 * MiB / 2;
constexpr size_t W_IN = 0, W_OUT = 6 * MiB, W_13 = 8 * MiB, W_2 = 19 * MiB;
constexpr size_t WS_SS = 439 * MiB;
constexpr size_t WS_HID = 100 * MiB;
constexpr size_t WS_KF = 102 * MiB;
constexpr int KF_LEN = 4112;
constexpr size_t WS_XN = 119 * MiB;
constexpr size_t WS_MIXO = 183 * MiB;
constexpr size_t WS_BIG = 247 * MiB;
constexpr size_t WS_VT = 441 * MiB;
constexpr size_t WS_KSS = 505 * MiB;
constexpr size_t WS_END = 509 * MiB;
constexpr int MISC_OFF = 163776, RST_OFF = 131072;
constexpr size_t WS_BAR = 16384, CTL_ZERO_BYTES = 65536;
constexpr int LDS_BYTES = 163840;
#define LAS __attribute__((address_space(3)))
typedef unsigned short bf16;
typedef unsigned v4u __attribute__((ext_vector_type(4)));
typedef unsigned v2u __attribute__((ext_vector_type(2)));
typedef float f32x4 __attribute__((ext_vector_type(4)));
typedef short bf16x8 __attribute__((ext_vector_type(8)));
typedef short v4i16_t __attribute__((ext_vector_type(4)));
#define LDS_WAIT() asm volatile("s_waitcnt lgkmcnt(0)" ::: "memory")
typedef float f32x2_cv __attribute__((ext_vector_type(2))); typedef __bf16 bf16x2_cv __attribute__((ext_vector_type(2)));
__device__ __forceinline__ unsigned pk2c(float lo, float hi) { const f32x2_cv v = {lo, hi}; const bf16x2_cv b = __builtin_convertvector(v, bf16x2_cv); return __builtin_bit_cast(unsigned, b); }
__device__ __forceinline__ unsigned pk2(float lo, float hi) { return pg8::cvt_pk_bf16(lo, hi); }
__device__ __forceinline__ float bflo(unsigned w) { return __uint_as_float(w << 16); }
__device__ __forceinline__ float bfhi(unsigned w) { return __uint_as_float(w & 0xffff0000u); }
__device__ __forceinline__ float bf2f(unsigned short b) { return __uint_as_float(((unsigned)b) << 16); }
__device__ __forceinline__ unsigned short f2bf(float f) { return (unsigned short)(pk2(f, 0.f) & 0xffffu); }
__device__ __forceinline__ float wave_sum(float v) {
#pragma unroll
    for (int o = 1; o < 64; o <<= 1) v += __shfl_xor(v, o);
    return v;
}

#define RLX_AGENT __ATOMIC_RELAXED, __HIP_MEMORY_SCOPE_AGENT
#define XB_TMO      128
#define XB_XCNT(j)  (256  + 64 * (j))
#define XB_XSUB(j)  (1280 + 64 * (j))
#define XB_XGEN(j)  (2304 + 64 * (j))
#define XB_TOP      3328
#define XB_TOPGEN   3392
#define XCD_BAR_WORDS 3456
#define XB_SPIN_CAP (1u << 18)

__device__ __forceinline__ unsigned xb_ld(unsigned* p)              { return __hip_atomic_load(p, __ATOMIC_RELAXED, __HIP_MEMORY_SCOPE_AGENT); }
__device__ __forceinline__ unsigned xb_add(unsigned* p, unsigned v) { return __hip_atomic_fetch_add(p, v, __ATOMIC_RELAXED, __HIP_MEMORY_SCOPE_AGENT); }
__device__ __forceinline__ unsigned xb_xcc_id() { return (unsigned)__builtin_amdgcn_s_getreg((3 << 11) | 20) & 0xFu; }
#define XB_SPIN(cond, bar) do { unsigned _sp = 0; while (cond) { __builtin_amdgcn_s_sleep(1); \
    if ((++_sp & 255u) == 0u) { if (xb_ld(&(bar)[XB_TMO])) break; if (_sp > XB_SPIN_CAP) { atomicAdd(&(bar)[XB_TMO], 1u); break; } } } } while (0)

struct XcdBarrier {
    unsigned* bar; unsigned x;
    volatile LAS unsigned* st;
};

__device__ __forceinline__ XcdBarrier xcd_barrier_post(unsigned* bar, volatile LAS unsigned* st) {
    XcdBarrier b; b.bar = bar; b.x = xb_xcc_id(); b.st = st;
    if (threadIdx.x == 0) (void)xb_add(&bar[XB_XCNT(b.x)], 1u);
    return b;
}
__device__ __forceinline__ void xcd_barrier_complete(unsigned* bar, unsigned x, unsigned& nloc, unsigned& nx) {
    const unsigned G = gridDim.x * gridDim.y * gridDim.z;
    unsigned sum, cnt, mine, sp = 0u;
    for (;;) {
        sum = 0u; cnt = 0u; mine = 0u;
#pragma unroll
        for (unsigned j = 0; j < 16; ++j) { const unsigned c = xb_ld(&bar[XB_XCNT(j)]); sum += c; cnt += (c > 0u) ? 1u : 0u; mine = (j == x) ? c : mine; }
        if (sum == G) break;
        __builtin_amdgcn_s_sleep(1);
        if ((++sp & 255u) == 0u) { if (xb_ld(&bar[XB_TMO])) break; if (sp > XB_SPIN_CAP) { atomicAdd(&bar[XB_TMO], 1u); break; } }
    }
    nloc = mine > 0u ? mine : 1u; nx = cnt > 0u ? cnt : 1u;
}

__device__ __forceinline__ void xcd_barrier(const XcdBarrier& b) {
    asm volatile("s_waitcnt vmcnt(0)" ::: "memory");
    __syncthreads();
    if (threadIdx.x == 0) {
        unsigned* bar = b.bar;
        __builtin_amdgcn_s_waitcnt(0);
        unsigned nloc = b.st[0], nx = b.st[1];
        if (nloc == 0u) { xcd_barrier_complete(bar, b.x, nloc, nx); b.st[0] = nloc; b.st[1] = nx; }
        const unsigned old = xb_add(&bar[XB_XSUB(b.x)], 1u);
        const unsigned gen = old / nloc;
        if (old + 1u == (gen + 1u) * nloc) {
            __builtin_amdgcn_fence(__ATOMIC_RELEASE, "agent");
            asm volatile("s_waitcnt vmcnt(0)" ::: "memory");
            const unsigned og = xb_add(&bar[XB_TOP], 1u);
            const unsigned tg = og / nx;
            if (og + 1u == (tg + 1u) * nx) xb_add(&bar[XB_TOPGEN], 1u);
            else XB_SPIN(xb_ld(&bar[XB_TOPGEN]) == tg, bar);
            __builtin_amdgcn_fence(__ATOMIC_ACQUIRE, "agent");
            xb_add(&bar[XB_XGEN(b.x)], 1u);
            asm volatile("s_waitcnt vmcnt(0)" ::: "memory");
        } else {
            XB_SPIN(xb_ld(&bar[XB_XGEN(b.x)]) == gen, bar);
            __builtin_amdgcn_fence(__ATOMIC_ACQUIRE, "agent");
            asm volatile("s_waitcnt vmcnt(0)" ::: "memory");
        }
    }
    __syncthreads();
}

__device__ __forceinline__ void transpose_item(const float* __restrict__ W, int K, int N, const float* __restrict__ gain, bf16* WT, int dst_row0, LAS float* scr, int k0, int n0, int lane) {
    float tv[32];
#pragma unroll
    for (int i = 0; i < 32; ++i) { const int kk = 2 * i + (lane >> 5); tv[i] = W[(size_t)(k0 + kk) * N + n0 + (lane & 31)]; }
#pragma unroll
    for (int i = 0; i < 32; ++i) { const int kk = 2 * i + (lane >> 5); float v = tv[i]; if (gain) v *= gain[k0 + kk]; scr[kk * 33 + (lane & 31)] = v; }
    LDS_WAIT();
    const int c = lane & 7;
#pragma unroll
    for (int j = 0; j < 4; ++j) { const int n = (lane >> 3) + 8 * j; const LAS float* s = scr + (8 * c) * 33 + n;
        v4u o; o.x = pk2(s[0 * 33], s[1 * 33]); o.y = pk2(s[2 * 33], s[3 * 33]); o.z = pk2(s[4 * 33], s[5 * 33]); o.w = pk2(s[6 * 33], s[7 * 33]);
        *(v4u*)(WT + (size_t)(dst_row0 + n) * K + k0 + 8 * c) = o; }
    LDS_WAIT();
}

struct Args { const float* in[24]; float* out; unsigned char* ws; int ph_lo, ph_hi; };

__device__ __forceinline__ void phase_prologue(const Args& a, LAS unsigned char* lds, int gw, int ngw, int wave, int lane) {
    LAS float* scr = (LAS float*)(lds + wave * 16384);
    constexpr int I_IN = 16 * 96, I_OUT = 16 * 32, I_13 = 16 * 176, I_2 = 44 * 32, I_L = I_IN + I_OUT + I_13 + I_2;
    for (int it = gw; it < NLAYER * I_L; it += ngw) {
        const int L = it / I_L; int r = it - L * I_L;
        const float* win = (L == 1) ? a.in[6] : (L == 2) ? a.in[11] : (L == 0 ? a.in[3] : a.in[3] + (size_t)DM * NQKV);
        const float* wout = (L == 1) ? a.in[10] : (L == 2) ? a.in[21] : (L == 0 ? a.in[5] : a.in[5] + (size_t)DM * DM);
        bf16* wl = (bf16*)(a.ws + WS_W + (size_t)L * W_LAYER);
        if (r < I_IN) { const int kb = r / 96, nb = r % 96, n0 = 32 * nb; int dst = n0;
            if (L % 3 == 0) { const int j = n0 & 1023; dst = (n0 < DM) ? 2 * DM + n0 : 256 * (j / 128) + (n0 < 2 * DM ? 0 : 128) + (j % 128); }
            transpose_item(win, DM, NQKV, a.in[1] + L * DM, wl + W_IN / 2, dst, scr, 64 * kb, n0, lane); continue; }
        r -= I_IN;
        if (r < I_OUT) { const int kb = r / 32, nb = r % 32; transpose_item(wout, DM, DM, nullptr, wl + W_OUT / 2, 32 * nb, scr, 64 * kb, 32 * nb, lane); continue; }
        r -= I_OUT;
        if (r < I_13) { const int kb = r / 176, nb = r % 176, n0 = 32 * nb, half = n0 / FFH, j = n0 % FFH, dst = 256 * (j / 128) + 128 * half + (j % 128);
            transpose_item(a.in[22] + (size_t)L * DM * NW13, DM, NW13, a.in[2] + L * DM, wl + W_13 / 2, dst, scr, 64 * kb, n0, lane); continue; }
        r -= I_13;
        { const int kb = r / 32, nb = r % 32; transpose_item(a.in[23] + (size_t)L * FFH * DM, FFH, DM, nullptr, wl + W_2 / 2, 32 * nb, scr, 64 * kb, 32 * nb, lane); }
    }
    const float* w1 = a.in[14]; const float* b1 = a.in[15]; const float* w2 = a.in[16]; const float* b2 = a.in[17]; const float* fr = a.in[19];
    float* hid = (float*)(a.ws + WS_HID);
    for (int t = gw; t < SEQ; t += ngw) {
        float zv = 0.f;
        if (lane == 0) zv = (float)t / (float)(SEQ - 1);
        else if (lane <= 32) { const int k = (lane - 1) & 15; const float band = 1e-4f + (float)k * ((15.0f - 1e-4f) / 15.0f);
            const float ang = ((6.283185307179586f * (float)t) / (float)SEQ) * band; zv = (lane <= 16) ? cosf(ang) : -sinf(ang); }
        float a1 = b1[lane];
        for (int e = 0; e < 33; ++e) a1 += __shfl(zv, e) * w1[e * 64 + lane];
        const float f = fr[lane];
        const float h1 = sinf(f * a1);
        float a2 = b2[lane];
        for (int i = 0; i < 64; ++i) a2 += __shfl(h1, i) * w2[i * 64 + lane];
        hid[t * 64 + lane] = sinf(f * a2);
    }
}

__device__ __forceinline__ void phase_filters(const Args& a, LAS unsigned char* lds, int vcu, int G, int wave, int lane, int tid) {
    const float* hid = (const float*)(a.ws + WS_HID); const float* w3 = a.in[18]; bf16* KF = (bf16*)(a.ws + WS_KF);
    constexpr int HS = 272;
    for (int p0 = vcu * NWAVES; p0 < 2 * DM; p0 += G * NWAVES) {
        const int p = p0 + wave, o = p >> 10, d = p & 1023, cf = o * 2048 + d, cr = cf + 1024;
        const float delta = 4.605170185988091f * (1.0f / 1.5f + (float)d * ((1.0f / 0.3f - 1.0f / 1.5f) / 1023.0f));
        bf16* kf = KF + (size_t)p * KF_LEN;
        LAS float* wcol = (LAS float*)(lds + 17408 + NWAVES * 16384 + wave * 512);
        wcol[lane] = w3[(size_t)lane * 4096 + cf]; wcol[64 + lane] = w3[(size_t)lane * 4096 + cr];
        float asum = 0.f;
        LAS float* vals = (LAS float*)(lds + 17408 + wave * 16384);
        v4u hreg[2];
#pragma unroll
        for (int i = 0; i < 2; ++i) { const int idx = tid + 512 * i; hreg[i] = *(const v4u*)(hid + (size_t)(idx >> 4) * 64 + (idx & 15) * 4); }
#pragma unroll 1
        for (int tb = 0; tb < 32; ++tb) {
            __syncthreads();
#pragma unroll
            for (int i = 0; i < 2; ++i) { const int idx = tid + 512 * i; *(LAS v4u*)(lds + (idx >> 4) * HS + (idx & 15) * 16) = hreg[i]; }
            if (tb < 31) {
#pragma unroll
                for (int i = 0; i < 2; ++i) { const int idx = tid + 512 * i; hreg[i] = *(const v4u*)(hid + (size_t)((tb + 1) * 64 + (idx >> 4)) * 64 + (idx & 15) * 4); } }
            __syncthreads();
            const int t = tb * 64 + lane; const LAS f32x4* hr = (const LAS f32x4*)(lds + lane * HS);
            float af = 0.f, ar = 0.f;
#pragma unroll
            for (int j4 = 0; j4 < 16; ++j4) { const f32x4 h = hr[j4]; const f32x4 a4 = ((const LAS f32x4*)wcol)[j4], b4 = ((const LAS f32x4*)wcol)[16 + j4];
                af += h[0] * a4[0] + h[1] * a4[1] + h[2] * a4[2] + h[3] * a4[3];
                ar += h[0] * b4[0] + h[1] * b4[1] + h[2] * b4[2] + h[3] * b4[3]; }
            const float dec = __expf(-((float)t / (float)(SEQ - 1)) * delta);
            af *= dec; ar *= dec; vals[(2 * tb) * 64 + lane] = af; vals[(2 * tb + 1) * 64 + lane] = ar;
            asum += (t == 0) ? fabsf(af + ar) : (fabsf(af) + fabsf(ar));
        }
        const float inv = 1.0f / wave_sum(asum);
#pragma unroll 4
        for (int tb = 0; tb < 32; ++tb) { const int t = tb * 64 + lane; const float vf = vals[(2 * tb) * 64 + lane], vr = vals[(2 * tb + 1) * 64 + lane];
            if (t == 0) kf[2048] = f2bf((vf + vr) * inv); else { kf[2048 - t] = f2bf(vf * inv); kf[2048 + t] = f2bf(vr * inv); } }
        if (lane < 17) kf[lane == 0 ? 0 : 4095 + lane] = 0;
    }
    __syncthreads();
}

__device__ __forceinline__ void phase_norm0(const float* __restrict__ x, bf16* __restrict__ xn, float* __restrict__ ss, int gw, int ngw, int lane) {
    for (int m = gw; m < MTOK; m += ngw) {
        const f32x4* xr = (const f32x4*)(x + (size_t)m * DM) + lane;
        f32x4 v[4]; float s = 0.f;
#pragma unroll
        for (int j = 0; j < 4; ++j) { v[j] = xr[64 * j]; s += (v[j].x * v[j].x + v[j].y * v[j].y) + (v[j].z * v[j].z + v[j].w * v[j].w); }
        s = wave_sum(s);
        if (lane < 16) ss[(size_t)m * 16 + lane] = (lane == 0) ? s : 0.f;
        unsigned long long* o8 = (unsigned long long*)(xn + (size_t)m * DM) + lane;
#pragma unroll
        for (int j = 0; j < 4; ++j) o8[64 * j] = (unsigned long long)pk2(v[j].x, v[j].y) | ((unsigned long long)pk2(v[j].z, v[j].w) << 32);
    }
}

__device__ __forceinline__ void fill_row_scales(const pg8::StaticOrder& S, const float* ss, LAS float* rst, int tid) {
    for (int idx = tid; idx < 11 * 256; idx += NTHREADS) { pg8::Unit u; if (!S.next(idx >> 8, u)) break; rst[idx] = pg8::row_rscale(ss, u.pm * 256 + (idx & 255)); }
    __syncthreads();
}

__device__ __forceinline__ void phase_shortconv(const bf16* __restrict__ cu, const bf16* __restrict__ bg, const float* __restrict__ cw, bf16* __restrict__ outp, int gtid, int ngt) {
    for (int idx = gtid; idx < MTOK * 128; idx += ngt) {
        const int m = idx >> 7, d0 = (idx & 127) * 8, t = m & (SEQ - 1);
        const size_t o = (size_t)m * DM + d0;
        const v4u bv = *(const v4u*)(bg + o), c1 = *(const v4u*)(cu + o);
        v4u c0 = {0u, 0u, 0u, 0u}, c2 = c0;
        if (t > 0) c0 = *(const v4u*)(cu + o - DM);
        if (t < SEQ - 1) c2 = *(const v4u*)(cu + o + DM);
        const f32x4 wa0 = *(const f32x4*)(cw + d0), wa1 = *(const f32x4*)(cw + d0 + 4), wb0 = *(const f32x4*)(cw + DM + d0), wb1 = *(const f32x4*)(cw + DM + d0 + 4),
                    wc0 = *(const f32x4*)(cw + 2 * DM + d0), wc1 = *(const f32x4*)(cw + 2 * DM + d0 + 4);
        v4u ov;
#pragma unroll
        for (int k = 0; k < 4; ++k) {
            const float w0l = (k < 2) ? wa0[2 * k] : wa1[2 * k - 4], w0h = (k < 2) ? wa0[2 * k + 1] : wa1[2 * k - 3];
            const float w1l = (k < 2) ? wb0[2 * k] : wb1[2 * k - 4], w1h = (k < 2) ? wb0[2 * k + 1] : wb1[2 * k - 3];
            const float w2l = (k < 2) ? wc0[2 * k] : wc1[2 * k - 4], w2h = (k < 2) ? wc0[2 * k + 1] : wc1[2 * k - 3];
            const float lo = bflo(bv[k]) * (w0l * bflo(c0[k]) + w1l * bflo(c1[k]) + w2l * bflo(c2[k]));
            const float hi = bfhi(bv[k]) * (w0h * bfhi(c0[k]) + w1h * bfhi(c1[k]) + w2h * bfhi(c2[k]));
            ov[k] = pk2(lo, hi);
        }
        *(v4u*)(outp + o) = ov;
    }
}

__device__ __forceinline__ void norm_frag(const v4u r0, const v4u r1, const LAS float* g, int quad, float extra, bf16x8& f0, bf16x8& f1) {
    float x[16];
#pragma unroll
    for (int k = 0; k < 4; ++k) { x[2 * k] = bflo(r0[k]); x[2 * k + 1] = bfhi(r0[k]); x[8 + 2 * k] = bflo(r1[k]); x[9 + 2 * k] = bfhi(r1[k]); }
    float ss = 0.f;
#pragma unroll
    for (int k = 0; k < 16; ++k) ss += x[k] * x[k];
    ss += __shfl_xor(ss, 16); ss += __shfl_xor(ss, 32);
    const float r = rsqrtf(ss * (1.0f / 64.0f) + RMS_EPS) * extra;
    v4u o0, o1;
#pragma unroll
    for (int k = 0; k < 4; ++k) { o0[k] = pk2c(x[2 * k] * r * g[8 * quad + 2 * k], x[2 * k + 1] * r * g[8 * quad + 2 * k + 1]);
        o1[k] = pk2c(x[8 + 2 * k] * r * g[32 + 8 * quad + 2 * k], x[9 + 2 * k] * r * g[32 + 8 * quad + 2 * k + 1]); }
    f0 = __builtin_bit_cast(bf16x8, o0); f1 = __builtin_bit_cast(bf16x8, o1);
}

__device__ __forceinline__ void norm_frag_r(const v4u r0, const v4u r1, const float (&g)[16], float extra, bf16x8& f0, bf16x8& f1) {
    float x[16];
#pragma unroll
    for (int k = 0; k < 4; ++k) { x[2 * k] = bflo(r0[k]); x[2 * k + 1] = bfhi(r0[k]); x[8 + 2 * k] = bflo(r1[k]); x[9 + 2 * k] = bfhi(r1[k]); }
    float ss = 0.f;
#pragma unroll
    for (int k = 0; k < 16; ++k) ss += x[k] * x[k];
    ss += __shfl_xor(ss, 16); ss += __shfl_xor(ss, 32);
    const float r = rsqrtf(ss * (1.0f / 64.0f) + RMS_EPS) * extra;
    v4u o0, o1;
#pragma unroll
    for (int k = 0; k < 4; ++k) { o0[k] = pk2c(x[2 * k] * (r * g[2 * k]), x[2 * k + 1] * (r * g[2 * k + 1])); o1[k] = pk2c(x[8 + 2 * k] * (r * g[8 + 2 * k]), x[9 + 2 * k] * (r * g[9 + 2 * k])); }
    f0 = __builtin_bit_cast(bf16x8, o0); f1 = __builtin_bit_cast(bf16x8, o1);
}
constexpr int AR_SLOT = 16640, AR_V = 8192, AR_RK = 16384, AR_NSLOT = 9, AR_RPB = AR_NSLOT * AR_SLOT, AR_G = AR_RPB + 1920;
__device__ __forceinline__ int ar_off(int k, int c) { return k * 128 + ((c ^ (k & 7)) << 4); }

constexpr int A3_NSLOT = 8, A3_RPB = A3_NSLOT * AR_SLOT, A3_G = A3_RPB + 1920, A3_CMB = A3_G + 256, A3_CMB_BYTES = 4608;
static_assert(A3_CMB + 4 * A3_CMB_BYTES <= MISC_OFF, "attention LDS map");
__device__ __forceinline__ void phase_natten3(const bf16* qkv, const float* qg, const float* kg, const float* rpb, const float* kss, bf16* outp, LAS unsigned char* lds, int vcu, int G, int wave, int lane, int tid) {
    LAS float* rpb_l = (LAS float*)(lds + A3_RPB); LAS float* g_l = (LAS float*)(lds + A3_G);
    const int n = lane & 15, quad = lane >> 4, qq = (lane >> 2) & 3, p = lane & 3;
    const int cb = wave & 3, kh = wave >> 2;
    LAS unsigned char* cmb = lds + A3_CMB + cb * A3_CMB_BYTES;
    const int lk = (tid >> 3) & 63, lc = tid & 7;
    for (int unit = vcu; unit < NB * 16; unit += G) {
        const int b = unit >> 4, h = unit & 15;
        const bf16* kvbase = qkv + (size_t)b * SEQ * NQKV + DM + h * 64 + lc * 8 + (size_t)lk * NQKV;
        const float* ksbase = kss + (size_t)(2 * h) * MTOK + (size_t)b * SEQ + tid;
        __syncthreads();
        for (int i = tid; i < 15 * 31; i += NTHREADS) rpb_l[i] = rpb[h * (15 * 31) + i] * 1.4426950408889634f;
        if (tid < 64) g_l[tid] = qg[tid] * kg[tid];
        {   v4u rk_[8], rv_[8]; float rs_[8];
#pragma unroll
            for (int rho = 0; rho < 8; ++rho) { const bf16* pp = kvbase + (size_t)rho * 64 * NQKV; rk_[rho] = *(const v4u*)pp; rv_[rho] = *(const v4u*)(pp + DM);
                rs_[rho] = (tid < 64) ? ksbase[rho * 64] + ksbase[MTOK + rho * 64] : 0.f; }
#pragma unroll
            for (int rho = 0; rho < 8; ++rho) { LAS unsigned char* slot = lds + rho * AR_SLOT; *(LAS v4u*)(slot + ar_off(lk, lc)) = rk_[rho]; *(LAS v4u*)(slot + AR_V + ar_off(lk, lc)) = rv_[rho];
                if (tid < 64) *(LAS float*)(slot + AR_RK + 4 * tid) = __builtin_amdgcn_rsqf(rs_[rho] * (1.0f / 64.0f) + RMS_EPS); } }
        int start = cb * 16 - 8; start = start < 0 ? 0 : (start > 32 ? 32 : start);
        const int qc = cb * 16 + n; int cs = qc - 8; cs = cs < 0 ? 0 : (cs > 48 ? 48 : cs);
        const bf16* qbase = qkv + (size_t)(b * SEQ + cb * 16 + n) * NQKV + h * 64 + 8 * quad;
        v4u qr0 = *(const v4u*)qbase, qr1 = *(const v4u*)(qbase + 32);
        __syncthreads();
        float gq[16];
#pragma unroll
        for (int k = 0; k < 8; ++k) { gq[k] = g_l[8 * quad + k]; gq[8 + k] = g_l[32 + 8 * quad + k]; }
        float bia[4][2][4]; int prev_d0 = 1000;
#pragma unroll 1
        for (int r = 0; r < 32; ++r) {
            int rs = r - 4; rs = rs < 0 ? 0 : (rs > 24 ? 24 : rs);
            int rsn = r - 3; rsn = rsn < 0 ? 0 : (rsn > 24 ? 24 : rsn);
            const bool slide = (r < 31) && (rsn != rs);
            v4u nk = {0u, 0u, 0u, 0u}, nv = nk; float nss = 0.f;
            if (slide) { const bf16* pp = kvbase + (size_t)(rs + 8) * 64 * NQKV; nk = *(const v4u*)pp; nv = *(const v4u*)(pp + DM); if (tid < 64) nss = ksbase[(rs + 8) * 64] + ksbase[MTOK + (rs + 8) * 64]; }
            bf16x8 qf0, qf1;
            norm_frag_r(qr0, qr1, gq, 0.125f * 1.4426950408889634f, qf0, qf1);
            if (r < 31) { const bf16* qp = qbase + (size_t)(r + 1) * 64 * NQKV; qr0 = *(const v4u*)qp; qr1 = *(const v4u*)(qp + 32); }
            f32x4 st[4][2];
#pragma unroll
            for (int jj = 0; jj < 4; ++jj) { const LAS unsigned char* slot = lds + ((rs + 4 * kh + jj) & 7) * AR_SLOT;
#pragma unroll
                for (int kt = 0; kt < 2; ++kt) { const int k = start + 16 * kt + n;
                    const bf16x8 kf0 = *(const LAS bf16x8*)(slot + ar_off(k, quad)), kf1 = *(const LAS bf16x8*)(slot + ar_off(k, quad + 4));
                    f32x4 sacc = {0.f, 0.f, 0.f, 0.f};
                    sacc = __builtin_amdgcn_mfma_f32_16x16x32_bf16(kf0, qf0, sacc, 0, 0, 0);
                    sacc = __builtin_amdgcn_mfma_f32_16x16x32_bf16(kf1, qf1, sacc, 0, 0, 0);
                    st[jj][kt] = sacc; } }
            if (rs - r != prev_d0) { prev_d0 = rs - r;
#pragma unroll
                for (int jj = 0; jj < 4; ++jj) { const int dr = rs + 4 * kh + jj - r + 7;
#pragma unroll
                    for (int kt = 0; kt < 2; ++kt)
#pragma unroll
                        for (int i = 0; i < 4; ++i) { const int kc = start + 16 * kt + 4 * quad + i; int dc = kc - qc + 15; dc = dc < 0 ? 0 : (dc > 30 ? 30 : dc);
                            bia[jj][kt][i] = ((kc >= cs) && (kc < cs + 16)) ? rpb_l[dr * 31 + dc] : -3.0e38f; } } }
            float sum = 0.f;
#pragma unroll
            for (int jj = 0; jj < 4; ++jj) { const LAS unsigned char* slot = lds + ((rs + 4 * kh + jj) & 7) * AR_SLOT;
#pragma unroll
                for (int kt = 0; kt < 2; ++kt) { const f32x4 rk = *(const LAS f32x4*)(slot + AR_RK + 4 * (start + 16 * kt + 4 * quad));
#pragma unroll
                    for (int i = 0; i < 4; ++i) { const float e = __builtin_amdgcn_exp2f(st[jj][kt][i] * rk[i] + bia[jj][kt][i]); st[jj][kt][i] = e; sum += e; } } }
            sum += __shfl_xor(sum, 16); sum += __shfl_xor(sum, 32);
            f32x4 oacc[4];
#pragma unroll
            for (int dt = 0; dt < 4; ++dt) oacc[dt] = (f32x4){0.f, 0.f, 0.f, 0.f};
            const int kl = start + 4 * quad + qq;
            v4i16_t lo[4][4], hi[4][4];
#pragma unroll
            for (int jj = 0; jj < 4; ++jj) {
                const unsigned vs = (unsigned)(unsigned long long)(lds + ((rs + 4 * kh + jj) & 7) * AR_SLOT + AR_V) + 8 * (p & 1);
#pragma unroll
                for (int dt = 0; dt < 4; ++dt) { const unsigned a_lo = vs + ar_off(kl, 2 * dt + (p >> 1)), a_hi = vs + ar_off(kl + 16, 2 * dt + (p >> 1));
                    asm volatile("ds_read_b64_tr_b16 %0, %1" : "=v"(lo[jj][dt]) : "v"(a_lo) : "memory");
                    asm volatile("ds_read_b64_tr_b16 %0, %1" : "=v"(hi[jj][dt]) : "v"(a_hi) : "memory"); } }
            bf16x8 pf[4];
#pragma unroll
            for (int jj = 0; jj < 4; ++jj) { const f32x4 s0 = st[jj][0], s1 = st[jj][1];
                v4u pw; pw.x = pk2c(s0[0], s0[1]); pw.y = pk2c(s0[2], s0[3]); pw.z = pk2c(s1[0], s1[1]); pw.w = pk2c(s1[2], s1[3]); pf[jj] = __builtin_bit_cast(bf16x8, pw); }
            asm volatile("s_waitcnt lgkmcnt(0)" ::: "memory"); __builtin_amdgcn_sched_barrier(0);
#pragma unroll
            for (int jj = 0; jj < 4; ++jj)
#pragma unroll
                for (int dt = 0; dt < 4; ++dt) {
                    const bf16x8 vf = (bf16x8){lo[jj][dt][0], lo[jj][dt][1], lo[jj][dt][2], lo[jj][dt][3], hi[jj][dt][0], hi[jj][dt][1], hi[jj][dt][2], hi[jj][dt][3]};
                    oacc[dt] = __builtin_amdgcn_mfma_f32_16x16x32_bf16(vf, pf[jj], oacc[dt], 0, 0, 0);
                }
            if (kh == 1) {
#pragma unroll
                for (int dt = 0; dt < 4; ++dt) *(LAS f32x4*)(cmb + (dt * 64 + lane) * 16) = oacc[dt];
                *(LAS float*)(cmb + 4096 + lane * 4) = sum;
            }
            __syncthreads();
            if (kh == 0) {
                const float lb = *(const LAS float*)(cmb + 4096 + lane * 4);
                const float inv = 1.0f / (sum + lb);
                bf16* op = outp + (size_t)(b * SEQ + r * 64 + cb * 16 + n) * DM + h * 64 + 4 * quad;
#pragma unroll
                for (int dt = 0; dt < 4; ++dt) { const f32x4 ob = *(const LAS f32x4*)(cmb + (dt * 64 + lane) * 16); const f32x4 o = (oacc[dt] + ob) * inv;
                    v2u w; w.x = pk2c(o[0], o[1]); w.y = pk2c(o[2], o[3]); *(v2u*)(op + 16 * dt) = w; }
            }
            if (slide) { LAS unsigned char* slot = lds + ((rs + 8) & 7) * AR_SLOT; *(LAS v4u*)(slot + ar_off(lk, lc)) = nk; *(LAS v4u*)(slot + AR_V + ar_off(lk, lc)) = nv;
                if (tid < 64) *(LAS float*)(slot + AR_RK + 4 * tid) = __builtin_amdgcn_rsqf(nss * (1.0f / 64.0f) + RMS_EPS); }
            __syncthreads();
        }
    }
}

constexpr int CT_STRIDE = 144, CT_BYTES = 66 * CT_STRIDE;
__device__ __forceinline__ void hyena_pre_fetch(const bf16* big, int id, int lane, v4u (&v)[9]) {
    const int ct = id & 31, tt = id >> 5, b = tt >> 5, t0 = (tt & 31) * 64, c0 = ct * 64;
#pragma unroll
    for (int ps = 0; ps < 9; ++ps) { const int rr = ps * 8 + (lane >> 3), part = lane & 7, t = t0 - 1 + rr;
        v[ps] = (v4u){0u, 0u, 0u, 0u};
        if (rr < 66 && t >= 0 && t < SEQ) v[ps] = *(const v4u*)(big + (size_t)(b * SEQ + t) * NQKV + c0 + part * 8); }
}
__device__ __forceinline__ void phase_hyena_pre(const bf16* big, const float* sw, const float* sb, bf16* VTp, bf16* X1Tp, LAS unsigned char* lds, int gw, int ngw, int wave, int lane) {
    LAS unsigned char* scr = lds + wave * 16384;
    v4u vin[9];
    if (gw < 512 * 32) hyena_pre_fetch(big, gw, lane, vin);
    for (int id = gw; id < 512 * 32; id += ngw) {
        const int ct = id & 31, tt = id >> 5, b = tt >> 5, t0 = (tt & 31) * 64, c0 = ct * 64;
#pragma unroll
        for (int ps = 0; ps < 9; ++ps) { const int rr = ps * 8 + (lane >> 3), part = lane & 7; if (rr < 66) *(LAS v4u*)(scr + rr * CT_STRIDE + part * 16) = vin[ps]; }
        if (id + ngw < 512 * 32) hyena_pre_fetch(big, id + ngw, lane, vin);
        LDS_WAIT();
        const int cg = c0 + lane; const float w0 = sw[cg], w1 = sw[NQKV + cg], w2 = sw[2 * NQKV + cg], bias = sb[cg];
        const LAS unsigned short* col = (const LAS unsigned short*)(scr + 2 * lane);
        float pa = bf2f(col[0]), pb = bf2f(col[CT_STRIDE / 2]);
        v4u o[8];
#pragma unroll
        for (int g8 = 0; g8 < 8; ++g8) { float y[8];
#pragma unroll
            for (int k = 0; k < 8; ++k) { const float pc = bf2f(col[(g8 * 8 + k + 2) * (CT_STRIDE / 2)]); y[k] = w0 * pa + w1 * pb + w2 * pc + bias; pa = pb; pb = pc; }
            o[g8].x = pk2(y[0], y[1]); o[g8].y = pk2(y[2], y[3]); o[g8].z = pk2(y[4], y[5]); o[g8].w = pk2(y[6], y[7]); }
        LDS_WAIT();
#pragma unroll
        for (int g8 = 0; g8 < 8; ++g8) *(LAS v4u*)(scr + lane * CT_STRIDE + g8 * 16) = o[g8];
        LDS_WAIT();
#pragma unroll
        for (int ps = 0; ps < 8; ++ps) { const int cl = ps * 8 + (lane >> 3), part = lane & 7, cc = c0 + cl;
            const v4u v = *(const LAS v4u*)(scr + cl * CT_STRIDE + part * 16);
            bf16* op = (cc < DM ? VTp + (size_t)cc * NB * SEQ : X1Tp + (size_t)(cc - DM) * NB * SEQ) + (size_t)b * SEQ + t0 + part * 8;
            *(v4u*)op = v; }
        LDS_WAIT();
    }
}
constexpr int U_STRIDE = 4112, U_BYTES = 16 * U_STRIDE, CP_OFF = U_BYTES, CP_STRIDE = 8224;
struct HyFilt { v4u a, b; };
__device__ __forceinline__ HyFilt hyena_fetch_filter(const bf16* kf, int tid) { HyFilt f; const v4u* src = (const v4u*)kf; f.a = src[tid]; f.b = (tid < 2) ? src[512 + tid] : (v4u){0u, 0u, 0u, 0u}; return f; }
__device__ __forceinline__ void hyena_put_filter(LAS unsigned char* lds, const HyFilt& f, int tid) {
    *(LAS v4u*)(lds + CP_OFF + 16 * tid) = f.a;
    if (tid < 2) *(LAS v4u*)(lds + CP_OFF + 16 * (512 + tid)) = f.b;
    __syncthreads();
    const v4u lo = *(LAS v4u*)(lds + CP_OFF + 16 * tid), hi = *(LAS v4u*)(lds + CP_OFF + 16 * tid + 16);
    const unsigned s[8] = {lo.x, lo.y, lo.z, lo.w, hi.x, hi.y, hi.z, hi.w};
#pragma unroll
    for (int r = 1; r < 8; ++r) { v4u o;
#pragma unroll
        for (int w = 0; w < 4; ++w) { const int q = w + r / 2; o[w] = (r & 1) ? ((s[q] >> 16) | (s[q + 1] << 16)) : s[q]; }
        *(LAS v4u*)(lds + CP_OFF + r * CP_STRIDE + 16 * tid) = o; }
    __syncthreads();
}
__device__ __forceinline__ void hyena_conv(LAS unsigned char* lds, f32x4 (&acc)[16], unsigned toep0, unsigned uaddr0) {
#pragma unroll
    for (int ti = 0; ti < 16; ++ti) acc[ti] = (f32x4){0.f, 0.f, 0.f, 0.f};
#pragma unroll 1
    for (int k8 = 0; k8 < 8; ++k8) {
        bf16x8 uf[8];
#pragma unroll
        for (int s = 0; s < 8; ++s) uf[s] = *(const LAS bf16x8*)(lds + uaddr0 + 512 * k8 + 64 * s);
#pragma unroll
        for (int x = 0; x < 30; ++x) {
            const bf16x8 tf = *(const LAS bf16x8*)(lds + toep0 + 512 * k8 + 32 * x);
#pragma unroll
            for (int s = 0; s < 8; ++s) { const int ti = 15 + 2 * s - x; if (ti >= 0 && ti < 16) acc[ti] = __builtin_amdgcn_mfma_f32_16x16x32_bf16(tf, uf[s], acc[ti], 0, 0, 0); }
        }
    }
}
__device__ __forceinline__ void phase_hyena(bf16* VT, const bf16* X1T, const bf16* KF, const float* skip, LAS unsigned char* lds, int vcu, int G, int wave, int lane, int tid) {
    const int n = lane & 15, quad = lane >> 4, rho = (-n) & 7;
    const int base = 2048 - 256 * wave - n + 8 * quad;
    const unsigned toep0 = CP_OFF + rho * CP_STRIDE + 16 * ((base >> 3) - 30);
    const unsigned uaddr0 = n * U_STRIDE + 16 * quad;
    v4u ur[8]; HyFilt f0;
    if (vcu < DM) { const v4u* src = (const v4u*)(VT + (size_t)vcu * NB * SEQ);
#pragma unroll
        for (int k = 0; k < 8; ++k) ur[k] = src[tid + 512 * k];
        f0 = hyena_fetch_filter(KF + (size_t)vcu * KF_LEN, tid); }
    for (int d = vcu; d < DM; d += G) {
        bf16* vrow = VT + (size_t)d * NB * SEQ;
#pragma unroll
        for (int k = 0; k < 8; ++k) { const int c = tid + 512 * k; *(LAS v4u*)(lds + (c >> 8) * U_STRIDE + 16 * (c & 255)) = ur[k]; }
        hyena_put_filter(lds, f0, tid);
        const HyFilt f1 = hyena_fetch_filter(KF + (size_t)(DM + d) * KF_LEN, tid);
        v2u xx[16];
#pragma unroll
        for (int ti = 0; ti < 16; ++ti) xx[ti] = *(const v2u*)(X1T + ((size_t)d * NB + n) * SEQ + 256 * wave + 16 * ti + 4 * quad);
        f32x4 acc[16];
        hyena_conv(lds, acc, toep0, uaddr0);
        const float sk0 = skip[d], sk1 = skip[DM + d];
        v2u z[16];
#pragma unroll
        for (int ti = 0; ti < 16; ++ti) { const int t = 256 * wave + 16 * ti + 4 * quad;
            const v2u vv = *(const LAS v2u*)(lds + n * U_STRIDE + 2 * t);
            const float z0 = bflo(xx[ti].x) * (acc[ti][0] + sk0 * bflo(vv.x)), z1 = bfhi(xx[ti].x) * (acc[ti][1] + sk0 * bfhi(vv.x));
            const float z2 = bflo(xx[ti].y) * (acc[ti][2] + sk0 * bflo(vv.y)), z3 = bfhi(xx[ti].y) * (acc[ti][3] + sk0 * bfhi(vv.y));
            z[ti].x = pk2(z0, z1); z[ti].y = pk2(z2, z3); }
        __syncthreads();
#pragma unroll
        for (int ti = 0; ti < 16; ++ti) { const int t = 256 * wave + 16 * ti + 4 * quad; *(LAS v2u*)(lds + n * U_STRIDE + 2 * t) = z[ti]; }
        hyena_put_filter(lds, f1, tid);
        if (d + G < DM) { const v4u* src = (const v4u*)(VT + (size_t)(d + G) * NB * SEQ);
#pragma unroll
            for (int k = 0; k < 8; ++k) ur[k] = src[tid + 512 * k];
            f0 = hyena_fetch_filter(KF + (size_t)(d + G) * KF_LEN, tid); }
        hyena_conv(lds, acc, toep0, uaddr0);
        __syncthreads();
#pragma unroll
        for (int ti = 0; ti < 16; ++ti) { const int t = 256 * wave + 16 * ti + 4 * quad;
            const float o0 = acc[ti][0] + sk1 * bflo(z[ti].x), o1 = acc[ti][1] + sk1 * bfhi(z[ti].x), o2 = acc[ti][2] + sk1 * bflo(z[ti].y), o3 = acc[ti][3] + sk1 * bfhi(z[ti].y);
            v2u w; w.x = pk2(o0, o1); w.y = pk2(o2, o3); *(LAS v2u*)(lds + n * U_STRIDE + 2 * t) = w; }
        __syncthreads();
        {   v4u* dst = (v4u*)vrow;
#pragma unroll
            for (int k = 0; k < 8; ++k) { const int c = tid + 512 * k; dst[c] = *(const LAS v4u*)(lds + (c >> 8) * U_STRIDE + 16 * (c & 255)); } }
        __syncthreads();
    }
}
constexpr int C5_STRIDE = 132;
__device__ __forceinline__ void phase_hyena_post(const bf16* big, const float* sw, const float* sb, const bf16* ZT, bf16* outp, LAS unsigned char* lds, int gw, int ngw, int wave, int lane) {
    LAS unsigned char* scr = lds + wave * 16384;
    for (int id = gw; id < 512 * 16; id += ngw) {
        const int dtile = id & 15, tt = id >> 4, b = tt >> 5, t0 = (tt & 31) * 64, d0 = dtile * 64;
        const int cg = 2 * DM + d0 + lane; const float w0 = sw[cg], w1 = sw[NQKV + cg], w2 = sw[2 * NQKV + cg], bias = sb[cg];
        const bf16* pp = big + (size_t)(b * SEQ + t0) * NQKV + cg;
        unsigned short pr[66];
#pragma unroll
        for (int k = 0; k < 66; ++k) { const int t = t0 - 1 + k; pr[k] = (t >= 0 && t < SEQ) ? pp[(long)(k - 1) * NQKV] : (unsigned short)0; }
        v4u zv[8];
#pragma unroll
        for (int ps = 0; ps < 8; ++ps) { const int dd = ps * 8 + (lane >> 3), part = lane & 7; zv[ps] = *(const v4u*)(ZT + ((size_t)(d0 + dd) * NB + b) * SEQ + t0 + part * 8); }
#pragma unroll
        for (int ps = 0; ps < 8; ++ps) { const int dd = ps * 8 + (lane >> 3), part = lane & 7;
            LAS unsigned* w = (LAS unsigned*)(scr + dd * C5_STRIDE + part * 16); w[0] = zv[ps].x; w[1] = zv[ps].y; w[2] = zv[ps].z; w[3] = zv[ps].w; }
        LDS_WAIT();
        const LAS unsigned short* zr = (const LAS unsigned short*)(scr + lane * C5_STRIDE);
        bf16* op = outp + (size_t)(b * SEQ + t0) * DM + d0 + lane;
#pragma unroll
        for (int k = 0; k < 64; ++k) { const float y = (w0 * bf2f(pr[k]) + w1 * bf2f(pr[k + 1]) + w2 * bf2f(pr[k + 2]) + bias) * bf2f(zr[k]); op[(size_t)k * DM] = f2bf(y); }
        LDS_WAIT();
    }
}

__global__ void __launch_bounds__(NTHREADS, 2) mk_fwd(Args a) {
    extern __shared__ __attribute__((aligned(16))) unsigned char lds_raw[];
    LAS unsigned char* lds = (LAS unsigned char*)lds_raw;
    cg::grid_group grid = cg::this_grid();
    const int tid = threadIdx.x, lane = tid & 63, wave = __builtin_amdgcn_readfirstlane(tid >> 6);
    const int G = gridDim.x, bx = blockIdx.x;
    const int vcu = (G % 8 == 0) ? (bx % 8) * (G / 8) + bx / 8 : bx;
    const int gw = vcu * NWAVES + wave, ngw = G * NWAVES;
    unsigned char* ws = a.ws;
    float* SS = (float*)(ws + WS_SS); bf16* XN = (bf16*)(ws + WS_XN); bf16* VT = (bf16*)(ws + WS_VT); bf16* MIXO = (bf16*)(ws + WS_MIXO); bf16* BIG = (bf16*)(ws + WS_BIG);
    const int lo = a.ph_lo, hi = a.ph_hi; int ph = 0;
    volatile LAS unsigned* MISC = (volatile LAS unsigned*)(lds + MISC_OFF);
    if (tid < 16) MISC[tid] = 0u;
    __syncthreads();
    XcdBarrier xbar = xcd_barrier_post((unsigned*)(ws + WS_BAR), MISC);
#define PH_BEGIN if (ph >= lo && ph < hi) {
#define PH_END   if (ph + 1 < hi) { if (ph == 0) grid.sync(); else xcd_barrier(xbar); } } ++ph;

    PH_BEGIN phase_prologue(a, lds, gw, ngw, wave, lane);
    PH_END
    PH_BEGIN phase_filters(a, lds, vcu, G, wave, lane, tid); phase_norm0(a.in[0], XN, SS, gw, ngw, lane); PH_END

    { constexpr int L = 0;

        constexpr int kind = L % 3;
        const bf16* wl = (const bf16*)(ws + WS_W + (size_t)L * W_LAYER);
        PH_BEGIN { pg8::Gemm g{XN, wl + W_IN / 2, MTOK, NQKV, DM}; pg8::StaticOrder S; S.init(MTOK, NQKV, G, bx); fill_row_scales(S, SS, (LAS float*)(lds + RST_OFF), tid);
                   if constexpr (kind == 0) { pg8::EpiShortIn E{BIG, BIG + (size_t)MTOK * DM, (const LAS float*)(lds + RST_OFF)}; pg8::gemm_phase<pg8::EpiShortIn, pg8::StaticOrder, true, true>(lds, g, S, E); }
                   else { pg8::EpiBf16PT<(kind == 1)> E{BIG, NQKV, (const LAS float*)(lds + RST_OFF), (float*)(ws + WS_KSS), MTOK};
                   pg8::gemm_phase<pg8::EpiBf16PT<(kind == 1)>, pg8::StaticOrder, true, true>(lds, g, S, E); }
 } PH_END
        if (kind == 0) {
            PH_BEGIN phase_shortconv(BIG, BIG + (size_t)MTOK * DM, a.in[4] + (size_t)(L / 3) * 3 * DM, MIXO, vcu * NTHREADS + tid, G * NTHREADS);
            PH_END
        } else if (kind == 1) {
            PH_BEGIN
            phase_natten3(BIG, a.in[7], a.in[8], a.in[9], (const float*)(ws + WS_KSS), MIXO, lds, vcu, G, wave, lane, tid); PH_END
        } else {
            PH_BEGIN phase_hyena_pre(BIG, a.in[12], a.in[13], VT, MIXO, lds, gw, ngw, wave, lane);
            PH_END
            PH_BEGIN
            phase_hyena(VT, MIXO, (const bf16*)(ws + WS_KF), a.in[20], lds, vcu, G, wave, lane, tid); PH_END
            PH_BEGIN phase_hyena_post(BIG, a.in[12], a.in[13], VT, MIXO, lds, gw, ngw, wave, lane);
            PH_END
        }
        PH_BEGIN { pg8::Gemm g{MIXO, wl + W_OUT / 2, MTOK, DM, DM}; pg8::StaticOrder S; S.init(MTOK, DM, G, bx); pg8::EpiResNorm E{a.out, XN, SS, DM};
                   pg8::gemm_phase<pg8::EpiResNorm, pg8::StaticOrder, true, true>(lds, g, S, E); } PH_END
        PH_BEGIN { pg8::Gemm g{XN, wl + W_13 / 2, MTOK, NW13, DM}; pg8::StaticOrder S; S.init(MTOK, NW13, G, bx); pg8::EpiSwiGLU E{BIG, FFH, (const LAS float*)(lds + RST_OFF)}; fill_row_scales(S, SS, (LAS float*)(lds + RST_OFF), tid);
                   pg8::gemm_phase<pg8::EpiSwiGLU, pg8::StaticOrder, true, true>(lds, g, S, E);
 } PH_END
        PH_BEGIN { pg8::Gemm g{BIG, wl + W_2 / 2, MTOK, DM, FFH}; pg8::StaticOrder S; S.init(MTOK, DM, G, bx); pg8::EpiResNormT<(L == NLAYER - 1)> E{a.out, XN, SS, DM};
                   pg8::gemm_phase<pg8::EpiResNormT<(L == NLAYER - 1)>, pg8::StaticOrder, true, true>(lds, g, S, E); } PH_END
        }
    { constexpr int L = 1;

        constexpr int kind = L % 3;
        const bf16* wl = (const bf16*)(ws + WS_W + (size_t)L * W_LAYER);
        PH_BEGIN { pg8::Gemm g{XN, wl + W_IN / 2, MTOK, NQKV, DM}; pg8::StaticOrder S; S.init(MTOK, NQKV, G, bx); fill_row_scales(S, SS, (LAS float*)(lds + RST_OFF), tid);
                   if constexpr (kind == 0) { pg8::EpiShortIn E{BIG, BIG + (size_t)MTOK * DM, (const LAS float*)(lds + RST_OFF)}; pg8::gemm_phase<pg8::EpiShortIn, pg8::StaticOrder, true, true>(lds, g, S, E); }
                   else { pg8::EpiBf16PT<(kind == 1)> E{BIG, NQKV, (const LAS float*)(lds + RST_OFF), (float*)(ws + WS_KSS), MTOK};
                   pg8::gemm_phase<pg8::EpiBf16PT<(kind == 1)>, pg8::StaticOrder, true, true>(lds, g, S, E); }
 } PH_END
        if (kind == 0) {
            PH_BEGIN phase_shortconv(BIG, BIG + (size_t)MTOK * DM, a.in[4] + (size_t)(L / 3) * 3 * DM, MIXO, vcu * NTHREADS + tid, G * NTHREADS);
            PH_END
        } else if (kind == 1) {
            PH_BEGIN
            phase_natten3(BIG, a.in[7], a.in[8], a.in[9], (const float*)(ws + WS_KSS), MIXO, lds, vcu, G, wave, lane, tid); PH_END
        } else {
            PH_BEGIN phase_hyena_pre(BIG, a.in[12], a.in[13], VT, MIXO, lds, gw, ngw, wave, lane);
            PH_END
            PH_BEGIN
            phase_hyena(VT, MIXO, (const bf16*)(ws + WS_KF), a.in[20], lds, vcu, G, wave, lane, tid); PH_END
            PH_BEGIN phase_hyena_post(BIG, a.in[12], a.in[13], VT, MIXO, lds, gw, ngw, wave, lane);
            PH_END
        }
        PH_BEGIN { pg8::Gemm g{MIXO, wl + W_OUT / 2, MTOK, DM, DM}; pg8::StaticOrder S; S.init(MTOK, DM, G, bx); pg8::EpiResNorm E{a.out, XN, SS, DM};
                   pg8::gemm_phase<pg8::EpiResNorm, pg8::StaticOrder, true, true>(lds, g, S, E); } PH_END
        PH_BEGIN { pg8::Gemm g{XN, wl + W_13 / 2, MTOK, NW13, DM}; pg8::StaticOrder S; S.init(MTOK, NW13, G, bx); pg8::EpiSwiGLU E{BIG, FFH, (const LAS float*)(lds + RST_OFF)}; fill_row_scales(S, SS, (LAS float*)(lds + RST_OFF), tid);
                   pg8::gemm_phase<pg8::EpiSwiGLU, pg8::StaticOrder, true, true>(lds, g, S, E);
 } PH_END
        PH_BEGIN { pg8::Gemm g{BIG, wl + W_2 / 2, MTOK, DM, FFH}; pg8::StaticOrder S; S.init(MTOK, DM, G, bx); pg8::EpiResNormT<(L == NLAYER - 1)> E{a.out, XN, SS, DM};
                   pg8::gemm_phase<pg8::EpiResNormT<(L == NLAYER - 1)>, pg8::StaticOrder, true, true>(lds, g, S, E); } PH_END
        }
    { constexpr int L = 2;

        constexpr int kind = L % 3;
        const bf16* wl = (const bf16*)(ws + WS_W + (size_t)L * W_LAYER);
        PH_BEGIN { pg8::Gemm g{XN, wl + W_IN / 2, MTOK, NQKV, DM}; pg8::StaticOrder S; S.init(MTOK, NQKV, G, bx); fill_row_scales(S, SS, (LAS float*)(lds + RST_OFF), tid);
                   if constexpr (kind == 0) { pg8::EpiShortIn E{BIG, BIG + (size_t)MTOK * DM, (const LAS float*)(lds + RST_OFF)}; pg8::gemm_phase<pg8::EpiShortIn, pg8::StaticOrder, true, true>(lds, g, S, E); }
                   else { pg8::EpiBf16PT<(kind == 1)> E{BIG, NQKV, (const LAS float*)(lds + RST_OFF), (float*)(ws + WS_KSS), MTOK};
                   pg8::gemm_phase<pg8::EpiBf16PT<(kind == 1)>, pg8::StaticOrder, true, true>(lds, g, S, E); }
 } PH_END
        if (kind == 0) {
            PH_BEGIN phase_shortconv(BIG, BIG + (size_t)MTOK * DM, a.in[4] + (size_t)(L / 3) * 3 * DM, MIXO, vcu * NTHREADS + tid, G * NTHREADS);
            PH_END
        } else if (kind == 1) {
            PH_BEGIN
            phase_natten3(BIG, a.in[7], a.in[8], a.in[9], (const float*)(ws + WS_KSS), MIXO, lds, vcu, G, wave, lane, tid); PH_END
        } else {
            PH_BEGIN phase_hyena_pre(BIG, a.in[12], a.in[13], VT, MIXO, lds, gw, ngw, wave, lane);
            PH_END
            PH_BEGIN
            phase_hyena(VT, MIXO, (const bf16*)(ws + WS_KF), a.in[20], lds, vcu, G, wave, lane, tid); PH_END
            PH_BEGIN phase_hyena_post(BIG, a.in[12], a.in[13], VT, MIXO, lds, gw, ngw, wave, lane);
            PH_END
        }
        PH_BEGIN { pg8::Gemm g{MIXO, wl + W_OUT / 2, MTOK, DM, DM}; pg8::StaticOrder S; S.init(MTOK, DM, G, bx); pg8::EpiResNorm E{a.out, XN, SS, DM};
                   pg8::gemm_phase<pg8::EpiResNorm, pg8::StaticOrder, true, true>(lds, g, S, E); } PH_END
        PH_BEGIN { pg8::Gemm g{XN, wl + W_13 / 2, MTOK, NW13, DM}; pg8::StaticOrder S; S.init(MTOK, NW13, G, bx); pg8::EpiSwiGLU E{BIG, FFH, (const LAS float*)(lds + RST_OFF)}; fill_row_scales(S, SS, (LAS float*)(lds + RST_OFF), tid);
                   pg8::gemm_phase<pg8::EpiSwiGLU, pg8::StaticOrder, true, true>(lds, g, S, E);
 } PH_END
        PH_BEGIN { pg8::Gemm g{BIG, wl + W_2 / 2, MTOK, DM, FFH}; pg8::StaticOrder S; S.init(MTOK, DM, G, bx); pg8::EpiResNormT<(L == NLAYER - 1)> E{a.out, XN, SS, DM};
                   pg8::gemm_phase<pg8::EpiResNormT<(L == NLAYER - 1)>, pg8::StaticOrder, true, true>(lds, g, S, E); } PH_END
        }
    { constexpr int L = 3;

        constexpr int kind = L % 3;
        const bf16* wl = (const bf16*)(ws + WS_W + (size_t)L * W_LAYER);
        PH_BEGIN { pg8::Gemm g{XN, wl + W_IN / 2, MTOK, NQKV, DM}; pg8::StaticOrder S; S.init(MTOK, NQKV, G, bx); fill_row_scales(S, SS, (LAS float*)(lds + RST_OFF), tid);
                   if constexpr (kind == 0) { pg8::EpiShortIn E{BIG, BIG + (size_t)MTOK * DM, (const LAS float*)(lds + RST_OFF)}; pg8::gemm_phase<pg8::EpiShortIn, pg8::StaticOrder, true, true>(lds, g, S, E); }
                   else { pg8::EpiBf16PT<(kind == 1)> E{BIG, NQKV, (const LAS float*)(lds + RST_OFF), (float*)(ws + WS_KSS), MTOK};
                   pg8::gemm_phase<pg8::EpiBf16PT<(kind == 1)>, pg8::StaticOrder, true, true>(lds, g, S, E); }
 } PH_END
        if (kind == 0) {
            PH_BEGIN phase_shortconv(BIG, BIG + (size_t)MTOK * DM, a.in[4] + (size_t)(L / 3) * 3 * DM, MIXO, vcu * NTHREADS + tid, G * NTHREADS);
            PH_END
        } else if (kind == 1) {
            PH_BEGIN
            phase_natten3(BIG, a.in[7], a.in[8], a.in[9], (const float*)(ws + WS_KSS), MIXO, lds, vcu, G, wave, lane, tid); PH_END
        } else {
            PH_BEGIN phase_hyena_pre(BIG, a.in[12], a.in[13], VT, MIXO, lds, gw, ngw, wave, lane);
            PH_END
            PH_BEGIN
            phase_hyena(VT, MIXO, (const bf16*)(ws + WS_KF), a.in[20], lds, vcu, G, wave, lane, tid); PH_END
            PH_BEGIN phase_hyena_post(BIG, a.in[12], a.in[13], VT, MIXO, lds, gw, ngw, wave, lane);
            PH_END
        }
        PH_BEGIN { pg8::Gemm g{MIXO, wl + W_OUT / 2, MTOK, DM, DM}; pg8::StaticOrder S; S.init(MTOK, DM, G, bx); pg8::EpiResNorm E{a.out, XN, SS, DM};
                   pg8::gemm_phase<pg8::EpiResNorm, pg8::StaticOrder, true, true>(lds, g, S, E); } PH_END
        PH_BEGIN { pg8::Gemm g{XN, wl + W_13 / 2, MTOK, NW13, DM}; pg8::StaticOrder S; S.init(MTOK, NW13, G, bx); pg8::EpiSwiGLU E{BIG, FFH, (const LAS float*)(lds + RST_OFF)}; fill_row_scales(S, SS, (LAS float*)(lds + RST_OFF), tid);
                   pg8::gemm_phase<pg8::EpiSwiGLU, pg8::StaticOrder, true, true>(lds, g, S, E);
 } PH_END
        PH_BEGIN { pg8::Gemm g{BIG, wl + W_2 / 2, MTOK, DM, FFH}; pg8::StaticOrder S; S.init(MTOK, DM, G, bx); pg8::EpiResNormT<(L == NLAYER - 1)> E{a.out, XN, SS, DM};
                   pg8::gemm_phase<pg8::EpiResNormT<(L == NLAYER - 1)>, pg8::StaticOrder, true, true>(lds, g, S, E); } PH_END
        }
#undef PH_BEGIN
#undef PH_END
}
#ifndef MK_NPH
#define MK_NPH (2 + 5 + 5 + 7 + 5)
#endif
constexpr int N_PHASES = MK_NPH;

extern "C" void kernel_launch(void* const* d_in, const int* in_sizes, int n_in, void* d_out, int out_size, void* d_ws, size_t ws_size, hipStream_t stream) {
    static int grid = 0;
    if (grid == 0) {
        if (n_in != 24 || out_size != MTOK * DM || ws_size < WS_END) { fprintf(stderr, "kernel_launch: unexpected shapes (n_in %d, out %d, ws %zu); nothing launched\n", n_in, out_size, ws_size); grid = -1; return; }
        int dev = 0, cus = 0, per_cu = 0;
        if (hipGetDevice(&dev) != hipSuccess || hipDeviceGetAttribute(&cus, hipDeviceAttributeMultiprocessorCount, dev) != hipSuccess) { grid = -1; return; }
        if (hipFuncSetAttribute((const void*)mk_fwd, hipFuncAttributeMaxDynamicSharedMemorySize, LDS_BYTES) != hipSuccess) { fprintf(stderr, "kernel_launch: hipFuncSetAttribute failed\n"); grid = -1; return; }
        if (hipOccupancyMaxActiveBlocksPerMultiprocessor(&per_cu, (const void*)mk_fwd, NTHREADS, LDS_BYTES) != hipSuccess || per_cu < 1) { fprintf(stderr, "kernel_launch: occupancy query gives %d\n", per_cu); per_cu = 1; }
        (void)hipGetLastError();
        grid = cus;
    }
    if (grid < 0) return;
    Args a{};
    for (int i = 0; i < 24; ++i) a.in[i] = (const float*)d_in[i];
    a.out = (float*)d_out; a.ws = (unsigned char*)d_ws;
    if (hipMemsetAsync(d_ws, 0, CTL_ZERO_BYTES, stream) != hipSuccess) { fprintf(stderr, "kernel_launch: memset of the control words failed\n"); return; }
#if MK_N_LAUNCHES == 1
    a.ph_lo = 0; a.ph_hi = N_PHASES;
    { void* args[] = {&a}; hipError_t e = hipLaunchCooperativeKernel((const void*)mk_fwd, dim3(grid), dim3(NTHREADS), args, LDS_BYTES, stream);
      if (e != hipSuccess) fprintf(stderr, "kernel_launch: cooperative launch failed: %s (grid %d)\n", hipGetErrorString(e), grid); }
#else
    for (int p = 0; p < N_PHASES; ++p) { a.ph_lo = p; a.ph_hi = p + 1; void* args[] = {&a};
        hipError_t e = hipLaunchCooperativeKernel((const void*)mk_fwd, dim3(grid), dim3(NTHREADS), args, LDS_BYTES, stream);
        if (e != hipSuccess) { fprintf(stderr, "kernel_launch: launch %d failed: %s\n", p, hipGetErrorString(e)); break; } }
#endif
}
```
